# Optimizing an MI355X kernel written in HIP

```python
import math
import jax, jax.numpy as jnp
from jax import lax
import numpy as np

D_MODEL = 1024
BATCH = 8
SEQ = 8192
DEPTH = 2

CHUNK = 64
Q_BLOCK = 128
HEAD_DIM = 64
ROPE_THETA = 10000.0
EPS = 1e-6
N_MEM = 256
MEM_HEADS = 4
MEM_WIDTH = MEM_HEADS * HEAD_DIM
MIX_WIDTH = D_MODEL
SEQ_WIDTH = MIX_WIDTH - MEM_WIDTH
DIFF_HEADS = SEQ_WIDTH // (2 * HEAD_DIM)
DSA_HEADS = SEQ_WIDTH // HEAD_DIM
IDX_HEADS = 8
IDX_DIM = 64
DSA_TOPK_MAX = 256
D_FF = 4 * D_MODEL
N_DIFF_LAYERS = (DEPTH + 1) // 2
N_DSA_LAYERS = DEPTH // 2

DIFF_SIZES = (2 * DIFF_HEADS * HEAD_DIM,
              2 * DIFF_HEADS * HEAD_DIM,
              DIFF_HEADS * 2 * HEAD_DIM,
              MEM_WIDTH)
DSA_SIZES = (DSA_HEADS * HEAD_DIM,
             HEAD_DIM,
             HEAD_DIM,
             IDX_HEADS * IDX_DIM,
             IDX_DIM,
             IDX_HEADS,
             MEM_WIDTH)
DIFF_IN = sum(DIFF_SIZES)
DSA_IN = sum(DSA_SIZES)

kernel_name = "hybrid_diffattn_dsa_memory_trunk"


def rms_norm(x, g):
    xf = x.astype(jnp.float32)
    y = xf * lax.rsqrt(jnp.mean(xf * xf, axis=-1, keepdims=True) + EPS)
    return (y * g.astype(jnp.float32)).astype(x.dtype)


def split_cols(a, sizes):
    idx = np.cumsum(sizes)[:-1].tolist()
    return jnp.split(a, idx, axis=-1)


def rope_tables(positions, dim):
    inv = ROPE_THETA ** (-jnp.arange(0, dim, 2, dtype=jnp.float32) / dim)
    ang = positions.astype(jnp.float32)[..., None] * inv
    return jnp.cos(ang), jnp.sin(ang)


def apply_rope(x, cos, sin):
    xf = x.astype(jnp.float32)
    x1, x2 = jnp.split(xf, 2, axis=-1)
    out = jnp.concatenate([x1 * cos - x2 * sin, x2 * cos + x1 * sin], axis=-1)
    return out.astype(x.dtype)


def to_blocks(a):
    b, s = a.shape[:2]
    return jnp.moveaxis(a.reshape(b, s // Q_BLOCK, Q_BLOCK, *a.shape[2:]), 1, 0)


def from_blocks(a):
    nb, b, q = a.shape[:3]
    return jnp.moveaxis(a, 0, 1).reshape(b, nb * q, *a.shape[3:])


def memory_attention(qm, mem_n, w_kv):
    b, s, _ = qm.shape
    km, vm = jnp.split(mem_n @ w_kv, 2, axis=-1)
    qm = qm.reshape(b, s, MEM_HEADS, HEAD_DIM)
    km = km.reshape(b, N_MEM, MEM_HEADS, HEAD_DIM)
    vm = vm.reshape(b, N_MEM, MEM_HEADS, HEAD_DIM)
    sc = jnp.einsum('bshd,bmhd->bhsm', qm, km).astype(jnp.float32) * (HEAD_DIM ** -0.5)
    p = jax.nn.softmax(sc, axis=-1).astype(vm.dtype)
    o = jnp.einsum('bhsm,bmhd->bshd', p, vm)
    return o.reshape(b, s, MEM_WIDTH)


def diff_attention(h, w_in, lq1, lk1, lq2, lk2, g_subln, cos, sin, chunk_id, layer_idx):
    b, s, _ = h.shape
    q, k, v, qm = split_cols(h @ w_in, DIFF_SIZES)
    q = apply_rope(q.reshape(b, s, 2 * DIFF_HEADS, HEAD_DIM), cos[:, :, None], sin[:, :, None])
    k = apply_rope(k.reshape(b, s, 2 * DIFF_HEADS, HEAD_DIM), cos[:, :, None], sin[:, :, None])
    v = v.reshape(b, s, DIFF_HEADS, 2 * HEAD_DIM)
    lam_init = 0.8 - 0.6 * math.exp(-0.3 * layer_idx)
    lam = (jnp.exp(jnp.sum(lq1.astype(jnp.float32) * lk1.astype(jnp.float32)))
           - jnp.exp(jnp.sum(lq2.astype(jnp.float32) * lk2.astype(jnp.float32))) + lam_init)
    scale = HEAD_DIM ** -0.5

    def block(args):
        qb, cqb = args
        sc = jnp.einsum('bqhd,bkhd->bhqk', qb, k).astype(jnp.float32) * scale
        mask = (cqb[:, :, None] >= chunk_id[:, None, :])[:, None]
        p = jax.nn.softmax(jnp.where(mask, sc, -jnp.inf), axis=-1)
        p = p.reshape(b, DIFF_HEADS, 2, qb.shape[1], s)
        a = p[:, :, 0] - lam * p[:, :, 1]
        return jnp.einsum('bhqk,bkhd->bqhd', a.astype(v.dtype), v)

    o = from_blocks(lax.map(block, (to_blocks(q), to_blocks(chunk_id))))
    o = rms_norm(o, g_subln) * (1.0 - lam_init)
    return o.reshape(b, s, SEQ_WIDTH), qm


def dsa_attention(h, w_in, cos, sin, chunk_id):
    b, s, _ = h.shape
    q, k, v, iq, ik, iw, qm = split_cols(h @ w_in, DSA_SIZES)
    q = apply_rope(q.reshape(b, s, DSA_HEADS, HEAD_DIM), cos[:, :, None], sin[:, :, None])
    k = apply_rope(k, cos, sin)
    iq = apply_rope(iq.reshape(b, s, IDX_HEADS, IDX_DIM), cos[:, :, None], sin[:, :, None])
    ik = apply_rope(ik, cos, sin)
    iw = iw * (IDX_HEADS ** -0.5 * IDX_DIM ** -0.5)
    top_k = min(DSA_TOPK_MAX, s // 4)
    scale = HEAD_DIM ** -0.5
    gather = jax.vmap(lambda tb, ib: tb[ib])

    def block(args):
        qb, iqb, iwb, cqb = args
        logits = jnp.einsum('bqhd,bkd->bqhk', iqb, ik).astype(jnp.float32)
        score = jnp.einsum('bqhk,bqh->bqk', jax.nn.relu(logits), iwb.astype(jnp.float32))
        admissible = cqb[:, :, None] >= chunk_id[:, None, :]
        score = jnp.where(admissible, score, -jnp.inf)
        top_val, top_idx = lax.top_k(score, top_k)
        valid = top_val > -jnp.inf
        kg = gather(k, top_idx)
        vg = gather(v, top_idx)
        sc = jnp.einsum('bqhd,bqkd->bhqk', qb, kg).astype(jnp.float32) * scale
        p = jax.nn.softmax(jnp.where(valid[:, None], sc, -jnp.inf), axis=-1)
        return jnp.einsum('bhqk,bqkd->bqhd', p.astype(vg.dtype), vg)

    o = from_blocks(lax.map(block, (to_blocks(q), to_blocks(iq), to_blocks(iw), to_blocks(chunk_id))))
    return o.reshape(b, s, SEQ_WIDTH), qm


def setup_inputs(seed: int = 0) -> dict:
    key = jax.random.key(seed)
    ks = jax.random.split(key, 24)

    def w(k, shape, fan_in):
        return jax.random.normal(k, shape, jnp.float32) * (fan_in ** -0.5)

    def gain(k, shape):
        return 1.0 + 0.05 * jax.random.normal(k, shape, jnp.float32)

    x = jax.random.normal(ks[0], (BATCH, SEQ, D_MODEL), jnp.float32)
    mem = jax.random.normal(ks[1], (BATCH, N_MEM, D_MODEL), jnp.float32)
    offsets = jax.random.randint(ks[2], (BATCH, 1), 0, 16) * CHUNK
    positions = (offsets + jnp.arange(SEQ)[None, :]).astype(jnp.int32)
    return {
        "x": x,
        "mem": mem,
        "positions": positions,
        "g_pre_mix": gain(ks[3], (DEPTH, D_MODEL)),
        "g_post_mix": gain(ks[4], (DEPTH, D_MODEL)),
        "g_mem": gain(ks[5], (DEPTH, D_MODEL)),
        "w_mem_kv": w(ks[6], (DEPTH, D_MODEL, 2 * MEM_WIDTH), D_MODEL),
        "w_out": w(ks[7], (DEPTH, MIX_WIDTH, D_MODEL), MIX_WIDTH),
        "g_pre_mlp": gain(ks[8], (DEPTH, D_MODEL)),
        "g_post_mlp": gain(ks[9], (DEPTH, D_MODEL)),
        "w_mlp_up": w(ks[10], (DEPTH, D_MODEL, D_FF), D_MODEL),
        "w_mlp_down": w(ks[11], (DEPTH, D_FF, D_MODEL), D_FF),
        "w_in_diff": w(ks[12], (N_DIFF_LAYERS, D_MODEL, DIFF_IN), D_MODEL),
        "lambda_q1": 0.1 * jax.random.normal(ks[13], (N_DIFF_LAYERS, HEAD_DIM), jnp.float32),
        "lambda_k1": 0.1 * jax.random.normal(ks[14], (N_DIFF_LAYERS, HEAD_DIM), jnp.float32),
        "lambda_q2": 0.1 * jax.random.normal(ks[15], (N_DIFF_LAYERS, HEAD_DIM), jnp.float32),
        "lambda_k2": 0.1 * jax.random.normal(ks[16], (N_DIFF_LAYERS, HEAD_DIM), jnp.float32),
        "g_diff_subln": gain(ks[17], (N_DIFF_LAYERS, 2 * HEAD_DIM)),
        "w_in_dsa": w(ks[18], (N_DSA_LAYERS, D_MODEL, DSA_IN), D_MODEL),
    }


def reference(x, mem, positions, g_pre_mix, g_post_mix, g_mem, w_mem_kv, w_out,
              g_pre_mlp, g_post_mlp, w_mlp_up, w_mlp_down, w_in_diff,
              lambda_q1, lambda_k1, lambda_q2, lambda_k2, g_diff_subln, w_in_dsa):
    cos, sin = rope_tables(positions, HEAD_DIM)
    chunk_id = positions // CHUNK
    for i in range(DEPTH):
        j = i // 2
        h = rms_norm(x, g_pre_mix[i])
        if i % 2 == 0:
            o_seq, qm = diff_attention(h, w_in_diff[j], lambda_q1[j], lambda_k1[j],
                                       lambda_q2[j], lambda_k2[j], g_diff_subln[j],
                                       cos, sin, chunk_id, i)
        else:
            o_seq, qm = dsa_attention(h, w_in_dsa[j], cos, sin, chunk_id)
        o_mem = memory_attention(qm, rms_norm(mem, g_mem[i]), w_mem_kv[i])
        y = jnp.concatenate([o_seq, o_mem], axis=-1) @ w_out[i]
        x = x + rms_norm(y, g_post_mix[i])
        h = rms_norm(x, g_pre_mlp[i])
        y = jnp.square(jax.nn.relu(h @ w_mlp_up[i])) @ w_mlp_down[i]
        x = x + rms_norm(y, g_post_mlp[i])
    return x
```

```cpp
#include <hip/hip_runtime.h>
#include <cstdio>
#include <cstdint>
#include <cstring>
namespace pg8 {
#define PG8_LAS __attribute__((address_space(3)))
typedef unsigned short bf16_t;
typedef short bf16x8 __attribute__((ext_vector_type(8)));
typedef float f32x4 __attribute__((ext_vector_type(4)));
typedef unsigned u32x4 __attribute__((ext_vector_type(4)));
constexpr int BM = 256, BK = 64, HALF = 128, HTB = HALF * BK * 2  , STAGE_BYTES = 8 * HTB, NXCD = 8, WGM = 8;

__host__ __device__ __forceinline__ int lds_byte(int r, int c) { const int st = (r >> 4) * 2 + (c >> 5), rr = r & 15, cc = c & 31, ob = rr * 64 + cc * 2; return st * 1024 + (ob ^ (((ob >> 9) & 1) << 5)); }
__host__ __device__ __forceinline__ void stage_rc(int b, int& R, int& C) { const int st = b / 1024, sb = b % 1024, swz = sb ^ (((sb >> 9) & 1) << 5); R = (st >> 1) * 16 + swz / 64; C = (st & 1) * 32 + (swz % 64) / 2; }
__host__ __device__ __forceinline__ int perm32(int rho) { const int n = rho >> 4, i = rho & 15; return 8 * (i >> 2) + 4 * n + (i & 3); }

struct Unit { int pm, pn; };
struct Gemm { const bf16_t* A; const bf16_t* Bt; int M, N, K; };

struct StaticOrder {
    int nM, nN, nwg, G, c;
    __host__ __device__ void init(int M, int N, int G_, int c_) { nM = M / BM; nN = N / BM; nwg = nM * nN; G = G_; c = c_; }
    __host__ __device__ bool next(int i, Unit& u) const {
        const long L = (long)i * G + c; if (L >= nwg) return false;
        int wgid = (int)L; { const int q = nwg / NXCD, r = nwg % NXCD, xcd = wgid % NXCD, off = wgid / NXCD; wgid = (xcd < r ? xcd * (q + 1) : r * (q + 1) + (xcd - r) * q) + off; }
        const int nig = WGM * nN, gid = wgid / nig, fm = gid * WGM, gsz = (nM - fm) < WGM ? (nM - fm) : WGM;
        u.pm = fm + ((wgid % nig) % gsz); u.pn = (wgid % nig) / gsz; return true;
    }
    __device__ __forceinline__ void a_ready(const Unit&) const {}
    __device__ __forceinline__ void done(const Unit&) const {}
};

__device__ __forceinline__ unsigned cvt_pk_bf16(float lo, float hi) { unsigned r; asm volatile("v_cvt_pk_bf16_f32 %0, %1, %2" : "=v"(r) : "v"(lo), "v"(hi)); return r; }
typedef float f32x2 __attribute__((ext_vector_type(2)));
__device__ __forceinline__ f32x2 gelu_pk(f32x2 v) {
    const f32x2 av = __builtin_elementwise_abs(v), d = av * 0.2316418882f + 1.0f;
    f32x2 t; t.x = __builtin_amdgcn_rcpf(d.x); t.y = __builtin_amdgcn_rcpf(d.y);
    f32x2 q = t * 0.5307027145f + (-0.7265760135f); q = q * t + 0.7107068705f; q = q * t + (-0.142248368f); q = q * t + 0.127414796f; q = q * t;
    const f32x2 s = (v * v) * (-0.72134752044f);
    f32x2 e; e.x = __builtin_amdgcn_exp2f(s.x); e.y = __builtin_amdgcn_exp2f(s.y);
    const f32x2 m = v * (q * e), r = v - m;
    f32x2 o; o.x = v.x < 0.f ? m.x : r.x; o.y = v.y < 0.f ? m.y : r.y; return o;
}

template <int ACT  > struct EpiBf16 {
    static constexpr bool PERM = true, AFTER_DRAIN = false; static_assert(ACT == 0 || ACT == 1, "EpiBf16: ACT is 0 (none) or 1 (gelu_pk)");
    bf16_t* O; int ldc; const float* bias; int split_cols; size_t split_stride; float scale0;
    __device__ __forceinline__ void operator()(const f32x4 (&acc)[2][2][4][2], const Unit& u, int wr, int wc, int fr, int fq) const {
        const int row0 = u.pm * BM + wr * 64 + fr; int colt = u.pn * BM; bf16_t* base = O;
        float sc = 1.f; if (split_cols) { const int t = colt / split_cols; base += (size_t)t * split_stride; colt -= t * split_cols; if (t == 0) sc = scale0; }
        const int col0 = colt + wc * 32 + 8 * fq, bcol0 = u.pn * BM + wc * 32 + 8 * fq;
        f32x4 bv[2][2];
#pragma unroll
        for (int bj = 0; bj < 2; ++bj)
#pragma unroll
            for (int n = 0; n < 2; ++n) bv[bj][n] = bias ? *(const f32x4*)(bias + bcol0 + bj * HALF + 4 * n) : (f32x4){0.f, 0.f, 0.f, 0.f};
#pragma unroll
        for (int ai = 0; ai < 2; ++ai)
#pragma unroll
            for (int m = 0; m < 4; ++m) { bf16_t* rowp = base + (size_t)(row0 + ai * HALF + m * 16) * ldc + col0;
#pragma unroll
                for (int bj = 0; bj < 2; ++bj) { f32x4 v0 = acc[ai][bj][m][0] + bv[bj][0], v1 = acc[ai][bj][m][1] + bv[bj][1];
                    if (ACT == 1) { f32x2 a = gelu_pk((f32x2){v0[0], v0[1]}), b = gelu_pk((f32x2){v0[2], v0[3]}), c = gelu_pk((f32x2){v1[0], v1[1]}), d = gelu_pk((f32x2){v1[2], v1[3]});
                        v0 = (f32x4){a.x, a.y, b.x, b.y}; v1 = (f32x4){c.x, c.y, d.x, d.y}; }
                    v0 = v0 * sc; v1 = v1 * sc; u32x4 w; w.x = cvt_pk_bf16(v0[0], v0[1]); w.y = cvt_pk_bf16(v0[2], v0[3]); w.z = cvt_pk_bf16(v1[0], v1[1]); w.w = cvt_pk_bf16(v1[2], v1[3]);
                    *(u32x4*)(rowp + bj * HALF) = w; } }
    }
};

struct PanelStats {
    unsigned* xbuf;
    unsigned* cnt;
    unsigned* tmo;
    int ntn; float eps;
    unsigned code;
    __device__ __forceinline__ bool run(const f32x4 (&v)[2][2][4][2], const Unit& u, int wr, int wc, int fr, int fq, PG8_LAS unsigned char* lds, int wid, int lane) const {
        typedef float f32x2v __attribute__((ext_vector_type(2)));
        PG8_LAS f32x2v* P = (PG8_LAS f32x2v*)lds;
        PG8_LAS f32x2v* S = (PG8_LAS f32x2v*)(lds + 8192);
        PG8_LAS unsigned* flag = (PG8_LAS unsigned*)(lds + 8192 + 2048);
#pragma unroll
        for (int ai = 0; ai < 2; ++ai)
#pragma unroll
            for (int m = 0; m < 4; ++m) {
                float s = 0.f;
#pragma unroll
                for (int bj = 0; bj < 2; ++bj)
#pragma unroll
                    for (int n = 0; n < 2; ++n) { const f32x4 x = v[ai][bj][m][n]; s += (x[0] + x[1]) + (x[2] + x[3]); }
                s += __shfl_xor(s, 16); s += __shfl_xor(s, 32);
                const float mw = s * (1.0f / 64.0f); float q = 0.f;
#pragma unroll
                for (int bj = 0; bj < 2; ++bj)
#pragma unroll
                    for (int n = 0; n < 2; ++n) { const f32x4 d = v[ai][bj][m][n] - mw; q += (d[0] * d[0] + d[1] * d[1]) + (d[2] * d[2] + d[3] * d[3]); }
                q += __shfl_xor(q, 16); q += __shfl_xor(q, 32);
                if (fq == 0) P[(ai * HALF + wr * 64 + m * 16 + fr) * 4 + wc] = (f32x2v){mw, q};
            }
        asm volatile("s_waitcnt lgkmcnt(0)" ::: "memory"); __builtin_amdgcn_s_barrier(); asm volatile("" ::: "memory");
#if defined(BROKEN_EXCHANGE_NO_WAIT)
#warning BROKEN CONTROL BUILD: the row-statistics exchange does not wait; results are wrong by design
        if (blockIdx.x >= 64) { const long long t0_ = clock64(); while (clock64() - t0_ < 60000) __builtin_amdgcn_s_sleep(8); }
#endif
        const int row = wid * 32 + (lane & 31);
        if (lane < 32) {
            const f32x2v a = P[row * 4 + 0], b = P[row * 4 + 1], c = P[row * 4 + 2], d = P[row * 4 + 3];
            const float mt = (a.x + b.x + c.x + d.x) * 0.25f;
            const float da = a.x - mt, db = b.x - mt, dc = c.x - mt, dd = d.x - mt;
            const float m2 = (a.y + b.y) + (c.y + d.y) + 64.0f * ((da * da + db * db) + (dc * dc + dd * dd));
            unsigned long long* slot = (unsigned long long*)xbuf + ((size_t)(u.pm * BM + row) * 4 + u.pn);
            __hip_atomic_store(slot, ((unsigned long long)__float_as_uint(m2) << 32) | __float_as_uint(mt), __ATOMIC_RELAXED, __HIP_MEMORY_SCOPE_AGENT);
        }
        asm volatile("s_waitcnt vmcnt(0)" ::: "memory");
        if (lane == 0) __hip_atomic_fetch_add(cnt + 64 * u.pm, 1u, __ATOMIC_RELAXED, __HIP_MEMORY_SCOPE_AGENT);
        if (wid == 0) {
            bool dead = false; const unsigned long long t0 = __builtin_amdgcn_s_memrealtime(); const unsigned want = 8u * (unsigned)ntn;
            for (;;) {
#if defined(BROKEN_EXCHANGE_NO_WAIT)
                break;
#endif
                if ((unsigned)__builtin_amdgcn_readfirstlane(__hip_atomic_load(cnt + 64 * u.pm, __ATOMIC_RELAXED, __HIP_MEMORY_SCOPE_AGENT)) >= want) break;
                if (__builtin_amdgcn_s_memrealtime() - t0 > 2000000ull) {
                    if (lane == 0) { unsigned expect = 0u; __hip_atomic_compare_exchange_strong(tmo + 1, &expect, code | (unsigned)(u.pm & 0xff), __ATOMIC_RELAXED, __ATOMIC_RELAXED, __HIP_MEMORY_SCOPE_AGENT);
                                     __hip_atomic_store(tmo, 1u, __ATOMIC_RELAXED, __HIP_MEMORY_SCOPE_AGENT); }
                    dead = true; break; }
                __builtin_amdgcn_s_sleep(2);
            }
            __builtin_amdgcn_fence(__ATOMIC_ACQUIRE, "agent");
            if (lane == 0) flag[0] = dead ? 1u : 0u;
        }
        asm volatile("s_waitcnt vmcnt(0) lgkmcnt(0)" ::: "memory"); __builtin_amdgcn_s_barrier(); asm volatile("" ::: "memory");
        const bool bad = flag[0] != 0u;
        if (lane < 32) {
            const unsigned long long* slot = (const unsigned long long*)xbuf + (size_t)(u.pm * BM + row) * 4; float mt[4], m2[4]; float ms = 0.f;
#pragma unroll
            for (int t = 0; t < 4; ++t) { if (t < ntn) { const unsigned long long w = __hip_atomic_load(slot + t, __ATOMIC_RELAXED, __HIP_MEMORY_SCOPE_AGENT); mt[t] = __uint_as_float((unsigned)w); m2[t] = __uint_as_float((unsigned)(w >> 32)); } else { mt[t] = 0.f; m2[t] = 0.f; } ms += mt[t]; }
            const float mean = ms / (float)ntn; float q = 0.f;
#pragma unroll
            for (int t = 0; t < 4; ++t) if (t < ntn) { const float dm = mt[t] - mean; q += m2[t] + 256.0f * dm * dm; }
            S[row] = (f32x2v){mean, 1.0f / sqrtf(q / (256.0f * (float)ntn) + eps)};
        }
        asm volatile("s_waitcnt lgkmcnt(0)" ::: "memory"); __builtin_amdgcn_s_barrier(); asm volatile("" ::: "memory");
        return bad;
    }
};
struct EpiLnRes {
    static constexpr bool PERM = false, AFTER_DRAIN = true;
    const float* base; float* out; int ldc; const float* bias; PanelStats st; unsigned poison;
    __device__ __forceinline__ void fused(f32x4 (&acc)[2][2][4][2], const Unit& u, int wr, int wc, int fr, int fq, PG8_LAS unsigned char* lds, int wid, int lane) const {
        typedef float f32x2v __attribute__((ext_vector_type(2)));
        const PG8_LAS f32x2v* S = (const PG8_LAS f32x2v*)(lds + 8192);
        const int col0 = u.pn * BM + wc * 32 + 4 * fq;
#pragma unroll
        for (int bj = 0; bj < 2; ++bj)
#pragma unroll
            for (int n = 0; n < 2; ++n) { const f32x4 bv = bias ? *(const f32x4*)(bias + col0 + bj * HALF + n * 16) : (f32x4){0.f, 0.f, 0.f, 0.f};
#pragma unroll
                for (int ai = 0; ai < 2; ++ai)
#pragma unroll
                    for (int m = 0; m < 4; ++m) acc[ai][bj][m][n] += bv; }
        f32x4 pre[4][2][2];
#pragma unroll
        for (int m = 0; m < 4; ++m) { const size_t off = (size_t)(u.pm * BM + wr * 64 + m * 16 + fr) * ldc + col0;
#pragma unroll
            for (int bj = 0; bj < 2; ++bj)
#pragma unroll
                for (int n = 0; n < 2; ++n) pre[m][bj][n] = *(const f32x4*)(base + off + bj * HALF + n * 16); }
        const bool bad = st.run(acc, u, wr, wc, fr, fq, lds, wid, lane) || poison != 0u;
        const float qnan = __builtin_nanf("");
#pragma unroll
        for (int ai = 0; ai < 2; ++ai)
#pragma unroll
            for (int m = 0; m < 4; ++m) { const int r = ai * HALF + wr * 64 + m * 16 + fr; const f32x2v sr = S[r]; const size_t off = (size_t)(u.pm * BM + r) * ldc + col0;
#pragma unroll
                for (int bj = 0; bj < 2; ++bj)
#pragma unroll
                    for (int n = 0; n < 2; ++n) { const f32x4 bs = ai == 0 ? pre[m][bj][n] : *(const f32x4*)(base + off + bj * HALF + n * 16); f32x4 o = bs + (acc[ai][bj][m][n] - sr.x) * sr.y;
                        if (bad) o = (f32x4){qnan, qnan, qnan, qnan}; *(f32x4*)(out + off + bj * HALF + n * 16) = o; }
                if (m & 1) asm volatile("" ::: "memory"); }
    }
};
struct EpiLnResLn {
    static constexpr bool PERM = false, AFTER_DRAIN = true;
    const float* base; float* out; bf16_t* xn; int ldc; const float* bias; PanelStats st1, st2; unsigned poison;
    __device__ __forceinline__ void fused(f32x4 (&acc)[2][2][4][2], const Unit& u, int wr, int wc, int fr, int fq, PG8_LAS unsigned char* lds, int wid, int lane) const {
        typedef float f32x2v __attribute__((ext_vector_type(2))); typedef unsigned u32x2v __attribute__((ext_vector_type(2)));
        const PG8_LAS f32x2v* S = (const PG8_LAS f32x2v*)(lds + 8192);
        const int col0 = u.pn * BM + wc * 32 + 4 * fq;
#pragma unroll
        for (int bj = 0; bj < 2; ++bj)
#pragma unroll
            for (int n = 0; n < 2; ++n) { const f32x4 bv = bias ? *(const f32x4*)(bias + col0 + bj * HALF + n * 16) : (f32x4){0.f, 0.f, 0.f, 0.f};
#pragma unroll
                for (int ai = 0; ai < 2; ++ai)
#pragma unroll
                    for (int m = 0; m < 4; ++m) acc[ai][bj][m][n] += bv; }
        bool bad = st1.run(acc, u, wr, wc, fr, fq, lds, wid, lane) || poison != 0u;
        const float qnan = __builtin_nanf("");
#pragma unroll
        for (int ai = 0; ai < 2; ++ai)
#pragma unroll
            for (int m = 0; m < 4; ++m) { const int r = ai * HALF + wr * 64 + m * 16 + fr; const f32x2v sr = S[r]; const size_t off = (size_t)(u.pm * BM + r) * ldc + col0;
#pragma unroll
                for (int bj = 0; bj < 2; ++bj)
#pragma unroll
                    for (int n = 0; n < 2; ++n) { const f32x4 bs = *(const f32x4*)(base + off + bj * HALF + n * 16); acc[ai][bj][m][n] = bs + (acc[ai][bj][m][n] - sr.x) * sr.y; }
                asm volatile("" : "+v"(acc[ai][0][m][0]), "+v"(acc[ai][0][m][1]), "+v"(acc[ai][1][m][0]), "+v"(acc[ai][1][m][1]));
                if (m & 1) asm volatile("" ::: "memory"); }
        const bool bad1 = bad;
        bad = st2.run(acc, u, wr, wc, fr, fq, lds, wid, lane) || bad;
#pragma unroll
        for (int ai = 0; ai < 2; ++ai)
#pragma unroll
            for (int m = 0; m < 4; ++m) { const int r = ai * HALF + wr * 64 + m * 16 + fr; const f32x2v sr = S[r]; const size_t off = (size_t)(u.pm * BM + r) * ldc + col0;
#pragma unroll
                for (int bj = 0; bj < 2; ++bj)
#pragma unroll
                    for (int n = 0; n < 2; ++n) { const f32x4 x1 = acc[ai][bj][m][n]; *(f32x4*)(out + off + bj * HALF + n * 16) = bad1 ? (f32x4){qnan, qnan, qnan, qnan} : x1;
                        const f32x4 o = (x1 - sr.x) * sr.y; u32x2v w; w.x = cvt_pk_bf16(o[0], o[1]); w.y = cvt_pk_bf16(o[2], o[3]);
                        if (bad) { w.x = 0x7fc07fc0u; w.y = 0x7fc07fc0u; } *(u32x2v*)(xn + off + bj * HALF + n * 16) = w; }
                asm volatile("" ::: "memory"); }
    }
};

template <class Epi, class Sched, bool ALIGN_EPI = false, bool SP2 = false>
__device__ __forceinline__ void gemm_phase(PG8_LAS unsigned char* lds, const Gemm g, const Sched& S, const Epi& E) {
    const int tid = threadIdx.x, wid = __builtin_amdgcn_readfirstlane(tid >> 6), lane = tid & 63, wr = wid >> 2, wc = wid & 3, fr = lane & 15, fq = lane >> 4;
    const int K = g.K, nt = K / BK;
    unsigned voffA[2], voffB[2];
#pragma unroll
    for (int i = 0; i < 2; ++i) { int R, C; stage_rc(tid * 16 + i * 8192, R, C); const int Rb = Epi::PERM ? ((R & ~31) + perm32(R & 31)) : R;
        voffA[i] = (unsigned)(R * K + C) * 2u; voffB[i] = (unsigned)(Rb * K + C) * 2u; }
    const size_t kstep = (size_t)(BK * 2);
    const size_t hstep = (size_t)HALF * K * 2;
    const size_t tstep = 2 * hstep;
    const unsigned ldsw = (unsigned)wid * 1024u;
    const int aoff = lds_byte(wr * 64 + fr, fq * 8), boff = lds_byte(wc * 32 + fr, fq * 8);
#define PG8_SA(b, h) (((b) * 2 + (h)) * HTB)
#define PG8_SB(b, h) ((4 + (b) * 2 + (h)) * HTB)
#define PG8_STAGE(bufoff, gbase, voff) do { _Pragma("unroll") for (int _i = 0; _i < 2; ++_i) \
        __builtin_amdgcn_global_load_lds((const unsigned*)((const char*)(gbase) + (voff)[_i]), (PG8_LAS unsigned*)(lds + (bufoff) + ldsw + _i * 8192), 16, 0, 0); } while (0)
#define PG8_LDA(dst, b, h) do { _Pragma("unroll") for (int m = 0; m < 4; ++m) _Pragma("unroll") for (int k = 0; k < 2; ++k) dst[m][k] = *(const PG8_LAS bf16x8*)(lds + PG8_SA(b, h) + aoff + m * 2048 + k * 1024); } while (0)
#define PG8_LDB(dst, b, h) do { _Pragma("unroll") for (int n = 0; n < 2; ++n) _Pragma("unroll") for (int k = 0; k < 2; ++k) dst[n][k] = *(const PG8_LAS bf16x8*)(lds + PG8_SB(b, h) + boff + n * 2048 + k * 1024); } while (0)
#define PG8_MMA(ai, bj, At, Bt) do { __builtin_amdgcn_s_setprio(1); _Pragma("unroll") for (int m = 0; m < 4; ++m) _Pragma("unroll") for (int n = 0; n < 2; ++n) _Pragma("unroll") for (int k = 0; k < 2; ++k) \
        acc[ai][bj][m][n] = __builtin_amdgcn_mfma_f32_16x16x32_bf16(Bt[n][k], At[m][k], acc[ai][bj][m][n], 0, 0, 0); __builtin_amdgcn_s_setprio(0); } while (0)
#define PG8_WAIT_V(n) asm volatile("s_waitcnt vmcnt(" #n ")" ::: "memory")
#define PG8_WAIT_L(n) asm volatile("s_waitcnt lgkmcnt(" #n ")" ::: "memory")
#define PG8_BAR __builtin_amdgcn_s_barrier()
#define PG8_SCHED __builtin_amdgcn_sched_barrier(0)
    Unit cur, nxt; int ui = 0;
    if (!S.next(0, cur)) return;
    f32x4 acc[2][2][4][2];
#pragma unroll
    for (int a = 0; a < 2; ++a)
#pragma unroll
        for (int b = 0; b < 2; ++b)
#pragma unroll
            for (int m = 0; m < 4; ++m)
#pragma unroll
                for (int n = 0; n < 2; ++n) acc[a][b][m][n] = (f32x4){0.f, 0.f, 0.f, 0.f};
    bf16x8 At[4][2], B0[2][2], B1[2][2];
    const char* cA = (const char*)g.A + (size_t)cur.pm * tstep; const char* cB = (const char*)g.Bt + (size_t)cur.pn * tstep;
    S.a_ready(cur);
    if constexpr (SP2) {
        PG8_STAGE(PG8_SB(0, 0), cB, voffB); PG8_STAGE(PG8_SB(0, 1), cB + hstep, voffB); PG8_STAGE(PG8_SA(0, 0), cA, voffA); PG8_STAGE(PG8_SA(0, 1), cA + hstep, voffA);
        if (wr == 1) PG8_BAR;
        PG8_WAIT_V(2); PG8_BAR;
        PG8_STAGE(PG8_SB(1, 0), cB + kstep, voffB); PG8_STAGE(PG8_SA(1, 0), cA + kstep, voffA); PG8_STAGE(PG8_SB(1, 1), cB + hstep + kstep, voffB);
        PG8_WAIT_V(6); PG8_BAR;
    } else {
        PG8_STAGE(PG8_SB(0, 0), cB, voffB); PG8_STAGE(PG8_SA(0, 0), cA, voffA); PG8_STAGE(PG8_SB(0, 1), cB + hstep, voffB); PG8_STAGE(PG8_SA(0, 1), cA + hstep, voffA);
        if (wr == 1) PG8_BAR;
        PG8_WAIT_V(4); PG8_BAR;
        PG8_STAGE(PG8_SB(1, 0), cB + kstep, voffB); PG8_STAGE(PG8_SA(1, 0), cA + kstep, voffA); PG8_STAGE(PG8_SB(1, 1), cB + hstep + kstep, voffB);
        PG8_WAIT_V(6); PG8_BAR;
    }
    for (;;) {
        const bool has_next = S.next(ui + 1, nxt);
        const char* nA = has_next ? (const char*)g.A + (size_t)nxt.pm * tstep : cA; const char* nB = has_next ? (const char*)g.Bt + (size_t)nxt.pn * tstep : cB;
        for (int t = 0; t < nt; t += 2) {
            const bool last = (t == nt - 2);
            const char* a1 = cA + (size_t)(t + 1) * kstep;
            const char* a2 = last ? nA : cA + (size_t)(t + 2) * kstep; const char* b2 = last ? nB : cB + (size_t)(t + 2) * kstep;
            const char* a3 = a2 + kstep; const char* b3 = b2 + kstep;
            if (last && has_next) S.a_ready(nxt);
            if constexpr (SP2) {
            PG8_LDB(B0, 0, 0); PG8_LDB(B1, 0, 1); PG8_SCHED; PG8_LDA(At, 0, 0); PG8_STAGE(PG8_SA(1, 1), a1 + hstep, voffA);
            PG8_WAIT_V(8); PG8_WAIT_L(0); PG8_BAR; PG8_MMA(0, 0, At, B0); PG8_MMA(0, 1, At, B1); PG8_BAR; PG8_SCHED;
            PG8_LDA(At, 0, 1); PG8_STAGE(PG8_SB(0, 0), b2, voffB); PG8_STAGE(PG8_SB(0, 1), b2 + hstep, voffB); PG8_STAGE(PG8_SA(0, 0), a2, voffA);
            PG8_WAIT_V(8); PG8_WAIT_L(0); PG8_BAR; PG8_MMA(1, 0, At, B0); PG8_MMA(1, 1, At, B1); PG8_BAR; PG8_SCHED;
            PG8_LDB(B0, 1, 0); PG8_LDB(B1, 1, 1); PG8_SCHED; PG8_LDA(At, 1, 0); PG8_STAGE(PG8_SA(0, 1), a2 + hstep, voffA);
            PG8_WAIT_V(8); PG8_WAIT_L(0); PG8_BAR; PG8_MMA(0, 0, At, B0); PG8_MMA(0, 1, At, B1); PG8_BAR; PG8_SCHED;
            PG8_LDA(At, 1, 1); PG8_STAGE(PG8_SB(1, 0), b3, voffB); PG8_STAGE(PG8_SB(1, 1), b3 + hstep, voffB); PG8_STAGE(PG8_SA(1, 0), a3, voffA);
            PG8_WAIT_V(8); PG8_WAIT_L(0); PG8_BAR; PG8_MMA(1, 0, At, B0); PG8_MMA(1, 1, At, B1); PG8_BAR; PG8_SCHED;
            } else {
            PG8_LDB(B0, 0, 0); PG8_SCHED; PG8_LDA(At, 0, 0); PG8_STAGE(PG8_SA(1, 1), a1 + hstep, voffA);
            PG8_WAIT_L(8); PG8_BAR; PG8_WAIT_L(0); PG8_MMA(0, 0, At, B0); PG8_BAR; PG8_SCHED;
            PG8_LDB(B1, 0, 1); PG8_STAGE(PG8_SB(0, 0), b2, voffB);
            PG8_BAR; PG8_WAIT_L(0); PG8_MMA(0, 1, At, B1); PG8_BAR;
            PG8_LDA(At, 0, 1); PG8_STAGE(PG8_SA(0, 0), a2, voffA);
            PG8_BAR; PG8_WAIT_L(0); PG8_MMA(1, 0, At, B0); PG8_BAR; PG8_SCHED;
            PG8_STAGE(PG8_SB(0, 1), b2 + hstep, voffB);
            PG8_WAIT_V(6); PG8_BAR; PG8_MMA(1, 1, At, B1); PG8_BAR;
            PG8_LDB(B0, 1, 0); PG8_SCHED; PG8_LDA(At, 1, 0); PG8_STAGE(PG8_SA(0, 1), a2 + hstep, voffA);
            PG8_WAIT_L(8); PG8_BAR; PG8_WAIT_L(0); PG8_MMA(0, 0, At, B0); PG8_BAR; PG8_SCHED;
            PG8_LDB(B1, 1, 1); PG8_STAGE(PG8_SB(1, 0), b3, voffB);
            PG8_BAR; PG8_WAIT_L(0); PG8_MMA(0, 1, At, B1); PG8_BAR;
            PG8_LDA(At, 1, 1); PG8_STAGE(PG8_SA(1, 0), a3, voffA);
            PG8_BAR; PG8_WAIT_L(0); PG8_MMA(1, 0, At, B0); PG8_BAR; PG8_SCHED;
            PG8_STAGE(PG8_SB(1, 1), b3 + hstep, voffB);
            PG8_WAIT_V(6); PG8_BAR; PG8_MMA(1, 1, At, B1); PG8_BAR;
            }
        }
        if constexpr (ALIGN_EPI) { if (wr == 0) PG8_BAR; }
        if constexpr (!Epi::AFTER_DRAIN) { E(acc, cur, wr, wc, fr, fq); S.done(cur); }
        if (!has_next) break;
#pragma unroll
        for (int a = 0; a < 2; ++a)
#pragma unroll
            for (int b = 0; b < 2; ++b)
#pragma unroll
                for (int m = 0; m < 4; ++m)
#pragma unroll
                    for (int n = 0; n < 2; ++n) acc[a][b][m][n] = (f32x4){0.f, 0.f, 0.f, 0.f};
        cur = nxt; cA = nA; cB = nB; ++ui;
        if constexpr (ALIGN_EPI) { if (wr == 1) PG8_BAR; }
    }
    PG8_WAIT_V(0);
    if constexpr (!ALIGN_EPI) { if (wr == 0) PG8_BAR; }
    PG8_BAR;
    if constexpr (Epi::AFTER_DRAIN) { E.fused(acc, cur, wr, wc, fr, fq, lds, wid, lane); S.done(cur); }
#undef PG8_SA
#undef PG8_SB
#undef PG8_STAGE
#undef PG8_LDA
#undef PG8_LDB
#undef PG8_MMA
#undef PG8_WAIT_V
#undef PG8_WAIT_L
#undef PG8_BAR
#undef PG8_SCHED
}
}

constexpr int NB = 8, S = 8192, M = NB * S, D = 1024, FF = 4096, NMEMT = 256;
constexpr int NDIFF = 2560, NDSA_L = 1736, NDSA = 1792;
constexpr float EPS = 1e-6f;
constexpr float C2 = 0.125f * 1.4426950408889634f;
constexpr int DQ = 0, DK = 768, DV = 832, DIQ = 896, DIK = 1408, DIW = 1472, DQM = 1480;

typedef unsigned short bf16_t;
typedef unsigned u32x4 __attribute__((ext_vector_type(4)));
typedef float f32x4 __attribute__((ext_vector_type(4)));

constexpr size_t MiB = 1u << 20;
constexpr size_t WS_CTL = 0;
constexpr size_t WS_WIN0 = 1 * MiB, WS_WIN1 = 6 * MiB, WS_WOUT = 10 * MiB, WS_WUP = 14 * MiB, WS_WDN = 30 * MiB, WS_WKV = 46 * MiB;
constexpr size_t WS_MEMN = 48 * MiB, WS_MEMKV = 56 * MiB, WS_ROPE = 60 * MiB, WS_TOPK = 76 * MiB;
constexpr size_t WS_H = 108 * MiB, WS_PROJ = 236 * MiB, WS_O = 556 * MiB, WS_HID = 236 * MiB, WS_Y = 748 * MiB, WS_END = 1004 * MiB;

__device__ __forceinline__ float bf2f(bf16_t v) { return __uint_as_float((unsigned)v << 16); }
__device__ __forceinline__ unsigned f2bf(float f) { unsigned u = __float_as_uint(f); return (u + 0x7fffu + ((u >> 16) & 1u)) >> 16; }
__device__ __forceinline__ unsigned pk2(float lo, float hi) { return f2bf(lo) | (f2bf(hi) << 16); }
__device__ __forceinline__ float wave_sum(float v) {
#pragma unroll
    for (int o = 1; o < 64; o <<= 1) v += __shfl_xor(v, o);
    return v;
}

template <int ACT> struct EpiB {
    static constexpr bool PERM = true, AFTER_DRAIN = false;
    bf16_t* O; int ldc;
    __device__ __forceinline__ void operator()(const pg8::f32x4 (&acc)[2][2][4][2], const pg8::Unit& u, int wr, int wc, int fr, int fq) const {
        const int row0 = u.pm * 256 + wr * 64 + fr, col0 = u.pn * 256 + wc * 32 + 8 * fq;
#pragma unroll
        for (int ai = 0; ai < 2; ++ai)
#pragma unroll
            for (int m = 0; m < 4; ++m) { bf16_t* rowp = O + (size_t)(row0 + ai * 128 + m * 16) * ldc + col0;
#pragma unroll
                for (int bj = 0; bj < 2; ++bj) { pg8::f32x4 v0 = acc[ai][bj][m][0], v1 = acc[ai][bj][m][1];
                    if (ACT == 2) {
#pragma unroll
                        for (int e = 0; e < 4; ++e) { float a = fmaxf(v0[e], 0.f); v0[e] = a * a; float b = fmaxf(v1[e], 0.f); v1[e] = b * b; } }
                    u32x4 w; w.x = pg8::cvt_pk_bf16(v0[0], v0[1]); w.y = pg8::cvt_pk_bf16(v0[2], v0[3]); w.z = pg8::cvt_pk_bf16(v1[0], v1[1]); w.w = pg8::cvt_pk_bf16(v1[2], v1[3]);
                    *(u32x4*)(rowp + bj * 128) = w; } }
    }
};
struct EpiF {
    static constexpr bool PERM = false, AFTER_DRAIN = false;
    float* C; int ldc;
    __device__ __forceinline__ void operator()(const pg8::f32x4 (&acc)[2][2][4][2], const pg8::Unit& u, int wr, int wc, int fr, int fq) const {
        const int row0 = u.pm * 256 + wr * 64 + fr, col0 = u.pn * 256 + wc * 32 + 4 * fq;
#pragma unroll
        for (int ai = 0; ai < 2; ++ai)
#pragma unroll
            for (int m = 0; m < 4; ++m) { float* rowp = C + (size_t)(row0 + ai * 128 + m * 16) * ldc + col0;
#pragma unroll
                for (int bj = 0; bj < 2; ++bj)
#pragma unroll
                    for (int n = 0; n < 2; ++n) *(pg8::f32x4*)(rowp + bj * 128 + n * 16) = acc[ai][bj][m][n]; }
    }
};

struct GemmArgs { const bf16_t* A; const bf16_t* Bt; void* out; int Mr, N, K, ldc; };
template <int MODE> __global__ void __launch_bounds__(512, 2) k_gemm(GemmArgs a) {
    extern __shared__ __attribute__((aligned(16))) unsigned char lds[];
    pg8::Gemm g{a.A, a.Bt, a.Mr, a.N, a.K};
    pg8::StaticOrder So; So.init(a.Mr, a.N, (int)gridDim.x, (int)blockIdx.x);
    if constexpr (MODE == 0) { EpiB<0> E{(bf16_t*)a.out, a.ldc}; pg8::gemm_phase<EpiB<0>, pg8::StaticOrder, true, true>((PG8_LAS unsigned char*)lds, g, So, E); }
    else if constexpr (MODE == 2) { EpiB<2> E{(bf16_t*)a.out, a.ldc}; pg8::gemm_phase<EpiB<2>, pg8::StaticOrder, true, true>((PG8_LAS unsigned char*)lds, g, So, E); }
    else { EpiF E{(float*)a.out, a.ldc}; pg8::gemm_phase<EpiF, pg8::StaticOrder, true, true>((PG8_LAS unsigned char*)lds, g, So, E); }
}

__global__ void __launch_bounds__(256) k_prep_w(const float* __restrict__ W, int K, int N, bf16_t* __restrict__ Wt, int Nout) {
    __shared__ float tile[32][33];
    const int nbp = Nout / 32; const int p0 = (blockIdx.x % nbp) * 32, k0 = (blockIdx.x / nbp) * 32;
    const int tx = threadIdx.x & 31, ty = threadIdx.x >> 5;
#pragma unroll
    for (int i = 0; i < 4; ++i) { const int kk = ty + 8 * i; const int p = p0 + tx; tile[kk][tx] = (p < N) ? W[(size_t)(k0 + kk) * N + p] : 0.f; }
    __syncthreads();
#pragma unroll
    for (int i = 0; i < 4; ++i) { const int pp = ty + 8 * i; Wt[(size_t)(p0 + pp) * K + k0 + tx] = (bf16_t)f2bf(tile[tx][pp]); }
}
__global__ void __launch_bounds__(256) k_rope_tab(const int* __restrict__ pos, float2* __restrict__ tab) {
    const int idx = blockIdx.x * 256 + threadIdx.x; if (idx >= M * 32) return;
    const int m = idx >> 5, i = idx & 31;
    const double inv = pow(10000.0, -(double)i / 32.0); const double ang = (double)pos[m] * inv;
    tab[idx] = make_float2((float)cos(ang), (float)sin(ang));
}
__global__ void __launch_bounds__(256) k_rmsnorm(const float* __restrict__ x, const float* __restrict__ g, bf16_t* __restrict__ out, int nrows) {
    const int lane = threadIdx.x & 63; const int row = blockIdx.x * 4 + (threadIdx.x >> 6); if (row >= nrows) return;
    const f32x4* xr = (const f32x4*)(x + (size_t)row * D) + lane; const f32x4* gr = (const f32x4*)g + lane;
    f32x4 v[4]; float s = 0.f;
#pragma unroll
    for (int j = 0; j < 4; ++j) { v[j] = xr[64 * j]; s += (v[j].x * v[j].x + v[j].y * v[j].y) + (v[j].z * v[j].z + v[j].w * v[j].w); }
    const float rstd = 1.f / sqrtf(wave_sum(s) * (1.f / D) + EPS);
    unsigned long long* o8 = (unsigned long long*)(out + (size_t)row * D) + lane;
#pragma unroll
    for (int j = 0; j < 4; ++j) { const f32x4 gg = gr[64 * j];
        o8[64 * j] = (unsigned long long)pk2(v[j].x * rstd * gg.x, v[j].y * rstd * gg.y) | ((unsigned long long)pk2(v[j].z * rstd * gg.z, v[j].w * rstd * gg.w) << 32); }
}
__global__ void __launch_bounds__(256) k_norm_res(const float* __restrict__ y, const float* xin, const float* __restrict__ g1, float* xout, const float* __restrict__ g2, bf16_t* __restrict__ h) {
    const int lane = threadIdx.x & 63; const int row = blockIdx.x * 4 + (threadIdx.x >> 6);
    const f32x4* yr = (const f32x4*)(y + (size_t)row * D) + lane; const f32x4* xr = (const f32x4*)(xin + (size_t)row * D) + lane;
    f32x4 v[4], xv[4]; float s = 0.f;
#pragma unroll
    for (int j = 0; j < 4; ++j) { v[j] = yr[64 * j]; xv[j] = xr[64 * j]; s += (v[j].x * v[j].x + v[j].y * v[j].y) + (v[j].z * v[j].z + v[j].w * v[j].w); }
    const float rstd = 1.f / sqrtf(wave_sum(s) * (1.f / D) + EPS);
    float s2 = 0.f;
#pragma unroll
    for (int j = 0; j < 4; ++j) { const f32x4 gg = ((const f32x4*)g1 + lane)[64 * j]; xv[j] = xv[j] + v[j] * rstd * gg;
        s2 += (xv[j].x * xv[j].x + xv[j].y * xv[j].y) + (xv[j].z * xv[j].z + xv[j].w * xv[j].w);
        ((f32x4*)(xout + (size_t)row * D) + lane)[64 * j] = xv[j]; }
    if (g2) {
        const float r2 = 1.f / sqrtf(wave_sum(s2) * (1.f / D) + EPS);
        unsigned long long* o8 = (unsigned long long*)(h + (size_t)row * D) + lane;
#pragma unroll
        for (int j = 0; j < 4; ++j) { const f32x4 gg = ((const f32x4*)g2 + lane)[64 * j];
            o8[64 * j] = (unsigned long long)pk2(xv[j].x * r2 * gg.x, xv[j].y * r2 * gg.y) | ((unsigned long long)pk2(xv[j].z * r2 * gg.z, xv[j].w * r2 * gg.w) << 32); }
    }
}
__global__ void __launch_bounds__(256) k_rope(bf16_t* buf, int ld, const float2* __restrict__ tab, int mode, int nheads) {
    const size_t idx = (size_t)blockIdx.x * 256 + threadIdx.x; const size_t tot = (size_t)M * nheads * 32; if (idx >= tot) return;
    const int i = (int)(idx & 31); const size_t r = idx >> 5; const int hs = (int)(r % nheads); const size_t m = r / nheads;
    int col0;
    if (mode == 0) col0 = 64 * hs; else col0 = (hs < 12) ? 64 * hs : (hs == 12) ? DK : (hs < 21) ? DIQ + 64 * (hs - 13) : DIK;
    bf16_t* p = buf + m * ld + col0 + i; const float2 cs = tab[m * 32 + i];
    const float x1 = bf2f(p[0]), x2 = bf2f(p[32]);
    p[0] = (bf16_t)f2bf(x1 * cs.x - x2 * cs.y); p[32] = (bf16_t)f2bf(x2 * cs.x + x1 * cs.y);
}

__global__ void __launch_bounds__(256) k_attn_diff_naive(const bf16_t* __restrict__ proj, bf16_t* __restrict__ o, const float* __restrict__ lq1, const float* __restrict__ lk1,
                                                          const float* __restrict__ lq2, const float* __restrict__ lk2, const float* __restrict__ gsub) {
    const int blk = blockIdx.x; const int c = blk % (S / 64), h = (blk / (S / 64)) % 6, b = blk / ((S / 64) * 6);
    const int tid = threadIdx.x, t = c * 64 + (tid >> 2), dq = tid & 3;
    const bf16_t* base = proj + (size_t)b * S * NDIFF;
    float a1 = 0.f, a2 = 0.f;
    for (int i = 0; i < 64; ++i) { a1 += lq1[i] * lk1[i]; a2 += lq2[i] * lk2[i]; }
    const float lam = expf(a1) - expf(a2) + 0.2f;
    const int nk = 64 * (c + 1);
    float res[32];
#pragma unroll
    for (int br = 0; br < 2; ++br) {
        float q[64];
        const bf16_t* qp = base + (size_t)t * NDIFF + (2 * h + br) * 64;
#pragma unroll
        for (int d = 0; d < 64; ++d) q[d] = bf2f(qp[d]) * C2;
        float acc[32];
#pragma unroll
        for (int i = 0; i < 32; ++i) acc[i] = 0.f;
        float mx = -INFINITY, l = 0.f;
        for (int j = 0; j < nk; ++j) {
            const bf16_t* kp = base + (size_t)j * NDIFF + 768 + (2 * h + br) * 64;
            const bf16_t* vp = base + (size_t)j * NDIFF + 1536 + h * 128 + dq * 32;
            float s = 0.f;
#pragma unroll
            for (int d = 0; d < 64; ++d) s += q[d] * bf2f(kp[d]);
            const float mn = fmaxf(mx, s); const float f = exp2f(mx - mn), p = exp2f(s - mn);
            l = l * f + p; mx = mn;
#pragma unroll
            for (int i = 0; i < 32; ++i) acc[i] = acc[i] * f + p * bf2f(vp[i]);
        }
        const float il = 1.f / l;
        if (br == 0) {
#pragma unroll
            for (int i = 0; i < 32; ++i) res[i] = acc[i] * il;
        } else {
#pragma unroll
            for (int i = 0; i < 32; ++i) res[i] -= lam * acc[i] * il;
        }
    }
    float ss = 0.f;
#pragma unroll
    for (int i = 0; i < 32; ++i) ss += res[i] * res[i];
    ss += __shfl_xor(ss, 1); ss += __shfl_xor(ss, 2);
    const float rstd = 1.f / sqrtf(ss * (1.f / 128.f) + EPS);
    bf16_t* op = o + (size_t)(b * S + t) * D + h * 128 + dq * 32;
#pragma unroll
    for (int i = 0; i < 32; ++i) op[i] = (bf16_t)f2bf(res[i] * rstd * gsub[dq * 32 + i] * 0.8f);
}
__global__ void __launch_bounds__(256) k_attn_mem_naive(const bf16_t* __restrict__ qbuf, int ld, int qcol0, const bf16_t* __restrict__ kv, bf16_t* __restrict__ o) {
    const int blk = blockIdx.x; const int c = blk % (S / 64), h = (blk / (S / 64)) % 4, b = blk / ((S / 64) * 4);
    const int tid = threadIdx.x, t = c * 64 + (tid >> 2), dq = tid & 3;
    float q[64];
    const bf16_t* qp = qbuf + (size_t)(b * S + t) * ld + qcol0 + h * 64;
#pragma unroll
    for (int d = 0; d < 64; ++d) q[d] = bf2f(qp[d]) * C2;
    float acc[16];
#pragma unroll
    for (int i = 0; i < 16; ++i) acc[i] = 0.f;
    float mx = -INFINITY, l = 0.f;
    for (int j = 0; j < NMEMT; ++j) {
        const bf16_t* kp = kv + (size_t)(b * NMEMT + j) * 512 + h * 64;
        const bf16_t* vp = kv + (size_t)(b * NMEMT + j) * 512 + 256 + h * 64 + dq * 16;
        float s = 0.f;
#pragma unroll
        for (int d = 0; d < 64; ++d) s += q[d] * bf2f(kp[d]);
        const float mn = fmaxf(mx, s); const float f = exp2f(mx - mn), p = exp2f(s - mn);
        l = l * f + p; mx = mn;
#pragma unroll
        for (int i = 0; i < 16; ++i) acc[i] = acc[i] * f + p * bf2f(vp[i]);
    }
    const float il = 1.f / l;
    bf16_t* op = o + (size_t)(b * S + t) * D + 768 + h * 64 + dq * 16;
#pragma unroll
    for (int i = 0; i < 16; ++i) op[i] = (bf16_t)f2bf(acc[i] * il);
}

__device__ __forceinline__ unsigned f2key(float f) { const unsigned u = __float_as_uint(f); return (u & 0x80000000u) ? ~u : (u | 0x80000000u); }
__global__ void __launch_bounds__(256) k_topk_naive(const bf16_t* __restrict__ proj, unsigned short* __restrict__ topk) {
    __shared__ unsigned keys[S];
    __shared__ float iqs[8][64];
    __shared__ float ws[8];
    __shared__ unsigned cnt_s; __shared__ unsigned scan_g[256], scan_e[256];
    const int m = blockIdx.x; const int b = m / S, t = m % S; const int c = t / 64; const int n = 64 * (c + 1);
    const int tid = threadIdx.x;
    unsigned short* out = topk + (size_t)m * 256;
    if (n <= 256) { out[tid] = (tid < n) ? (unsigned short)tid : (unsigned short)0xFFFFu; return; }
    const bf16_t* row = proj + (size_t)m * NDSA;
    for (int i = tid; i < 512; i += 256) iqs[i >> 6][i & 63] = bf2f(row[DIQ + i]);
    if (tid < 8) ws[tid] = bf2f(row[DIW + tid]) * 0.04419417382415922f;
    __syncthreads();
    for (int j = tid; j < n; j += 256) {
        const bf16_t* kp = proj + (size_t)(b * S + j) * NDSA + DIK;
        float kf[64];
#pragma unroll
        for (int d = 0; d < 64; ++d) kf[d] = bf2f(kp[d]);
        float sc = 0.f;
#pragma unroll
        for (int hh = 0; hh < 8; ++hh) { float lg = 0.f;
#pragma unroll
            for (int d = 0; d < 64; ++d) lg += iqs[hh][d] * kf[d];
            sc += fmaxf(lg, 0.f) * ws[hh]; }
        sc += 0.0f;
        keys[j] = f2key(sc);
    }
    __syncthreads();
    unsigned T = 0u;
    for (int bit = 31; bit >= 0; --bit) {
        const unsigned cand = T | (1u << bit);
        if (tid == 0) cnt_s = 0u;
        __syncthreads();
        unsigned c0 = 0u;
        for (int j = tid; j < n; j += 256) c0 += (keys[j] >= cand) ? 1u : 0u;
        c0 = (unsigned)wave_sum((float)c0);
        if ((tid & 63) == 0) atomicAdd(&cnt_s, c0);
        __syncthreads();
        if (cnt_s >= 256u) T = cand;
        __syncthreads();
    }
    const int per = (n + 255) / 256; const int j0 = tid * per, j1 = (j0 + per < n) ? j0 + per : n;
    unsigned g = 0u, e = 0u;
    for (int j = j0; j < j1; ++j) { const unsigned k = keys[j]; g += (k > T) ? 1u : 0u; e += (k == T) ? 1u : 0u; }
    scan_g[tid] = g; scan_e[tid] = e;
    __syncthreads();
    unsigned pg = 0u, pe = 0u, tg = 0u;
    for (int i = 0; i < 256; ++i) { const unsigned gi = scan_g[i], ei = scan_e[i]; if (i < tid) { pg += gi; pe += ei; } tg += gi; }
    const unsigned R = 256u - tg;
    unsigned og = pg, oe = pe;
    for (int j = j0; j < j1; ++j) { const unsigned k = keys[j];
        if (k > T) { out[og] = (unsigned short)j; ++og; }
        else if (k == T) { if (oe < R) out[tg + oe] = (unsigned short)j; ++oe; } }
}
__global__ void __launch_bounds__(64) k_dsa_attn_naive(const bf16_t* __restrict__ proj, const unsigned short* __restrict__ topk, bf16_t* __restrict__ o) {
    const int m = blockIdx.x; const int b = m / S; const int lane = threadIdx.x;
    const int hd = (lane < 48) ? (lane >> 2) : 0, dq = lane & 3;
    const bf16_t* row = proj + (size_t)m * NDSA;
    float q[64];
#pragma unroll
    for (int d = 0; d < 64; ++d) q[d] = bf2f(row[DQ + hd * 64 + d]) * C2;
    float acc[16];
#pragma unroll
    for (int i = 0; i < 16; ++i) acc[i] = 0.f;
    float mx = -INFINITY, l = 0.f;
    const unsigned short* ix = topk + (size_t)m * 256;
    for (int jj = 0; jj < 256; ++jj) {
        const unsigned j = ix[jj]; if (j == 0xFFFFu) continue;
        const bf16_t* kp = proj + (size_t)(b * S + j) * NDSA + DK;
        const bf16_t* vp = proj + (size_t)(b * S + j) * NDSA + DV + dq * 16;
        float s = 0.f;
#pragma unroll
        for (int d = 0; d < 64; ++d) s += q[d] * bf2f(kp[d]);
        const float mn = fmaxf(mx, s); const float f = exp2f(mx - mn), p = exp2f(s - mn);
        l = l * f + p; mx = mn;
#pragma unroll
        for (int i = 0; i < 16; ++i) acc[i] = acc[i] * f + p * bf2f(vp[i]);
    }
    if (lane < 48) {
        const float il = 1.f / l;
        bf16_t* op = o + (size_t)m * D + hd * 64 + dq * 16;
#pragma unroll
        for (int i = 0; i < 16; ++i) op[i] = (bf16_t)f2bf(acc[i] * il);
    }
}

static void launch_gemm(int mode, const bf16_t* A, const bf16_t* Bt, void* out, int Mr, int N, int K, int ldc, hipStream_t st) {
    GemmArgs a; memset(&a, 0, sizeof(a)); a.A = A; a.Bt = Bt; a.out = out; a.Mr = Mr; a.N = N; a.K = K; a.ldc = ldc;
    const int LDSB = pg8::STAGE_BYTES;
    if (mode == 0) hipLaunchKernelGGL(k_gemm<0>, dim3(256), dim3(512), LDSB, st, a);
    else if (mode == 2) hipLaunchKernelGGL(k_gemm<2>, dim3(256), dim3(512), LDSB, st, a);
    else hipLaunchKernelGGL(k_gemm<1>, dim3(256), dim3(512), LDSB, st, a);
}

extern "C" void kernel_launch(void* const* d_in, const int* in_sizes, int n_in, void* d_out, int out_size, void* d_ws, size_t ws_size, hipStream_t stream) {
    static int inited = 0;
    if (!inited) {
        if (n_in != 19 || out_size != M * D || ws_size < WS_END) { fprintf(stderr, "kernel_launch: unexpected shapes n_in %d out %d ws %zu\n", n_in, out_size, ws_size); inited = -1; return; }
        hipFuncSetAttribute((const void*)k_gemm<0>, hipFuncAttributeMaxDynamicSharedMemorySize, pg8::STAGE_BYTES);
        hipFuncSetAttribute((const void*)k_gemm<1>, hipFuncAttributeMaxDynamicSharedMemorySize, pg8::STAGE_BYTES);
        hipFuncSetAttribute((const void*)k_gemm<2>, hipFuncAttributeMaxDynamicSharedMemorySize, pg8::STAGE_BYTES);
        inited = 1;
    }
    if (inited < 0) return;
    const float* x = (const float*)d_in[0]; const float* mem = (const float*)d_in[1]; const int* pos = (const int*)d_in[2];
    const float* g_pre_mix = (const float*)d_in[3]; const float* g_post_mix = (const float*)d_in[4]; const float* g_mem = (const float*)d_in[5];
    const float* w_mem_kv = (const float*)d_in[6]; const float* w_out = (const float*)d_in[7]; const float* g_pre_mlp = (const float*)d_in[8];
    const float* g_post_mlp = (const float*)d_in[9]; const float* w_up = (const float*)d_in[10]; const float* w_dn = (const float*)d_in[11];
    const float* w_in_diff = (const float*)d_in[12]; const float* lq1 = (const float*)d_in[13]; const float* lk1 = (const float*)d_in[14];
    const float* lq2 = (const float*)d_in[15]; const float* lk2 = (const float*)d_in[16]; const float* gsub = (const float*)d_in[17]; const float* w_in_dsa = (const float*)d_in[18];
    unsigned char* ws = (unsigned char*)d_ws; float* out = (float*)d_out;
    bf16_t* Win0 = (bf16_t*)(ws + WS_WIN0); bf16_t* Win1 = (bf16_t*)(ws + WS_WIN1); bf16_t* Wout = (bf16_t*)(ws + WS_WOUT);
    bf16_t* Wup = (bf16_t*)(ws + WS_WUP); bf16_t* Wdn = (bf16_t*)(ws + WS_WDN); bf16_t* Wkv = (bf16_t*)(ws + WS_WKV);
    bf16_t* memn = (bf16_t*)(ws + WS_MEMN); bf16_t* memkv = (bf16_t*)(ws + WS_MEMKV); float2* rope = (float2*)(ws + WS_ROPE);
    unsigned short* topk = (unsigned short*)(ws + WS_TOPK); bf16_t* H = (bf16_t*)(ws + WS_H); bf16_t* proj = (bf16_t*)(ws + WS_PROJ);
    bf16_t* O = (bf16_t*)(ws + WS_O); bf16_t* hid = (bf16_t*)(ws + WS_HID); float* Y = (float*)(ws + WS_Y);
    hipLaunchKernelGGL(k_prep_w, dim3((NDIFF / 32) * (D / 32)), dim3(256), 0, stream, w_in_diff, D, NDIFF, Win0, NDIFF);
    hipLaunchKernelGGL(k_prep_w, dim3((NDSA / 32) * (D / 32)), dim3(256), 0, stream, w_in_dsa, D, NDSA_L, Win1, NDSA);
    for (int l = 0; l < 2; ++l) {
        hipLaunchKernelGGL(k_prep_w, dim3((D / 32) * (D / 32)), dim3(256), 0, stream, w_out + (size_t)l * D * D, D, D, Wout + (size_t)l * D * D, D);
        hipLaunchKernelGGL(k_prep_w, dim3((FF / 32) * (D / 32)), dim3(256), 0, stream, w_up + (size_t)l * D * FF, D, FF, Wup + (size_t)l * D * FF, FF);
        hipLaunchKernelGGL(k_prep_w, dim3((D / 32) * (FF / 32)), dim3(256), 0, stream, w_dn + (size_t)l * D * FF, FF, D, Wdn + (size_t)l * D * FF, D);
        hipLaunchKernelGGL(k_prep_w, dim3((512 / 32) * (D / 32)), dim3(256), 0, stream, w_mem_kv + (size_t)l * D * 512, D, 512, Wkv + (size_t)l * D * 512, 512);
        hipLaunchKernelGGL(k_rmsnorm, dim3(NB * NMEMT / 4), dim3(256), 0, stream, mem, g_mem + l * D, memn + (size_t)l * NB * NMEMT * D, NB * NMEMT);
        launch_gemm(0, memn + (size_t)l * NB * NMEMT * D, Wkv + (size_t)l * D * 512, memkv + (size_t)l * NB * NMEMT * 512, NB * NMEMT, 512, D, 512, stream);
    }
    hipLaunchKernelGGL(k_rope_tab, dim3(M * 32 / 256), dim3(256), 0, stream, pos, rope);
    hipLaunchKernelGGL(k_rmsnorm, dim3(M / 4), dim3(256), 0, stream, x, g_pre_mix, H, M);
    launch_gemm(0, H, Win0, proj, M, NDIFF, D, NDIFF, stream);
    hipLaunchKernelGGL(k_rope, dim3((unsigned)(((size_t)M * 24 * 32) / 256)), dim3(256), 0, stream, proj, NDIFF, rope, 0, 24);
    hipLaunchKernelGGL(k_attn_diff_naive, dim3(NB * 6 * (S / 64)), dim3(256), 0, stream, proj, O, lq1, lk1, lq2, lk2, gsub);
    hipLaunchKernelGGL(k_attn_mem_naive, dim3(NB * 4 * (S / 64)), dim3(256), 0, stream, proj, NDIFF, 2304, memkv, O);
    launch_gemm(1, O, Wout, Y, M, D, D, D, stream);
    hipLaunchKernelGGL(k_norm_res, dim3(M / 4), dim3(256), 0, stream, Y, x, g_post_mix, out, g_pre_mlp, H);
    launch_gemm(2, H, Wup, hid, M, FF, D, FF, stream);
    launch_gemm(1, hid, Wdn, Y, M, D, FF, D, stream);
    hipLaunchKernelGGL(k_norm_res, dim3(M / 4), dim3(256), 0, stream, Y, out, g_post_mlp, out, g_pre_mix + D, H);
    launch_gemm(0, H, Win1, proj, M, NDSA, D, NDSA, stream);
    hipLaunchKernelGGL(k_rope, dim3((unsigned)(((size_t)M * 22 * 32) / 256)), dim3(256), 0, stream, proj, NDSA, rope, 1, 22);
    hipLaunchKernelGGL(k_topk_naive, dim3(M), dim3(256), 0, stream, proj, topk);
    hipLaunchKernelGGL(k_dsa_attn_naive, dim3(M), dim3(64), 0, stream, proj, topk, O);
    hipLaunchKernelGGL(k_attn_mem_naive, dim3(NB * 4 * (S / 64)), dim3(256), 0, stream, proj, NDSA, DQM, memkv + (size_t)NB * NMEMT * 512, O);
    launch_gemm(1, O, Wout + (size_t)D * D, Y, M, D, D, D, stream);
    hipLaunchKernelGGL(k_norm_res, dim3(M / 4), dim3(256), 0, stream, Y, out, g_post_mix + D, out, g_pre_mlp + D, H);
    launch_gemm(2, H, Wup + (size_t)D * FF, hid, M, FF, D, FF, stream);
    launch_gemm(1, hid, Wdn + (size_t)D * FF, Y, M, D, FF, D, stream);
    hipLaunchKernelGGL(k_norm_res, dim3(M / 4), dim3(256), 0, stream, Y, out, g_post_mlp + D, out, (const float*)nullptr, (bf16_t*)nullptr);
}
```

```cpp
#include <hip/hip_runtime.h>
#include <cstdio>
#include <cstdint>
#include <cstring>
namespace pg8 {
#define PG8_LAS __attribute__((address_space(3)))
typedef unsigned short bf16_t;
typedef short bf16x8 __attribute__((ext_vector_type(8)));
typedef float f32x4 __attribute__((ext_vector_type(4)));
typedef unsigned u32x4 __attribute__((ext_vector_type(4)));
constexpr int BM = 256, BK = 64, HALF = 128, HTB = HALF * BK * 2  , STAGE_BYTES = 8 * HTB, NXCD = 8, WGM = 8;

__host__ __device__ __forceinline__ int lds_byte(int r, int c) { const int st = (r >> 4) * 2 + (c >> 5), rr = r & 15, cc = c & 31, ob = rr * 64 + cc * 2; return st * 1024 + (ob ^ (((ob >> 9) & 1) << 5)); }
__host__ __device__ __forceinline__ void stage_rc(int b, int& R, int& C) { const int st = b / 1024, sb = b % 1024, swz = sb ^ (((sb >> 9) & 1) << 5); R = (st >> 1) * 16 + swz / 64; C = (st & 1) * 32 + (swz % 64) / 2; }
__host__ __device__ __forceinline__ int perm32(int rho) { const int n = rho >> 4, i = rho & 15; return 8 * (i >> 2) + 4 * n + (i & 3); }

struct Unit { int pm, pn; };
struct Gemm { const bf16_t* A; const bf16_t* Bt; int M, N, K; };

struct StaticOrder {
    int nM, nN, nwg, G, c;
    __host__ __device__ void init(int M, int N, int G_, int c_) { nM = M / BM; nN = N / BM; nwg = nM * nN; G = G_; c = c_; }
    __host__ __device__ bool next(int i, Unit& u) const {
        const long L = (long)i * G + c; if (L >= nwg) return false;
        int wgid = (int)L; { const int q = nwg / NXCD, r = nwg % NXCD, xcd = wgid % NXCD, off = wgid / NXCD; wgid = (xcd < r ? xcd * (q + 1) : r * (q + 1) + (xcd - r) * q) + off; }
        const int nig = WGM * nN, gid = wgid / nig, fm = gid * WGM, gsz = (nM - fm) < WGM ? (nM - fm) : WGM;
        u.pm = fm + ((wgid % nig) % gsz); u.pn = (wgid % nig) / gsz; return true;
    }
    __device__ __forceinline__ void a_ready(const Unit&) const {}
    __device__ __forceinline__ void done(const Unit&) const {}
};

__device__ __forceinline__ unsigned cvt_pk_bf16(float lo, float hi) { unsigned r; asm volatile("v_cvt_pk_bf16_f32 %0, %1, %2" : "=v"(r) : "v"(lo), "v"(hi)); return r; }
typedef float f32x2 __attribute__((ext_vector_type(2)));
__device__ __forceinline__ f32x2 gelu_pk(f32x2 v) {
    const f32x2 av = __builtin_elementwise_abs(v), d = av * 0.2316418882f + 1.0f;
    f32x2 t; t.x = __builtin_amdgcn_rcpf(d.x); t.y = __builtin_amdgcn_rcpf(d.y);
    f32x2 q = t * 0.5307027145f + (-0.7265760135f); q = q * t + 0.7107068705f; q = q * t + (-0.142248368f); q = q * t + 0.127414796f; q = q * t;
    const f32x2 s = (v * v) * (-0.72134752044f);
    f32x2 e; e.x = __builtin_amdgcn_exp2f(s.x); e.y = __builtin_amdgcn_exp2f(s.y);
    const f32x2 m = v * (q * e), r = v - m;
    f32x2 o; o.x = v.x < 0.f ? m.x : r.x; o.y = v.y < 0.f ? m.y : r.y; return o;
}

template <int ACT  > struct EpiBf16 {
    static constexpr bool PERM = true, AFTER_DRAIN = false; static_assert(ACT == 0 || ACT == 1, "EpiBf16: ACT is 0 (none) or 1 (gelu_pk)");
    bf16_t* O; int ldc; const float* bias; int split_cols; size_t split_stride; float scale0;
    __device__ __forceinline__ void operator()(const f32x4 (&acc)[2][2][4][2], const Unit& u, int wr, int wc, int fr, int fq) const {
        const int row0 = u.pm * BM + wr * 64 + fr; int colt = u.pn * BM; bf16_t* base = O;
        float sc = 1.f; if (split_cols) { const int t = colt / split_cols; base += (size_t)t * split_stride; colt -= t * split_cols; if (t == 0) sc = scale0; }
        const int col0 = colt + wc * 32 + 8 * fq, bcol0 = u.pn * BM + wc * 32 + 8 * fq;
        f32x4 bv[2][2];
#pragma unroll
        for (int bj = 0; bj < 2; ++bj)
#pragma unroll
            for (int n = 0; n < 2; ++n) bv[bj][n] = bias ? *(const f32x4*)(bias + bcol0 + bj * HALF + 4 * n) : (f32x4){0.f, 0.f, 0.f, 0.f};
#pragma unroll
        for (int ai = 0; ai < 2; ++ai)
#pragma unroll
            for (int m = 0; m < 4; ++m) { bf16_t* rowp = base + (size_t)(row0 + ai * HALF + m * 16) * ldc + col0;
#pragma unroll
                for (int bj = 0; bj < 2; ++bj) { f32x4 v0 = acc[ai][bj][m][0] + bv[bj][0], v1 = acc[ai][bj][m][1] + bv[bj][1];
                    if (ACT == 1) { f32x2 a = gelu_pk((f32x2){v0[0], v0[1]}), b = gelu_pk((f32x2){v0[2], v0[3]}), c = gelu_pk((f32x2){v1[0], v1[1]}), d = gelu_pk((f32x2){v1[2], v1[3]});
                        v0 = (f32x4){a.x, a.y, b.x, b.y}; v1 = (f32x4){c.x, c.y, d.x, d.y}; }
                    v0 = v0 * sc; v1 = v1 * sc; u32x4 w; w.x = cvt_pk_bf16(v0[0], v0[1]); w.y = cvt_pk_bf16(v0[2], v0[3]); w.z = cvt_pk_bf16(v1[0], v1[1]); w.w = cvt_pk_bf16(v1[2], v1[3]);
                    *(u32x4*)(rowp + bj * HALF) = w; } }
    }
};

struct PanelStats {
    unsigned* xbuf;
    unsigned* cnt;
    unsigned* tmo;
    int ntn; float eps;
    unsigned code;
    __device__ __forceinline__ bool run(const f32x4 (&v)[2][2][4][2], const Unit& u, int wr, int wc, int fr, int fq, PG8_LAS unsigned char* lds, int wid, int lane) const {
        typedef float f32x2v __attribute__((ext_vector_type(2)));
        PG8_LAS f32x2v* P = (PG8_LAS f32x2v*)lds;
        PG8_LAS f32x2v* S = (PG8_LAS f32x2v*)(lds + 8192);
        PG8_LAS unsigned* flag = (PG8_LAS unsigned*)(lds + 8192 + 2048);
#pragma unroll
        for (int ai = 0; ai < 2; ++ai)
#pragma unroll
            for (int m = 0; m < 4; ++m) {
                float s = 0.f;
#pragma unroll
                for (int bj = 0; bj < 2; ++bj)
#pragma unroll
                    for (int n = 0; n < 2; ++n) { const f32x4 x = v[ai][bj][m][n]; s += (x[0] + x[1]) + (x[2] + x[3]); }
                s += __shfl_xor(s, 16); s += __shfl_xor(s, 32);
                const float mw = s * (1.0f / 64.0f); float q = 0.f;
#pragma unroll
                for (int bj = 0; bj < 2; ++bj)
#pragma unroll
                    for (int n = 0; n < 2; ++n) { const f32x4 d = v[ai][bj][m][n] - mw; q += (d[0] * d[0] + d[1] * d[1]) + (d[2] * d[2] + d[3] * d[3]); }
                q += __shfl_xor(q, 16); q += __shfl_xor(q, 32);
                if (fq == 0) P[(ai * HALF + wr * 64 + m * 16 + fr) * 4 + wc] = (f32x2v){mw, q};
            }
        asm volatile("s_waitcnt lgkmcnt(0)" ::: "memory"); __builtin_amdgcn_s_barrier(); asm volatile("" ::: "memory");
#if defined(BROKEN_EXCHANGE_NO_WAIT)
#warning BROKEN CONTROL BUILD: the row-statistics exchange does not wait; results are wrong by design
        if (blockIdx.x >= 64) { const long long t0_ = clock64(); while (clock64() - t0_ < 60000) __builtin_amdgcn_s_sleep(8); }
#endif
        const int row = wid * 32 + (lane & 31);
        if (lane < 32) {
            const f32x2v a = P[row * 4 + 0], b = P[row * 4 + 1], c = P[row * 4 + 2], d = P[row * 4 + 3];
            const float mt = (a.x + b.x + c.x + d.x) * 0.25f;
            const float da = a.x - mt, db = b.x - mt, dc = c.x - mt, dd = d.x - mt;
            const float m2 = (a.y + b.y) + (c.y + d.y) + 64.0f * ((da * da + db * db) + (dc * dc + dd * dd));
            unsigned long long* slot = (unsigned long long*)xbuf + ((size_t)(u.pm * BM + row) * 4 + u.pn);
            __hip_atomic_store(slot, ((unsigned long long)__float_as_uint(m2) << 32) | __float_as_uint(mt), __ATOMIC_RELAXED, __HIP_MEMORY_SCOPE_AGENT);
        }
        asm volatile("s_waitcnt vmcnt(0)" ::: "memory");
        if (lane == 0) __hip_atomic_fetch_add(cnt + 64 * u.pm, 1u, __ATOMIC_RELAXED, __HIP_MEMORY_SCOPE_AGENT);
        if (wid == 0) {
            bool dead = false; const unsigned long long t0 = __builtin_amdgcn_s_memrealtime(); const unsigned want = 8u * (unsigned)ntn;
            for (;;) {
#if defined(BROKEN_EXCHANGE_NO_WAIT)
                break;
#endif
                if ((unsigned)__builtin_amdgcn_readfirstlane(__hip_atomic_load(cnt + 64 * u.pm, __ATOMIC_RELAXED, __HIP_MEMORY_SCOPE_AGENT)) >= want) break;
                if (__builtin_amdgcn_s_memrealtime() - t0 > 2000000ull) {
                    if (lane == 0) { unsigned expect = 0u; __hip_atomic_compare_exchange_strong(tmo + 1, &expect, code | (unsigned)(u.pm & 0xff), __ATOMIC_RELAXED, __ATOMIC_RELAXED, __HIP_MEMORY_SCOPE_AGENT);
                                     __hip_atomic_store(tmo, 1u, __ATOMIC_RELAXED, __HIP_MEMORY_SCOPE_AGENT); }
                    dead = true; break; }
                __builtin_amdgcn_s_sleep(2);
            }
            __builtin_amdgcn_fence(__ATOMIC_ACQUIRE, "agent");
            if (lane == 0) flag[0] = dead ? 1u : 0u;
        }
        asm volatile("s_waitcnt vmcnt(0) lgkmcnt(0)" ::: "memory"); __builtin_amdgcn_s_barrier(); asm volatile("" ::: "memory");
        const bool bad = flag[0] != 0u;
        if (lane < 32) {
            const unsigned long long* slot = (const unsigned long long*)xbuf + (size_t)(u.pm * BM + row) * 4; float mt[4], m2[4]; float ms = 0.f;
#pragma unroll
            for (int t = 0; t < 4; ++t) { if (t < ntn) { const unsigned long long w = __hip_atomic_load(slot + t, __ATOMIC_RELAXED, __HIP_MEMORY_SCOPE_AGENT); mt[t] = __uint_as_float((unsigned)w); m2[t] = __uint_as_float((unsigned)(w >> 32)); } else { mt[t] = 0.f; m2[t] = 0.f; } ms += mt[t]; }
            const float mean = ms / (float)ntn; float q = 0.f;
#pragma unroll
            for (int t = 0; t < 4; ++t) if (t < ntn) { const float dm = mt[t] - mean; q += m2[t] + 256.0f * dm * dm; }
            S[row] = (f32x2v){mean, 1.0f / sqrtf(q / (256.0f * (float)ntn) + eps)};
        }
        asm volatile("s_waitcnt lgkmcnt(0)" ::: "memory"); __builtin_amdgcn_s_barrier(); asm volatile("" ::: "memory");
        return bad;
    }
};
struct EpiLnRes {
    static constexpr bool PERM = false, AFTER_DRAIN = true;
    const float* base; float* out; int ldc; const float* bias; PanelStats st; unsigned poison;
    __device__ __forceinline__ void fused(f32x4 (&acc)[2][2][4][2], const Unit& u, int wr, int wc, int fr, int fq, PG8_LAS unsigned char* lds, int wid, int lane) const {
        typedef float f32x2v __attribute__((ext_vector_type(2)));
        const PG8_LAS f32x2v* S = (const PG8_LAS f32x2v*)(lds + 8192);
        const int col0 = u.pn * BM + wc * 32 + 4 * fq;
#pragma unroll
        for (int bj = 0; bj < 2; ++bj)
#pragma unroll
            for (int n = 0; n < 2; ++n) { const f32x4 bv = bias ? *(const f32x4*)(bias + col0 + bj * HALF + n * 16) : (f32x4){0.f, 0.f, 0.f, 0.f};
#pragma unroll
                for (int ai = 0; ai < 2; ++ai)
#pragma unroll
                    for (int m = 0; m < 4; ++m) acc[ai][bj][m][n] += bv; }
        f32x4 pre[4][2][2];
#pragma unroll
        for (int m = 0; m < 4; ++m) { const size_t off = (size_t)(u.pm * BM + wr * 64 + m * 16 + fr) * ldc + col0;
#pragma unroll
            for (int bj = 0; bj < 2; ++bj)
#pragma unroll
                for (int n = 0; n < 2; ++n) pre[m][bj][n] = *(const f32x4*)(base + off + bj * HALF + n * 16); }
        const bool bad = st.run(acc, u, wr, wc, fr, fq, lds, wid, lane) || poison != 0u;
        const float qnan = __builtin_nanf("");
#pragma unroll
        for (int ai = 0; ai < 2; ++ai)
#pragma unroll
            for (int m = 0; m < 4; ++m) { const int r = ai * HALF + wr * 64 + m * 16 + fr; const f32x2v sr = S[r]; const size_t off = (size_t)(u.pm * BM + r) * ldc + col0;
#pragma unroll
                for (int bj = 0; bj < 2; ++bj)
#pragma unroll
                    for (int n = 0; n < 2; ++n) { const f32x4 bs = ai == 0 ? pre[m][bj][n] : *(const f32x4*)(base + off + bj * HALF + n * 16); f32x4 o = bs + (acc[ai][bj][m][n] - sr.x) * sr.y;
                        if (bad) o = (f32x4){qnan, qnan, qnan, qnan}; *(f32x4*)(out + off + bj * HALF + n * 16) = o; }
                if (m & 1) asm volatile("" ::: "memory"); }
    }
};
struct EpiLnResLn {
    static constexpr bool PERM = false, AFTER_DRAIN = true;
    const float* base; float* out; bf16_t* xn; int ldc; const float* bias; PanelStats st1, st2; unsigned poison;
    __device__ __forceinline__ void fused(f32x4 (&acc)[2][2][4][2], const Unit& u, int wr, int wc, int fr, int fq, PG8_LAS unsigned char* lds, int wid, int lane) const {
        typedef float f32x2v __attribute__((ext_vector_type(2))); typedef unsigned u32x2v __attribute__((ext_vector_type(2)));
        const PG8_LAS f32x2v* S = (const PG8_LAS f32x2v*)(lds + 8192);
        const int col0 = u.pn * BM + wc * 32 + 4 * fq;
#pragma unroll
        for (int bj = 0; bj < 2; ++bj)
#pragma unroll
            for (int n = 0; n < 2; ++n) { const f32x4 bv = bias ? *(const f32x4*)(bias + col0 + bj * HALF + n * 16) : (f32x4){0.f, 0.f, 0.f, 0.f};
#pragma unroll
                for (int ai = 0; ai < 2; ++ai)
#pragma unroll
                    for (int m = 0; m < 4; ++m) acc[ai][bj][m][n] += bv; }
        bool bad = st1.run(acc, u, wr, wc, fr, fq, lds, wid, lane) || poison != 0u;
        const float qnan = __builtin_nanf("");
#pragma unroll
        for (int ai = 0; ai < 2; ++ai)
#pragma unroll
            for (int m = 0; m < 4; ++m) { const int r = ai * HALF + wr * 64 + m * 16 + fr; const f32x2v sr = S[r]; const size_t off = (size_t)(u.pm * BM + r) * ldc + col0;
#pragma unroll
                for (int bj = 0; bj < 2; ++bj)
#pragma unroll
                    for (int n = 0; n < 2; ++n) { const f32x4 bs = *(const f32x4*)(base + off + bj * HALF + n * 16); acc[ai][bj][m][n] = bs + (acc[ai][bj][m][n] - sr.x) * sr.y; }
                asm volatile("" : "+v"(acc[ai][0][m][0]), "+v"(acc[ai][0][m][1]), "+v"(acc[ai][1][m][0]), "+v"(acc[ai][1][m][1]));
                if (m & 1) asm volatile("" ::: "memory"); }
        const bool bad1 = bad;
        bad = st2.run(acc, u, wr, wc, fr, fq, lds, wid, lane) || bad;
#pragma unroll
        for (int ai = 0; ai < 2; ++ai)
#pragma unroll
            for (int m = 0; m < 4; ++m) { const int r = ai * HALF + wr * 64 + m * 16 + fr; const f32x2v sr = S[r]; const size_t off = (size_t)(u.pm * BM + r) * ldc + col0;
#pragma unroll
                for (int bj = 0; bj < 2; ++bj)
#pragma unroll
                    for (int n = 0; n < 2; ++n) { const f32x4 x1 = acc[ai][bj][m][n]; *(f32x4*)(out + off + bj * HALF + n * 16) = bad1 ? (f32x4){qnan, qnan, qnan, qnan} : x1;
                        const f32x4 o = (x1 - sr.x) * sr.y; u32x2v w; w.x = cvt_pk_bf16(o[0], o[1]); w.y = cvt_pk_bf16(o[2], o[3]);
                        if (bad) { w.x = 0x7fc07fc0u; w.y = 0x7fc07fc0u; } *(u32x2v*)(xn + off + bj * HALF + n * 16) = w; }
                asm volatile("" ::: "memory"); }
    }
};

template <class Epi, class Sched, bool ALIGN_EPI = false, bool SP2 = false>
__device__ __forceinline__ void gemm_phase(PG8_LAS unsigned char* lds, const Gemm g, const Sched& S, const Epi& E) {
    const int tid = threadIdx.x, wid = __builtin_amdgcn_readfirstlane(tid >> 6), lane = tid & 63, wr = wid >> 2, wc = wid & 3, fr = lane & 15, fq = lane >> 4;
    const int K = g.K, nt = K / BK;
    unsigned voffA[2], voffB[2];
#pragma unroll
    for (int i = 0; i < 2; ++i) { int R, C; stage_rc(tid * 16 + i * 8192, R, C); const int Rb = Epi::PERM ? ((R & ~31) + perm32(R & 31)) : R;
        voffA[i] = (unsigned)(R * K + C) * 2u; voffB[i] = (unsigned)(Rb * K + C) * 2u; }
    const size_t kstep = (size_t)(BK * 2);
    const size_t hstep = (size_t)HALF * K * 2;
    const size_t tstep = 2 * hstep;
    const unsigned ldsw = (unsigned)wid * 1024u;
    const int aoff = lds_byte(wr * 64 + fr, fq * 8), boff = lds_byte(wc * 32 + fr, fq * 8);
#define PG8_SA(b, h) (((b) * 2 + (h)) * HTB)
#define PG8_SB(b, h) ((4 + (b) * 2 + (h)) * HTB)
#define PG8_STAGE(bufoff, gbase, voff) do { _Pragma("unroll") for (int _i = 0; _i < 2; ++_i) \
        __builtin_amdgcn_global_load_lds((const unsigned*)((const char*)(gbase) + (voff)[_i]), (PG8_LAS unsigned*)(lds + (bufoff) + ldsw + _i * 8192), 16, 0, 0); } while (0)
#define PG8_LDA(dst, b, h) do { _Pragma("unroll") for (int m = 0; m < 4; ++m) _Pragma("unroll") for (int k = 0; k < 2; ++k) dst[m][k] = *(const PG8_LAS bf16x8*)(lds + PG8_SA(b, h) + aoff + m * 2048 + k * 1024); } while (0)
#define PG8_LDB(dst, b, h) do { _Pragma("unroll") for (int n = 0; n < 2; ++n) _Pragma("unroll") for (int k = 0; k < 2; ++k) dst[n][k] = *(const PG8_LAS bf16x8*)(lds + PG8_SB(b, h) + boff + n * 2048 + k * 1024); } while (0)
#define PG8_MMA(ai, bj, At, Bt) do { __builtin_amdgcn_s_setprio(1); _Pragma("unroll") for (int m = 0; m < 4; ++m) _Pragma("unroll") for (int n = 0; n < 2; ++n) _Pragma("unroll") for (int k = 0; k < 2; ++k) \
        acc[ai][bj][m][n] = __builtin_amdgcn_mfma_f32_16x16x32_bf16(Bt[n][k], At[m][k], acc[ai][bj][m][n], 0, 0, 0); __builtin_amdgcn_s_setprio(0); } while (0)
#define PG8_WAIT_V(n) asm volatile("s_waitcnt vmcnt(" #n ")" ::: "memory")
#define PG8_WAIT_L(n) asm volatile("s_waitcnt lgkmcnt(" #n ")" ::: "memory")
#define PG8_BAR __builtin_amdgcn_s_barrier()
#define PG8_SCHED __builtin_amdgcn_sched_barrier(0)
    Unit cur, nxt; int ui = 0;
    if (!S.next(0, cur)) return;
    f32x4 acc[2][2][4][2];
#pragma unroll
    for (int a = 0; a < 2; ++a)
#pragma unroll
        for (int b = 0; b < 2; ++b)
#pragma unroll
            for (int m = 0; m < 4; ++m)
#pragma unroll
                for (int n = 0; n < 2; ++n) acc[a][b][m][n] = (f32x4){0.f, 0.f, 0.f, 0.f};
    bf16x8 At[4][2], B0[2][2], B1[2][2];
    const char* cA = (const char*)g.A + (size_t)cur.pm * tstep; const char* cB = (const char*)g.Bt + (size_t)cur.pn * tstep;
    S.a_ready(cur);
    if constexpr (SP2) {
        PG8_STAGE(PG8_SB(0, 0), cB, voffB); PG8_STAGE(PG8_SB(0, 1), cB + hstep, voffB); PG8_STAGE(PG8_SA(0, 0), cA, voffA); PG8_STAGE(PG8_SA(0, 1), cA + hstep, voffA);
        if (wr == 1) PG8_BAR;
        PG8_WAIT_V(2); PG8_BAR;
        PG8_STAGE(PG8_SB(1, 0), cB + kstep, voffB); PG8_STAGE(PG8_SA(1, 0), cA + kstep, voffA); PG8_STAGE(PG8_SB(1, 1), cB + hstep + kstep, voffB);
        PG8_WAIT_V(6); PG8_BAR;
    } else {
        PG8_STAGE(PG8_SB(0, 0), cB, voffB); PG8_STAGE(PG8_SA(0, 0), cA, voffA); PG8_STAGE(PG8_SB(0, 1), cB + hstep, voffB); PG8_STAGE(PG8_SA(0, 1), cA + hstep, voffA);
        if (wr == 1) PG8_BAR;
        PG8_WAIT_V(4); PG8_BAR;
        PG8_STAGE(PG8_SB(1, 0), cB + kstep, voffB); PG8_STAGE(PG8_SA(1, 0), cA + kstep, voffA); PG8_STAGE(PG8_SB(1, 1), cB + hstep + kstep, voffB);
        PG8_WAIT_V(6); PG8_BAR;
    }
    for (;;) {
        const bool has_next = S.next(ui + 1, nxt);
        const char* nA = has_next ? (const char*)g.A + (size_t)nxt.pm * tstep : cA; const char* nB = has_next ? (const char*)g.Bt + (size_t)nxt.pn * tstep : cB;
        for (int t = 0; t < nt; t += 2) {
            const bool last = (t == nt - 2);
            const char* a1 = cA + (size_t)(t + 1) * kstep;
            const char* a2 = last ? nA : cA + (size_t)(t + 2) * kstep; const char* b2 = last ? nB : cB + (size_t)(t + 2) * kstep;
            const char* a3 = a2 + kstep; const char* b3 = b2 + kstep;
            if (last && has_next) S.a_ready(nxt);
            if constexpr (SP2) {
            PG8_LDB(B0, 0, 0); PG8_LDB(B1, 0, 1); PG8_SCHED; PG8_LDA(At, 0, 0); PG8_STAGE(PG8_SA(1, 1), a1 + hstep, voffA);
            PG8_WAIT_V(8); PG8_WAIT_L(0); PG8_BAR; PG8_MMA(0, 0, At, B0); PG8_MMA(0, 1, At, B1); PG8_BAR; PG8_SCHED;
            PG8_LDA(At, 0, 1); PG8_STAGE(PG8_SB(0, 0), b2, voffB); PG8_STAGE(PG8_SB(0, 1), b2 + hstep, voffB); PG8_STAGE(PG8_SA(0, 0), a2, voffA);
            PG8_WAIT_V(8); PG8_WAIT_L(0); PG8_BAR; PG8_MMA(1, 0, At, B0); PG8_MMA(1, 1, At, B1); PG8_BAR; PG8_SCHED;
            PG8_LDB(B0, 1, 0); PG8_LDB(B1, 1, 1); PG8_SCHED; PG8_LDA(At, 1, 0); PG8_STAGE(PG8_SA(0, 1), a2 + hstep, voffA);
            PG8_WAIT_V(8); PG8_WAIT_L(0); PG8_BAR; PG8_MMA(0, 0, At, B0); PG8_MMA(0, 1, At, B1); PG8_BAR; PG8_SCHED;
            PG8_LDA(At, 1, 1); PG8_STAGE(PG8_SB(1, 0), b3, voffB); PG8_STAGE(PG8_SB(1, 1), b3 + hstep, voffB); PG8_STAGE(PG8_SA(1, 0), a3, voffA);
            PG8_WAIT_V(8); PG8_WAIT_L(0); PG8_BAR; PG8_MMA(1, 0, At, B0); PG8_MMA(1, 1, At, B1); PG8_BAR; PG8_SCHED;
            } else {
            PG8_LDB(B0, 0, 0); PG8_SCHED; PG8_LDA(At, 0, 0); PG8_STAGE(PG8_SA(1, 1), a1 + hstep, voffA);
            PG8_WAIT_L(8); PG8_BAR; PG8_WAIT_L(0); PG8_MMA(0, 0, At, B0); PG8_BAR; PG8_SCHED;
            PG8_LDB(B1, 0, 1); PG8_STAGE(PG8_SB(0, 0), b2, voffB);
            PG8_BAR; PG8_WAIT_L(0); PG8_MMA(0, 1, At, B1); PG8_BAR;
            PG8_LDA(At, 0, 1); PG8_STAGE(PG8_SA(0, 0), a2, voffA);
            PG8_BAR; PG8_WAIT_L(0); PG8_MMA(1, 0, At, B0); PG8_BAR; PG8_SCHED;
            PG8_STAGE(PG8_SB(0, 1), b2 + hstep, voffB);
            PG8_WAIT_V(6); PG8_BAR; PG8_MMA(1, 1, At, B1); PG8_BAR;
            PG8_LDB(B0, 1, 0); PG8_SCHED; PG8_LDA(At, 1, 0); PG8_STAGE(PG8_SA(0, 1), a2 + hstep, voffA);
            PG8_WAIT_L(8); PG8_BAR; PG8_WAIT_L(0); PG8_MMA(0, 0, At, B0); PG8_BAR; PG8_SCHED;
            PG8_LDB(B1, 1, 1); PG8_STAGE(PG8_SB(1, 0), b3, voffB);
            PG8_BAR; PG8_WAIT_L(0); PG8_MMA(0, 1, At, B1); PG8_BAR;
            PG8_LDA(At, 1, 1); PG8_STAGE(PG8_SA(1, 0), a3, voffA);
            PG8_BAR; PG8_WAIT_L(0); PG8_MMA(1, 0, At, B0); PG8_BAR; PG8_SCHED;
            PG8_STAGE(PG8_SB(1, 1), b3 + hstep, voffB);
            PG8_WAIT_V(6); PG8_BAR; PG8_MMA(1, 1, At, B1); PG8_BAR;
            }
        }
        if constexpr (ALIGN_EPI) { if (wr == 0) PG8_BAR; }
        if constexpr (!Epi::AFTER_DRAIN) { E(acc, cur, wr, wc, fr, fq); S.done(cur); }
        if (!has_next) break;
#pragma unroll
        for (int a = 0; a < 2; ++a)
#pragma unroll
            for (int b = 0; b < 2; ++b)
#pragma unroll
                for (int m = 0; m < 4; ++m)
#pragma unroll
                    for (int n = 0; n < 2; ++n) acc[a][b][m][n] = (f32x4){0.f, 0.f, 0.f, 0.f};
        cur = nxt; cA = nA; cB = nB; ++ui;
        if constexpr (ALIGN_EPI) { if (wr == 1) PG8_BAR; }
    }
    PG8_WAIT_V(0);
    if constexpr (!ALIGN_EPI) { if (wr == 0) PG8_BAR; }
    PG8_BAR;
    if constexpr (Epi::AFTER_DRAIN) { E.fused(acc, cur, wr, wc, fr, fq, lds, wid, lane); S.done(cur); }
#undef PG8_SA
#undef PG8_SB
#undef PG8_STAGE
#undef PG8_LDA
#undef PG8_LDB
#undef PG8_MMA
#undef PG8_WAIT_V
#undef PG8_WAIT_L
#undef PG8_BAR
#undef PG8_SCHED
}
}
#define GAS __attribute__((address_space(1)))
#define LAS __attribute__((address_space(3)))
typedef unsigned short bf16;
typedef unsigned v4u __attribute__((ext_vector_type(4)));
typedef float f32x4 __attribute__((ext_vector_type(4)));
typedef short bf16x8 __attribute__((ext_vector_type(8)));
typedef GAS unsigned gu32;
typedef GAS unsigned long long gu64;
#define RLX_AGENT __ATOMIC_RELAXED, __HIP_MEMORY_SCOPE_AGENT
#define LDS_WAIT() asm volatile("s_waitcnt lgkmcnt(0)" ::: "memory")
#define VM_WAIT() asm volatile("s_waitcnt vmcnt(0)" ::: "memory")
__device__ __forceinline__ unsigned long long rt() { return __builtin_amdgcn_s_memrealtime(); }
#define XB_TMO      128
#define XB_XCNT(j)  (256  + 64 * (j))
#define XB_XSUB(j)  (1280 + 64 * (j))
#define XB_XGEN(j)  (2304 + 64 * (j))
#define XB_TOP      3328
#define XB_TOPGEN   3392
#define XCD_BAR_WORDS 3456
#define XB_SPIN_CAP (1u << 18)

__device__ __forceinline__ unsigned xb_ld(unsigned* p)              { return __hip_atomic_load(p, __ATOMIC_RELAXED, __HIP_MEMORY_SCOPE_AGENT); }
__device__ __forceinline__ unsigned xb_add(unsigned* p, unsigned v) { return __hip_atomic_fetch_add(p, v, __ATOMIC_RELAXED, __HIP_MEMORY_SCOPE_AGENT); }
__device__ __forceinline__ unsigned xb_xcc_id() { return (unsigned)__builtin_amdgcn_s_getreg((3 << 11) | 20) & 0xFu; }
#define XB_SPIN(cond, bar) do { unsigned _sp = 0; while (cond) { __builtin_amdgcn_s_sleep(1); \
    if ((++_sp & 255u) == 0u) { if (xb_ld(&(bar)[XB_TMO])) break; if (_sp > XB_SPIN_CAP) { atomicAdd(&(bar)[XB_TMO], 1u); break; } } } } while (0)

struct XcdBarrier {
    unsigned* bar; unsigned x;
    volatile LAS unsigned* st;
};

__device__ __forceinline__ XcdBarrier xcd_barrier_post(unsigned* bar, volatile LAS unsigned* st) {
    XcdBarrier b; b.bar = bar; b.x = xb_xcc_id(); b.st = st;
    if (threadIdx.x == 0) (void)xb_add(&bar[XB_XCNT(b.x)], 1u);
    return b;
}
__device__ __forceinline__ void xcd_barrier_complete(unsigned* bar, unsigned x, unsigned& nloc, unsigned& nx) {
    const unsigned G = gridDim.x * gridDim.y * gridDim.z;
    unsigned sum, cnt, mine, sp = 0u;
    for (;;) {
        sum = 0u; cnt = 0u; mine = 0u;
#pragma unroll
        for (unsigned j = 0; j < 16; ++j) { const unsigned c = xb_ld(&bar[XB_XCNT(j)]); sum += c; cnt += (c > 0u) ? 1u : 0u; mine = (j == x) ? c : mine; }
        if (sum == G) break;
        __builtin_amdgcn_s_sleep(1);
        if ((++sp & 255u) == 0u) { if (xb_ld(&bar[XB_TMO])) break; if (sp > XB_SPIN_CAP) { atomicAdd(&bar[XB_TMO], 1u); break; } }
    }
    nloc = mine > 0u ? mine : 1u; nx = cnt > 0u ? cnt : 1u;
}

__device__ __forceinline__ void xcd_barrier(const XcdBarrier& b) {
    asm volatile("s_waitcnt vmcnt(0)" ::: "memory");
    __syncthreads();
    if (threadIdx.x == 0) {
        unsigned* bar = b.bar;
        __builtin_amdgcn_s_waitcnt(0);
        unsigned nloc = b.st[0], nx = b.st[1];
        if (nloc == 0u) { xcd_barrier_complete(bar, b.x, nloc, nx); b.st[0] = nloc; b.st[1] = nx; }
        const unsigned old = xb_add(&bar[XB_XSUB(b.x)], 1u);
        const unsigned gen = old / nloc;
        if (old + 1u == (gen + 1u) * nloc) {
            __builtin_amdgcn_fence(__ATOMIC_RELEASE, "agent");
            asm volatile("s_waitcnt vmcnt(0)" ::: "memory");
            const unsigned og = xb_add(&bar[XB_TOP], 1u);
            const unsigned tg = og / nx;
            if (og + 1u == (tg + 1u) * nx) xb_add(&bar[XB_TOPGEN], 1u);
            else XB_SPIN(xb_ld(&bar[XB_TOPGEN]) == tg, bar);
            __builtin_amdgcn_fence(__ATOMIC_ACQUIRE, "agent");
            xb_add(&bar[XB_XGEN(b.x)], 1u);
            asm volatile("s_waitcnt vmcnt(0)" ::: "memory");
        } else {
            XB_SPIN(xb_ld(&bar[XB_XGEN(b.x)]) == gen, bar);
            __builtin_amdgcn_fence(__ATOMIC_ACQUIRE, "agent");
            asm volatile("s_waitcnt vmcnt(0)" ::: "memory");
        }
    }
    __syncthreads();
}

constexpr int NB = 8, S = 8192, M = NB * S, D = 1024, FF = 4096, NMEMT = 256;
constexpr int NDIFF = 2560, NDSA_L = 1736, NDSA = 1792;
constexpr float EPS = 1e-6f;
constexpr float C2 = 0.125f * 1.4426950408889634f;
constexpr int DQ = 0, DK = 768, DV = 832, DIQ = 896, DIK = 1408, DIW = 1472, DQM = 1480;

typedef unsigned short bf16_t;
typedef unsigned u32x4 __attribute__((ext_vector_type(4)));
typedef float f32x4 __attribute__((ext_vector_type(4)));

constexpr size_t MiB = 1u << 20;
constexpr size_t WS_CTL = 0;
constexpr size_t WS_WIN0 = 1 * MiB, WS_WIN1 = 6 * MiB, WS_WOUT = 10 * MiB, WS_WUP = 14 * MiB, WS_WDN = 30 * MiB, WS_WKV = 46 * MiB;
constexpr size_t WS_MEMN = 48 * MiB, WS_MEMKV = 56 * MiB, WS_ROPE = 60 * MiB, WS_TOPK = 76 * MiB;
constexpr size_t WS_H = 108 * MiB, WS_PROJ = 236 * MiB, WS_O = 556 * MiB, WS_HID = 236 * MiB, WS_Y = 748 * MiB, WS_END = 1004 * MiB;

__device__ __forceinline__ float bf2f(bf16_t v) { return __uint_as_float((unsigned)v << 16); }
__device__ __forceinline__ unsigned f2bf(float f) { unsigned u = __float_as_uint(f); return (u + 0x7fffu + ((u >> 16) & 1u)) >> 16; }
__device__ __forceinline__ unsigned pk2(float lo, float hi) { return f2bf(lo) | (f2bf(hi) << 16); }
__device__ __forceinline__ float wave_sum(float v) {
#pragma unroll
    for (int o = 1; o < 64; o <<= 1) v += __shfl_xor(v, o);
    return v;
}

template <int ACT> struct EpiB {
    static constexpr bool PERM = true, AFTER_DRAIN = false;
    bf16_t* O; int ldc;
    __device__ __forceinline__ void operator()(const pg8::f32x4 (&acc)[2][2][4][2], const pg8::Unit& u, int wr, int wc, int fr, int fq) const {
        const int row0 = u.pm * 256 + wr * 64 + fr, col0 = u.pn * 256 + wc * 32 + 8 * fq;
#pragma unroll
        for (int ai = 0; ai < 2; ++ai)
#pragma unroll
            for (int m = 0; m < 4; ++m) { bf16_t* rowp = O + (size_t)(row0 + ai * 128 + m * 16) * ldc + col0;
#pragma unroll
                for (int bj = 0; bj < 2; ++bj) { pg8::f32x4 v0 = acc[ai][bj][m][0], v1 = acc[ai][bj][m][1];
                    if (ACT == 2) {
#pragma unroll
                        for (int e = 0; e < 4; ++e) { float a = fmaxf(v0[e], 0.f); v0[e] = a * a; float b = fmaxf(v1[e], 0.f); v1[e] = b * b; } }
                    u32x4 w; w.x = pg8::cvt_pk_bf16(v0[0], v0[1]); w.y = pg8::cvt_pk_bf16(v0[2], v0[3]); w.z = pg8::cvt_pk_bf16(v1[0], v1[1]); w.w = pg8::cvt_pk_bf16(v1[2], v1[3]);
                    *(u32x4*)(rowp + bj * 128) = w; } }
    }
};
struct EpiF {
    static constexpr bool PERM = false, AFTER_DRAIN = false;
    float* C; int ldc;
    __device__ __forceinline__ void operator()(const pg8::f32x4 (&acc)[2][2][4][2], const pg8::Unit& u, int wr, int wc, int fr, int fq) const {
        const int row0 = u.pm * 256 + wr * 64 + fr, col0 = u.pn * 256 + wc * 32 + 4 * fq;
#pragma unroll
        for (int ai = 0; ai < 2; ++ai)
#pragma unroll
            for (int m = 0; m < 4; ++m) { float* rowp = C + (size_t)(row0 + ai * 128 + m * 16) * ldc + col0;
#pragma unroll
                for (int bj = 0; bj < 2; ++bj)
#pragma unroll
                    for (int n = 0; n < 2; ++n) *(pg8::f32x4*)(rowp + bj * 128 + n * 16) = acc[ai][bj][m][n]; }
    }
};


constexpr int NWAVES = 8, NTHR = 512;
constexpr int RING_BYTES = 131072, LDSCTL_OFF = RING_BYTES, LDS_BYTES = 147456;
constexpr size_t CTL_ZERO_BYTES = 1 * MiB;
constexpr int CW_TMO = 0, CW_BAR = 4096;

struct Args { const void* in[19]; float* out; unsigned char* ws; };

#define GSTRIDE_WAVES(gw, NGW) const int gw = (int)blockIdx.x * NWAVES + wave, NGW = (int)gridDim.x * NWAVES

__device__ __forceinline__ void prep_item(const float* __restrict__ W, int K, int N, bf16_t* __restrict__ Wt, int Nout, LAS float* scr, int item, int lane) {
    const int nblk = Nout / 32, kb = item / nblk, nb = item % nblk, k0 = 64 * kb, p0 = 32 * nb;
    const int p = p0 + (lane & 31);
#pragma unroll 8
    for (int i = 0; i < 32; ++i) { const int kk = 2 * i + (lane >> 5); scr[kk * 33 + (lane & 31)] = (p < N) ? W[(size_t)(k0 + kk) * N + p] : 0.f; }
    LDS_WAIT(); asm volatile("" ::: "memory");
    const int c = lane & 7;
#pragma unroll
    for (int j = 0; j < 4; ++j) { const int n = (lane >> 3) + 8 * j; const LAS float* s = scr + (8 * c) * 33 + n;
        u32x4 o; o.x = pk2(s[0 * 33], s[1 * 33]); o.y = pk2(s[2 * 33], s[3 * 33]); o.z = pk2(s[4 * 33], s[5 * 33]); o.w = pk2(s[6 * 33], s[7 * 33]);
        *(u32x4*)(Wt + (size_t)(p0 + n) * K + k0 + 8 * c) = o; }
    LDS_WAIT(); asm volatile("" ::: "memory");
}
__device__ __forceinline__ void prep_matrix(const float* W, int K, int N, bf16_t* Wt, int Nout, LAS float* scr, int gw, int NGW, int lane) {
    const int nitems = (K / 64) * (Nout / 32);
    for (int it = gw; it < nitems; it += NGW) prep_item(W, K, N, Wt, Nout, scr, it, lane);
}
__device__ __forceinline__ void rms_row_bf16(const float* xrow, const float* g, bf16_t* orow, int lane) {
    const f32x4* xr = (const f32x4*)xrow + lane; const f32x4* gr = (const f32x4*)g + lane;
    f32x4 v[4]; float s = 0.f;
#pragma unroll
    for (int j = 0; j < 4; ++j) { v[j] = xr[64 * j]; s += (v[j].x * v[j].x + v[j].y * v[j].y) + (v[j].z * v[j].z + v[j].w * v[j].w); }
    const float rstd = 1.f / sqrtf(wave_sum(s) * (1.f / D) + EPS);
    unsigned long long* o8 = (unsigned long long*)orow + lane;
#pragma unroll
    for (int j = 0; j < 4; ++j) { const f32x4 gg = gr[64 * j];
        o8[64 * j] = (unsigned long long)pk2(v[j].x * rstd * gg.x, v[j].y * rstd * gg.y) | ((unsigned long long)pk2(v[j].z * rstd * gg.z, v[j].w * rstd * gg.w) << 32); }
}
__device__ __forceinline__ void norm_res_row(const float* yrow, const float* xin, const float* g1, float* xout, const float* g2, bf16_t* hrow, int lane) {
    const f32x4* yr = (const f32x4*)yrow + lane; const f32x4* xr = (const f32x4*)xin + lane;
    f32x4 v[4], xv[4]; float s = 0.f;
#pragma unroll
    for (int j = 0; j < 4; ++j) { v[j] = yr[64 * j]; xv[j] = xr[64 * j]; s += (v[j].x * v[j].x + v[j].y * v[j].y) + (v[j].z * v[j].z + v[j].w * v[j].w); }
    const float rstd = 1.f / sqrtf(wave_sum(s) * (1.f / D) + EPS);
    float s2 = 0.f;
#pragma unroll
    for (int j = 0; j < 4; ++j) { const f32x4 gg = ((const f32x4*)g1 + lane)[64 * j]; xv[j] = xv[j] + v[j] * rstd * gg;
        s2 += (xv[j].x * xv[j].x + xv[j].y * xv[j].y) + (xv[j].z * xv[j].z + xv[j].w * xv[j].w);
        ((f32x4*)xout + lane)[64 * j] = xv[j]; }
    if (g2) {
        const float r2 = 1.f / sqrtf(wave_sum(s2) * (1.f / D) + EPS);
        unsigned long long* o8 = (unsigned long long*)hrow + lane;
#pragma unroll
        for (int j = 0; j < 4; ++j) { const f32x4 gg = ((const f32x4*)g2 + lane)[64 * j];
            o8[64 * j] = (unsigned long long)pk2(xv[j].x * r2 * gg.x, xv[j].y * r2 * gg.y) | ((unsigned long long)pk2(xv[j].z * r2 * gg.z, xv[j].w * r2 * gg.w) << 32); }
    }
}
__device__ __forceinline__ void ph_norm_res(const float* Y, const float* xin, const float* g1, float* xout, const float* g2, bf16_t* H, int wave, int lane) {
    GSTRIDE_WAVES(gw, NGW);
    for (int m = gw; m < M; m += NGW) norm_res_row(Y + (size_t)m * D, xin + (size_t)m * D, g1, xout + (size_t)m * D, g2, H + (size_t)m * D, lane);
}
__device__ __forceinline__ void ph_rope(bf16_t* buf, int ld, const float2* __restrict__ tab, int mode, int nheads) {
    const size_t tot = (size_t)M * nheads * 32;
    for (size_t idx = (size_t)blockIdx.x * NTHR + threadIdx.x; idx < tot; idx += (size_t)gridDim.x * NTHR) {
        const int i = (int)(idx & 31); const size_t r = idx >> 5; const int hs = (int)(r % nheads); const size_t m = r / nheads;
        int col0;
        if (mode == 0) col0 = 64 * hs; else col0 = (hs < 12) ? 64 * hs : (hs == 12) ? DK : (hs < 21) ? DIQ + 64 * (hs - 13) : DIK;
        bf16_t* p = buf + m * ld + col0 + i; const float2 cs = tab[m * 32 + i];
        const float x1 = bf2f(p[0]), x2 = bf2f(p[32]);
        p[0] = (bf16_t)f2bf(x1 * cs.x - x2 * cs.y); p[32] = (bf16_t)f2bf(x2 * cs.x + x1 * cs.y);
    }
}

__device__ __forceinline__ void ph_attn_diff_naive(const bf16_t* __restrict__ proj, bf16_t* __restrict__ o, const float* __restrict__ lq1, const float* __restrict__ lk1,
                                                   const float* __restrict__ lq2, const float* __restrict__ lk2, const float* __restrict__ gsub) {
    float a1 = 0.f, a2 = 0.f;
    for (int i = 0; i < 64; ++i) { a1 += lq1[i] * lk1[i]; a2 += lq2[i] * lk2[i]; }
    const float lam = expf(a1) - expf(a2) + 0.2f;
    const int half = __builtin_amdgcn_readfirstlane((int)threadIdx.x >> 8), tid = threadIdx.x & 255;
    const int NU = NB * 6 * (S / 64);
    for (int u = (int)blockIdx.x * 2 + half; u < NU; u += (int)gridDim.x * 2) {
        const int c = (S / 64 - 1) - (u / (NB * 6)), bh = u % (NB * 6), h = bh % 6, b = bh / 6;
        const int t = c * 64 + (tid >> 2), dq = tid & 3;
        const bf16_t* base = proj + (size_t)b * S * NDIFF;
        const int nk = 64 * (c + 1);
        float res[32];
#pragma unroll
        for (int br = 0; br < 2; ++br) {
            float q[64];
            const bf16_t* qp = base + (size_t)t * NDIFF + (2 * h + br) * 64;
#pragma unroll
            for (int d = 0; d < 64; ++d) q[d] = bf2f(qp[d]) * C2;
            float acc[32];
#pragma unroll
            for (int i = 0; i < 32; ++i) acc[i] = 0.f;
            float mx = -INFINITY, l = 0.f;
            for (int j = 0; j < nk; ++j) {
                const bf16_t* kp = base + (size_t)j * NDIFF + 768 + (2 * h + br) * 64;
                const bf16_t* vp = base + (size_t)j * NDIFF + 1536 + h * 128 + dq * 32;
                float s = 0.f;
#pragma unroll
                for (int d = 0; d < 64; ++d) s += q[d] * bf2f(kp[d]);
                const float mn = fmaxf(mx, s); const float f = exp2f(mx - mn), p = exp2f(s - mn);
                l = l * f + p; mx = mn;
#pragma unroll
                for (int i = 0; i < 32; ++i) acc[i] = acc[i] * f + p * bf2f(vp[i]);
            }
            const float il = 1.f / l;
            if (br == 0) {
#pragma unroll
                for (int i = 0; i < 32; ++i) res[i] = acc[i] * il;
            } else {
#pragma unroll
                for (int i = 0; i < 32; ++i) res[i] -= lam * acc[i] * il;
            }
        }
        float ss = 0.f;
#pragma unroll
        for (int i = 0; i < 32; ++i) ss += res[i] * res[i];
        ss += __shfl_xor(ss, 1); ss += __shfl_xor(ss, 2);
        const float rstd = 1.f / sqrtf(ss * (1.f / 128.f) + EPS);
        bf16_t* op = o + (size_t)(b * S + t) * D + h * 128 + dq * 32;
#pragma unroll
        for (int i = 0; i < 32; ++i) op[i] = (bf16_t)f2bf(res[i] * rstd * gsub[dq * 32 + i] * 0.8f);
    }
}
__device__ __forceinline__ void ph_attn_mem_naive(const bf16_t* __restrict__ qbuf, int ld, int qcol0, const bf16_t* __restrict__ kv, bf16_t* __restrict__ o) {
    int tidx = threadIdx.x; asm volatile("" : "+v"(tidx));
    const int half = __builtin_amdgcn_readfirstlane(tidx >> 8), tid = tidx & 255;
    const int NU = NB * 4 * (S / 64);
    for (int u = (int)blockIdx.x * 2 + half; u < NU; u += (int)gridDim.x * 2) {
        const int c = u % (S / 64), h = (u / (S / 64)) % 4, b = u / ((S / 64) * 4);
        const int t = c * 64 + (tid >> 2), dq = tid & 3;
        float q[64];
        const bf16_t* qp = qbuf + (size_t)(b * S + t) * ld + qcol0 + h * 64;
#pragma unroll
        for (int d = 0; d < 64; ++d) q[d] = bf2f(qp[d]) * C2;
        float acc[16];
#pragma unroll
        for (int i = 0; i < 16; ++i) acc[i] = 0.f;
        float mx = -INFINITY, l = 0.f;
        for (int j = 0; j < NMEMT; ++j) {
            const bf16_t* kp = kv + (size_t)(b * NMEMT + j) * 512 + h * 64;
            const bf16_t* vp = kv + (size_t)(b * NMEMT + j) * 512 + 256 + h * 64 + dq * 16;
            float s = 0.f;
#pragma unroll
            for (int d = 0; d < 64; ++d) s += q[d] * bf2f(kp[d]);
            const float mn = fmaxf(mx, s); const float f = exp2f(mx - mn), p = exp2f(s - mn);
            l = l * f + p; mx = mn;
#pragma unroll
            for (int i = 0; i < 16; ++i) acc[i] = acc[i] * f + p * bf2f(vp[i]);
        }
        const float il = 1.f / l;
        bf16_t* op = o + (size_t)(b * S + t) * D + 768 + h * 64 + dq * 16;
#pragma unroll
        for (int i = 0; i < 16; ++i) op[i] = (bf16_t)f2bf(acc[i] * il);
    }
}
__device__ __forceinline__ unsigned f2key(float f) { const unsigned u = __float_as_uint(f); return (u & 0x80000000u) ? ~u : (u | 0x80000000u); }
__device__ __forceinline__ void ph_topk_naive(const bf16_t* __restrict__ proj, unsigned short* __restrict__ topk, LAS unsigned char* lds) {
    LAS unsigned* keys = (LAS unsigned*)lds;
    LAS float* iqs = (LAS float*)(lds + 32768);
    LAS float* ws = (LAS float*)(lds + 32768 + 2048);
    LAS unsigned* cnt_s = (LAS unsigned*)(lds + 32768 + 2048 + 64);
    LAS unsigned* scan_g = (LAS unsigned*)(lds + 36864);
    LAS unsigned* scan_e = (LAS unsigned*)(lds + 36864 + 2048);
    const int tid = threadIdx.x;
    for (int m = blockIdx.x; m < M; m += gridDim.x) {
        const int b = m / S, t = m % S; const int c = t / 64; const int n = 64 * (c + 1);
        unsigned short* out = topk + (size_t)m * 256;
        if (n <= 256) { if (tid < 256) out[tid] = (tid < n) ? (unsigned short)tid : (unsigned short)0xFFFFu; continue; }
        const bf16_t* row = proj + (size_t)m * NDSA;
        __syncthreads();
        iqs[tid] = bf2f(row[DIQ + tid]);
        if (tid < 8) ws[tid] = bf2f(row[DIW + tid]) * 0.04419417382415922f;
        __syncthreads();
        for (int j = tid; j < n; j += NTHR) {
            const bf16_t* kp = proj + (size_t)(b * S + j) * NDSA + DIK;
            float kf[64];
#pragma unroll
            for (int d = 0; d < 64; ++d) kf[d] = bf2f(kp[d]);
            float sc = 0.f;
#pragma unroll 1
            for (int hh = 0; hh < 8; ++hh) { float lg = 0.f;
#pragma unroll
                for (int d = 0; d < 64; ++d) lg += iqs[hh * 64 + d] * kf[d];
                sc += fmaxf(lg, 0.f) * ws[hh]; }
            sc += 0.0f;
            keys[j] = f2key(sc);
        }
        __syncthreads();
        unsigned T = 0u;
        for (int bit = 31; bit >= 0; --bit) {
            const unsigned cand = T | (1u << bit);
            if (tid == 0) cnt_s[0] = 0u;
            __syncthreads();
            unsigned c0 = 0u;
            for (int j = tid; j < n; j += NTHR) c0 += (keys[j] >= cand) ? 1u : 0u;
            c0 = (unsigned)wave_sum((float)c0);
            if ((tid & 63) == 0) atomicAdd((unsigned*)cnt_s, c0);
            __syncthreads();
            if (cnt_s[0] >= 256u) T = cand;
            __syncthreads();
        }
        const int per = (n + NTHR - 1) / NTHR; const int j0 = tid * per, j1 = (j0 + per < n) ? j0 + per : n;
        unsigned g = 0u, e = 0u;
        for (int j = j0; j < j1; ++j) { const unsigned k = keys[j]; g += (k > T) ? 1u : 0u; e += (k == T) ? 1u : 0u; }
        scan_g[tid] = g; scan_e[tid] = e;
        __syncthreads();
        unsigned pg = 0u, pe = 0u, tg = 0u;
        for (int i = 0; i < NTHR; ++i) { const unsigned gi = scan_g[i], ei = scan_e[i]; if (i < tid) { pg += gi; pe += ei; } tg += gi; }
        const unsigned R = 256u - tg;
        unsigned og = pg, oe = pe;
        for (int j = j0; j < j1; ++j) { const unsigned k = keys[j];
            if (k > T) { out[og] = (unsigned short)j; ++og; }
            else if (k == T) { if (oe < R) out[tg + oe] = (unsigned short)j; ++oe; } }
    }
}
__device__ __forceinline__ void ph_dsa_attn_naive(const bf16_t* __restrict__ proj, const unsigned short* __restrict__ topk, bf16_t* __restrict__ o, int wave, int lane) {
    GSTRIDE_WAVES(gw, NGW);
    const int hd = (lane < 48) ? (lane >> 2) : 0, dq = lane & 3;
    for (int m = gw; m < M; m += NGW) {
        const int b = m / S;
        const bf16_t* row = proj + (size_t)m * NDSA;
        float q[64];
#pragma unroll
        for (int d = 0; d < 64; ++d) q[d] = bf2f(row[DQ + hd * 64 + d]) * C2;
        float acc[16];
#pragma unroll
        for (int i = 0; i < 16; ++i) acc[i] = 0.f;
        float mx = -INFINITY, l = 0.f;
        const unsigned short* ix = topk + (size_t)m * 256;
        for (int jj = 0; jj < 256; ++jj) {
            const unsigned j = ix[jj]; if (j == 0xFFFFu) continue;
            const bf16_t* kp = proj + (size_t)(b * S + j) * NDSA + DK;
            const bf16_t* vp = proj + (size_t)(b * S + j) * NDSA + DV + dq * 16;
            float s = 0.f;
#pragma unroll
            for (int d = 0; d < 64; ++d) s += q[d] * bf2f(kp[d]);
            const float mn = fmaxf(mx, s); const float f = exp2f(mx - mn), p = exp2f(s - mn);
            l = l * f + p; mx = mn;
#pragma unroll
            for (int i = 0; i < 16; ++i) acc[i] = acc[i] * f + p * bf2f(vp[i]);
        }
        if (lane < 48) {
            const float il = 1.f / l;
            bf16_t* op = o + (size_t)m * D + hd * 64 + dq * 16;
#pragma unroll
            for (int i = 0; i < 16; ++i) op[i] = (bf16_t)f2bf(acc[i] * il);
        }
    }
}

#define GEMM_PHASE(EPI, Aptr, Bptr, Mr, Nn, Kk, ...) do { pg8::Gemm g_{(Aptr), (Bptr), (Mr), (Nn), (Kk)}; pg8::StaticOrder S_; S_.init((Mr), (Nn), (int)gridDim.x, (int)blockIdx.x); \
    EPI E_{__VA_ARGS__}; pg8::gemm_phase<EPI, pg8::StaticOrder, true, true>(lds, g_, S_, E_); } while (0)

__global__ void __launch_bounds__(NTHR, 2) mk_fwd(Args args) {
    extern __shared__ __attribute__((aligned(16))) unsigned char lds_raw[];
    LAS unsigned char* lds = (LAS unsigned char*)lds_raw;
    const int tid = threadIdx.x, lane = tid & 63, wave = __builtin_amdgcn_readfirstlane(tid >> 6);
    unsigned char* ws = args.ws; float* out = args.out;
    const float* x = (const float*)args.in[0]; const float* mem = (const float*)args.in[1]; const int* pos = (const int*)args.in[2];
    const float* g_pre_mix = (const float*)args.in[3]; const float* g_post_mix = (const float*)args.in[4]; const float* g_mem = (const float*)args.in[5];
    const float* w_mem_kv = (const float*)args.in[6]; const float* w_out = (const float*)args.in[7]; const float* g_pre_mlp = (const float*)args.in[8];
    const float* g_post_mlp = (const float*)args.in[9]; const float* w_up = (const float*)args.in[10]; const float* w_dn = (const float*)args.in[11];
    const float* w_in_diff = (const float*)args.in[12]; const float* lq1 = (const float*)args.in[13]; const float* lk1 = (const float*)args.in[14];
    const float* lq2 = (const float*)args.in[15]; const float* lk2 = (const float*)args.in[16]; const float* gsub = (const float*)args.in[17]; const float* w_in_dsa = (const float*)args.in[18];
    bf16_t* Win0 = (bf16_t*)(ws + WS_WIN0); bf16_t* Win1 = (bf16_t*)(ws + WS_WIN1); bf16_t* Wout = (bf16_t*)(ws + WS_WOUT);
    bf16_t* Wup = (bf16_t*)(ws + WS_WUP); bf16_t* Wdn = (bf16_t*)(ws + WS_WDN); bf16_t* Wkv = (bf16_t*)(ws + WS_WKV);
    bf16_t* memn = (bf16_t*)(ws + WS_MEMN); bf16_t* memkv = (bf16_t*)(ws + WS_MEMKV); float2* rope = (float2*)(ws + WS_ROPE);
    unsigned short* topk = (unsigned short*)(ws + WS_TOPK); bf16_t* H = (bf16_t*)(ws + WS_H); bf16_t* proj = (bf16_t*)(ws + WS_PROJ);
    bf16_t* O = (bf16_t*)(ws + WS_O); bf16_t* hid = (bf16_t*)(ws + WS_HID); float* Y = (float*)(ws + WS_Y);
    gu32* ctl = (gu32*)(ws + WS_CTL);

    for (int u = tid; u < (LDS_BYTES - LDSCTL_OFF) / 4; u += NTHR) ((LAS unsigned*)(lds + LDSCTL_OFF))[u] = 0u;
    __syncthreads();
    XcdBarrier bar = xcd_barrier_post((unsigned*)(ctl + CW_BAR), (volatile LAS unsigned*)(lds + LDSCTL_OFF + 64));
#define GRID_BAR() xcd_barrier(bar)

    {
        LAS float* scr = (LAS float*)(lds + wave * 16384);
        GSTRIDE_WAVES(gw, NGW);
        prep_matrix(w_in_diff, D, NDIFF, Win0, NDIFF, scr, gw, NGW, lane);
        prep_matrix(w_in_dsa, D, NDSA_L, Win1, NDSA, scr, gw, NGW, lane);
#pragma unroll 1
        for (int l = 0; l < 2; ++l) {
            prep_matrix(w_out + (size_t)l * D * D, D, D, Wout + (size_t)l * D * D, D, scr, gw, NGW, lane);
            prep_matrix(w_up + (size_t)l * D * FF, D, FF, Wup + (size_t)l * D * FF, FF, scr, gw, NGW, lane);
            prep_matrix(w_dn + (size_t)l * D * FF, FF, D, Wdn + (size_t)l * D * FF, D, scr, gw, NGW, lane);
            prep_matrix(w_mem_kv + (size_t)l * D * 512, D, 512, Wkv + (size_t)l * D * 512, 512, scr, gw, NGW, lane);
            for (int m = gw; m < NB * NMEMT; m += NGW) rms_row_bf16(mem + (size_t)m * D, g_mem + l * D, memn + ((size_t)l * NB * NMEMT + m) * D, lane);
        }
        for (int idx = (int)blockIdx.x * NTHR + tid; idx < M * 32; idx += (int)gridDim.x * NTHR) {
            const int m = idx >> 5, i = idx & 31;
            const double inv = pow(10000.0, -(double)i / 32.0); const double ang = (double)pos[m] * inv;
            rope[idx] = make_float2((float)cos(ang), (float)sin(ang));
        }
        for (int m = gw; m < M; m += NGW) rms_row_bf16(x + (size_t)m * D, g_pre_mix, H + (size_t)m * D, lane);
    }
    GRID_BAR();
    GEMM_PHASE(EpiB<0>, memn, Wkv, NB * NMEMT, 512, D, memkv, 512);
    GEMM_PHASE(EpiB<0>, memn + (size_t)NB * NMEMT * D, Wkv + (size_t)D * 512, NB * NMEMT, 512, D, memkv + (size_t)NB * NMEMT * 512, 512);
    GEMM_PHASE(EpiB<0>, H, Win0, M, NDIFF, D, proj, NDIFF);
    GRID_BAR();
    ph_rope(proj, NDIFF, rope, 0, 24);
    GRID_BAR();
    ph_attn_diff_naive(proj, O, lq1, lk1, lq2, lk2, gsub);
    ph_attn_mem_naive(proj, NDIFF, 2304, memkv, O);
    GRID_BAR();
    GEMM_PHASE(EpiF, O, Wout, M, D, D, Y, D);
    GRID_BAR();
    ph_norm_res(Y, x, g_post_mix, out, g_pre_mlp, H, wave, lane);
    GRID_BAR();
    GEMM_PHASE(EpiB<2>, H, Wup, M, FF, D, hid, FF);
    GRID_BAR();
    GEMM_PHASE(EpiF, hid, Wdn, M, D, FF, Y, D);
    GRID_BAR();
    ph_norm_res(Y, out, g_post_mlp, out, g_pre_mix + D, H, wave, lane);
    GRID_BAR();
    GEMM_PHASE(EpiB<0>, H, Win1, M, NDSA, D, proj, NDSA);
    GRID_BAR();
    ph_rope(proj, NDSA, rope, 1, 22);
    GRID_BAR();
    ph_topk_naive(proj, topk, lds);
    GRID_BAR();
    ph_dsa_attn_naive(proj, topk, O, wave, lane);
    ph_attn_mem_naive(proj, NDSA, DQM, memkv + (size_t)NB * NMEMT * 512, O);
    GRID_BAR();
    GEMM_PHASE(EpiF, O, Wout + (size_t)D * D, M, D, D, Y, D);
    GRID_BAR();
    ph_norm_res(Y, out, g_post_mix + D, out, g_pre_mlp + D, H, wave, lane);
    GRID_BAR();
    GEMM_PHASE(EpiB<2>, H, Wup + (size_t)D * FF, M, FF, D, hid, FF);
    GRID_BAR();
    GEMM_PHASE(EpiF, hid, Wdn + (size_t)D * FF, M, D, FF, Y, D);
    GRID_BAR();
    ph_norm_res(Y, out, g_post_mlp + D, out, (const float*)nullptr, H, wave, lane);
}

extern "C" void kernel_launch(void* const* d_in, const int* in_sizes, int n_in, void* d_out, int out_size, void* d_ws, size_t ws_size, hipStream_t stream) {
    static int grid = 0;
    if (grid == 0) {
        if (n_in != 19 || out_size != M * D || ws_size < WS_END) { fprintf(stderr, "kernel_launch: unexpected shapes n_in %d out %d ws %zu\n", n_in, out_size, ws_size); grid = -1; return; }
        int dev = 0, cus = 0, per_cu = 0;
        if (hipGetDevice(&dev) != hipSuccess || hipDeviceGetAttribute(&cus, hipDeviceAttributeMultiprocessorCount, dev) != hipSuccess) { grid = -1; return; }
        if (hipFuncSetAttribute((const void*)mk_fwd, hipFuncAttributeMaxDynamicSharedMemorySize, LDS_BYTES) != hipSuccess) { fprintf(stderr, "kernel_launch: hipFuncSetAttribute failed\n"); grid = -1; return; }
        if (hipOccupancyMaxActiveBlocksPerMultiprocessor(&per_cu, (const void*)mk_fwd, NTHR, LDS_BYTES) != hipSuccess || per_cu < 1) { fprintf(stderr, "kernel_launch: occupancy query says %d blocks per CU\n", per_cu); grid = -1; (void)hipGetLastError(); return; }
        grid = cus;
    }
    if (grid < 0) return;
    (void)hipMemsetAsync((char*)d_ws + WS_CTL, 0, CTL_ZERO_BYTES, stream);
    Args a; memset(&a, 0, sizeof(a));
    for (int i = 0; i < 19; ++i) a.in[i] = d_in[i];
    a.out = (float*)d_out; a.ws = (unsigned char*)d_ws;
    hipLaunchKernelGGL(mk_fwd, dim3(grid), dim3(NTHR), LDS_BYTES, stream, a);
}
```

```cpp
#include <hip/hip_runtime.h>
#include <cstdio>
#include <cstdint>
#include <cstring>
namespace pg8 {
#define PG8_LAS __attribute__((address_space(3)))
typedef unsigned short bf16_t;
typedef short bf16x8 __attribute__((ext_vector_type(8)));
typedef float f32x4 __attribute__((ext_vector_type(4)));
typedef unsigned u32x4 __attribute__((ext_vector_type(4)));
constexpr int BM = 256, BK = 64, HALF = 128, HTB = HALF * BK * 2  , STAGE_BYTES = 8 * HTB, NXCD = 8, WGM = 8;

__host__ __device__ __forceinline__ int lds_byte(int r, int c) { const int st = (r >> 4) * 2 + (c >> 5), rr = r & 15, cc = c & 31, ob = rr * 64 + cc * 2; return st * 1024 + (ob ^ (((ob >> 9) & 1) << 5)); }
__host__ __device__ __forceinline__ void stage_rc(int b, int& R, int& C) { const int st = b / 1024, sb = b % 1024, swz = sb ^ (((sb >> 9) & 1) << 5); R = (st >> 1) * 16 + swz / 64; C = (st & 1) * 32 + (swz % 64) / 2; }
__host__ __device__ __forceinline__ int perm32(int rho) { const int n = rho >> 4, i = rho & 15; return 8 * (i >> 2) + 4 * n + (i & 3); }

struct Unit { int pm, pn; };
struct Gemm { const bf16_t* A; const bf16_t* Bt; int M, N, K; };

struct StaticOrder {
    int nM, nN, nwg, G, c;
    __host__ __device__ void init(int M, int N, int G_, int c_) { nM = M / BM; nN = N / BM; nwg = nM * nN; G = G_; c = c_; }
    __host__ __device__ bool next(int i, Unit& u) const {
        const long L = (long)i * G + c; if (L >= nwg) return false;
        int wgid = (int)L; { const int q = nwg / NXCD, r = nwg % NXCD, xcd = wgid % NXCD, off = wgid / NXCD; wgid = (xcd < r ? xcd * (q + 1) : r * (q + 1) + (xcd - r) * q) + off; }
        const int nig = WGM * nN, gid = wgid / nig, fm = gid * WGM, gsz = (nM - fm) < WGM ? (nM - fm) : WGM;
        u.pm = fm + ((wgid % nig) % gsz); u.pn = (wgid % nig) / gsz; return true;
    }
    __device__ __forceinline__ void a_ready(const Unit&) const {}
    __device__ __forceinline__ void done(const Unit&) const {}
};

__device__ __forceinline__ unsigned cvt_pk_bf16(float lo, float hi) { unsigned r; asm volatile("v_cvt_pk_bf16_f32 %0, %1, %2" : "=v"(r) : "v"(lo), "v"(hi)); return r; }
typedef float f32x2 __attribute__((ext_vector_type(2)));
__device__ __forceinline__ f32x2 gelu_pk(f32x2 v) {
    const f32x2 av = __builtin_elementwise_abs(v), d = av * 0.2316418882f + 1.0f;
    f32x2 t; t.x = __builtin_amdgcn_rcpf(d.x); t.y = __builtin_amdgcn_rcpf(d.y);
    f32x2 q = t * 0.5307027145f + (-0.7265760135f); q = q * t + 0.7107068705f; q = q * t + (-0.142248368f); q = q * t + 0.127414796f; q = q * t;
    const f32x2 s = (v * v) * (-0.72134752044f);
    f32x2 e; e.x = __builtin_amdgcn_exp2f(s.x); e.y = __builtin_amdgcn_exp2f(s.y);
    const f32x2 m = v * (q * e), r = v - m;
    f32x2 o; o.x = v.x < 0.f ? m.x : r.x; o.y = v.y < 0.f ? m.y : r.y; return o;
}

template <int ACT  > struct EpiBf16 {
    static constexpr bool PERM = true, AFTER_DRAIN = false; static_assert(ACT == 0 || ACT == 1, "EpiBf16: ACT is 0 (none) or 1 (gelu_pk)");
    bf16_t* O; int ldc; const float* bias; int split_cols; size_t split_stride; float scale0;
    __device__ __forceinline__ void operator()(const f32x4 (&acc)[2][2][4][2], const Unit& u, int wr, int wc, int fr, int fq) const {
        const int row0 = u.pm * BM + wr * 64 + fr; int colt = u.pn * BM; bf16_t* base = O;
        float sc = 1.f; if (split_cols) { const int t = colt / split_cols; base += (size_t)t * split_stride; colt -= t * split_cols; if (t == 0) sc = scale0; }
        const int col0 = colt + wc * 32 + 8 * fq, bcol0 = u.pn * BM + wc * 32 + 8 * fq;
        f32x4 bv[2][2];
#pragma unroll
        for (int bj = 0; bj < 2; ++bj)
#pragma unroll
            for (int n = 0; n < 2; ++n) bv[bj][n] = bias ? *(const f32x4*)(bias + bcol0 + bj * HALF + 4 * n) : (f32x4){0.f, 0.f, 0.f, 0.f};
#pragma unroll
        for (int ai = 0; ai < 2; ++ai)
#pragma unroll
            for (int m = 0; m < 4; ++m) { bf16_t* rowp = base + (size_t)(row0 + ai * HALF + m * 16) * ldc + col0;
#pragma unroll
                for (int bj = 0; bj < 2; ++bj) { f32x4 v0 = acc[ai][bj][m][0] + bv[bj][0], v1 = acc[ai][bj][m][1] + bv[bj][1];
                    if (ACT == 1) { f32x2 a = gelu_pk((f32x2){v0[0], v0[1]}), b = gelu_pk((f32x2){v0[2], v0[3]}), c = gelu_pk((f32x2){v1[0], v1[1]}), d = gelu_pk((f32x2){v1[2], v1[3]});
                        v0 = (f32x4){a.x, a.y, b.x, b.y}; v1 = (f32x4){c.x, c.y, d.x, d.y}; }
                    v0 = v0 * sc; v1 = v1 * sc; u32x4 w; w.x = cvt_pk_bf16(v0[0], v0[1]); w.y = cvt_pk_bf16(v0[2], v0[3]); w.z = cvt_pk_bf16(v1[0], v1[1]); w.w = cvt_pk_bf16(v1[2], v1[3]);
                    *(u32x4*)(rowp + bj * HALF) = w; } }
    }
};

struct PanelStats {
    unsigned* xbuf;
    unsigned* cnt;
    unsigned* tmo;
    int ntn; float eps;
    unsigned code;
    __device__ __forceinline__ bool run(const f32x4 (&v)[2][2][4][2], const Unit& u, int wr, int wc, int fr, int fq, PG8_LAS unsigned char* lds, int wid, int lane) const {
        typedef float f32x2v __attribute__((ext_vector_type(2)));
        PG8_LAS f32x2v* P = (PG8_LAS f32x2v*)lds;
        PG8_LAS f32x2v* S = (PG8_LAS f32x2v*)(lds + 8192);
        PG8_LAS unsigned* flag = (PG8_LAS unsigned*)(lds + 8192 + 2048);
#pragma unroll
        for (int ai = 0; ai < 2; ++ai)
#pragma unroll
            for (int m = 0; m < 4; ++m) {
                float s = 0.f;
#pragma unroll
                for (int bj = 0; bj < 2; ++bj)
#pragma unroll
                    for (int n = 0; n < 2; ++n) { const f32x4 x = v[ai][bj][m][n]; s += (x[0] + x[1]) + (x[2] + x[3]); }
                s += __shfl_xor(s, 16); s += __shfl_xor(s, 32);
                const float mw = s * (1.0f / 64.0f); float q = 0.f;
#pragma unroll
                for (int bj = 0; bj < 2; ++bj)
#pragma unroll
                    for (int n = 0; n < 2; ++n) { const f32x4 d = v[ai][bj][m][n] - mw; q += (d[0] * d[0] + d[1] * d[1]) + (d[2] * d[2] + d[3] * d[3]); }
                q += __shfl_xor(q, 16); q += __shfl_xor(q, 32);
                if (fq == 0) P[(ai * HALF + wr * 64 + m * 16 + fr) * 4 + wc] = (f32x2v){mw, q};
            }
        asm volatile("s_waitcnt lgkmcnt(0)" ::: "memory"); __builtin_amdgcn_s_barrier(); asm volatile("" ::: "memory");
#if defined(BROKEN_EXCHANGE_NO_WAIT)
#warning BROKEN CONTROL BUILD: the row-statistics exchange does not wait; results are wrong by design
        if (blockIdx.x >= 64) { const long long t0_ = clock64(); while (clock64() - t0_ < 60000) __builtin_amdgcn_s_sleep(8); }
#endif
        const int row = wid * 32 + (lane & 31);
        if (lane < 32) {
            const f32x2v a = P[row * 4 + 0], b = P[row * 4 + 1], c = P[row * 4 + 2], d = P[row * 4 + 3];
            const float mt = (a.x + b.x + c.x + d.x) * 0.25f;
            const float da = a.x - mt, db = b.x - mt, dc = c.x - mt, dd = d.x - mt;
            const float m2 = (a.y + b.y) + (c.y + d.y) + 64.0f * ((da * da + db * db) + (dc * dc + dd * dd));
            unsigned long long* slot = (unsigned long long*)xbuf + ((size_t)(u.pm * BM + row) * 4 + u.pn);
            __hip_atomic_store(slot, ((unsigned long long)__float_as_uint(m2) << 32) | __float_as_uint(mt), __ATOMIC_RELAXED, __HIP_MEMORY_SCOPE_AGENT);
        }
        asm volatile("s_waitcnt vmcnt(0)" ::: "memory");
        if (lane == 0) __hip_atomic_fetch_add(cnt + 64 * u.pm, 1u, __ATOMIC_RELAXED, __HIP_MEMORY_SCOPE_AGENT);
        if (wid == 0) {
            bool dead = false; const unsigned long long t0 = __builtin_amdgcn_s_memrealtime(); const unsigned want = 8u * (unsigned)ntn;
            for (;;) {
#if defined(BROKEN_EXCHANGE_NO_WAIT)
                break;
#endif
                if ((unsigned)__builtin_amdgcn_readfirstlane(__hip_atomic_load(cnt + 64 * u.pm, __ATOMIC_RELAXED, __HIP_MEMORY_SCOPE_AGENT)) >= want) break;
                if (__builtin_amdgcn_s_memrealtime() - t0 > 2000000ull) {
                    if (lane == 0) { unsigned expect = 0u; __hip_atomic_compare_exchange_strong(tmo + 1, &expect, code | (unsigned)(u.pm & 0xff), __ATOMIC_RELAXED, __ATOMIC_RELAXED, __HIP_MEMORY_SCOPE_AGENT);
                                     __hip_atomic_store(tmo, 1u, __ATOMIC_RELAXED, __HIP_MEMORY_SCOPE_AGENT); }
                    dead = true; break; }
                __builtin_amdgcn_s_sleep(2);
            }
            __builtin_amdgcn_fence(__ATOMIC_ACQUIRE, "agent");
            if (lane == 0) flag[0] = dead ? 1u : 0u;
        }
        asm volatile("s_waitcnt vmcnt(0) lgkmcnt(0)" ::: "memory"); __builtin_amdgcn_s_barrier(); asm volatile("" ::: "memory");
        const bool bad = flag[0] != 0u;
        if (lane < 32) {
            const unsigned long long* slot = (const unsigned long long*)xbuf + (size_t)(u.pm * BM + row) * 4; float mt[4], m2[4]; float ms = 0.f;
#pragma unroll
            for (int t = 0; t < 4; ++t) { if (t < ntn) { const unsigned long long w = __hip_atomic_load(slot + t, __ATOMIC_RELAXED, __HIP_MEMORY_SCOPE_AGENT); mt[t] = __uint_as_float((unsigned)w); m2[t] = __uint_as_float((unsigned)(w >> 32)); } else { mt[t] = 0.f; m2[t] = 0.f; } ms += mt[t]; }
            const float mean = ms / (float)ntn; float q = 0.f;
#pragma unroll
            for (int t = 0; t < 4; ++t) if (t < ntn) { const float dm = mt[t] - mean; q += m2[t] + 256.0f * dm * dm; }
            S[row] = (f32x2v){mean, 1.0f / sqrtf(q / (256.0f * (float)ntn) + eps)};
        }
        asm volatile("s_waitcnt lgkmcnt(0)" ::: "memory"); __builtin_amdgcn_s_barrier(); asm volatile("" ::: "memory");
        return bad;
    }
};
struct EpiLnRes {
    static constexpr bool PERM = false, AFTER_DRAIN = true;
    const float* base; float* out; int ldc; const float* bias; PanelStats st; unsigned poison;
    __device__ __forceinline__ void fused(f32x4 (&acc)[2][2][4][2], const Unit& u, int wr, int wc, int fr, int fq, PG8_LAS unsigned char* lds, int wid, int lane) const {
        typedef float f32x2v __attribute__((ext_vector_type(2)));
        const PG8_LAS f32x2v* S = (const PG8_LAS f32x2v*)(lds + 8192);
        const int col0 = u.pn * BM + wc * 32 + 4 * fq;
#pragma unroll
        for (int bj = 0; bj < 2; ++bj)
#pragma unroll
            for (int n = 0; n < 2; ++n) { const f32x4 bv = bias ? *(const f32x4*)(bias + col0 + bj * HALF + n * 16) : (f32x4){0.f, 0.f, 0.f, 0.f};
#pragma unroll
                for (int ai = 0; ai < 2; ++ai)
#pragma unroll
                    for (int m = 0; m < 4; ++m) acc[ai][bj][m][n] += bv; }
        f32x4 pre[4][2][2];
#pragma unroll
        for (int m = 0; m < 4; ++m) { const size_t off = (size_t)(u.pm * BM + wr * 64 + m * 16 + fr) * ldc + col0;
#pragma unroll
            for (int bj = 0; bj < 2; ++bj)
#pragma unroll
                for (int n = 0; n < 2; ++n) pre[m][bj][n] = *(const f32x4*)(base + off + bj * HALF + n * 16); }
        const bool bad = st.run(acc, u, wr, wc, fr, fq, lds, wid, lane) || poison != 0u;
        const float qnan = __builtin_nanf("");
#pragma unroll
        for (int ai = 0; ai < 2; ++ai)
#pragma unroll
            for (int m = 0; m < 4; ++m) { const int r = ai * HALF + wr * 64 + m * 16 + fr; const f32x2v sr = S[r]; const size_t off = (size_t)(u.pm * BM + r) * ldc + col0;
#pragma unroll
                for (int bj = 0; bj < 2; ++bj)
#pragma unroll
                    for (int n = 0; n < 2; ++n) { const f32x4 bs = ai == 0 ? pre[m][bj][n] : *(const f32x4*)(base + off + bj * HALF + n * 16); f32x4 o = bs + (acc[ai][bj][m][n] - sr.x) * sr.y;
                        if (bad) o = (f32x4){qnan, qnan, qnan, qnan}; *(f32x4*)(out + off + bj * HALF + n * 16) = o; }
                if (m & 1) asm volatile("" ::: "memory"); }
    }
};
struct EpiLnResLn {
    static constexpr bool PERM = false, AFTER_DRAIN = true;
    const float* base; float* out; bf16_t* xn; int ldc; const float* bias; PanelStats st1, st2; unsigned poison;
    __device__ __forceinline__ void fused(f32x4 (&acc)[2][2][4][2], const Unit& u, int wr, int wc, int fr, int fq, PG8_LAS unsigned char* lds, int wid, int lane) const {
        typedef float f32x2v __attribute__((ext_vector_type(2))); typedef unsigned u32x2v __attribute__((ext_vector_type(2)));
        const PG8_LAS f32x2v* S = (const PG8_LAS f32x2v*)(lds + 8192);
        const int col0 = u.pn * BM + wc * 32 + 4 * fq;
#pragma unroll
        for (int bj = 0; bj < 2; ++bj)
#pragma unroll
            for (int n = 0; n < 2; ++n) { const f32x4 bv = bias ? *(const f32x4*)(bias + col0 + bj * HALF + n * 16) : (f32x4){0.f, 0.f, 0.f, 0.f};
#pragma unroll
                for (int ai = 0; ai < 2; ++ai)
#pragma unroll
                    for (int m = 0; m < 4; ++m) acc[ai][bj][m][n] += bv; }
        bool bad = st1.run(acc, u, wr, wc, fr, fq, lds, wid, lane) || poison != 0u;
        const float qnan = __builtin_nanf("");
#pragma unroll
        for (int ai = 0; ai < 2; ++ai)
#pragma unroll
            for (int m = 0; m < 4; ++m) { const int r = ai * HALF + wr * 64 + m * 16 + fr; const f32x2v sr = S[r]; const size_t off = (size_t)(u.pm * BM + r) * ldc + col0;
#pragma unroll
                for (int bj = 0; bj < 2; ++bj)
#pragma unroll
                    for (int n = 0; n < 2; ++n) { const f32x4 bs = *(const f32x4*)(base + off + bj * HALF + n * 16); acc[ai][bj][m][n] = bs + (acc[ai][bj][m][n] - sr.x) * sr.y; }
                asm volatile("" : "+v"(acc[ai][0][m][0]), "+v"(acc[ai][0][m][1]), "+v"(acc[ai][1][m][0]), "+v"(acc[ai][1][m][1]));
                if (m & 1) asm volatile("" ::: "memory"); }
        const bool bad1 = bad;
        bad = st2.run(acc, u, wr, wc, fr, fq, lds, wid, lane) || bad;
#pragma unroll
        for (int ai = 0; ai < 2; ++ai)
#pragma unroll
            for (int m = 0; m < 4; ++m) { const int r = ai * HALF + wr * 64 + m * 16 + fr; const f32x2v sr = S[r]; const size_t off = (size_t)(u.pm * BM + r) * ldc + col0;
#pragma unroll
                for (int bj = 0; bj < 2; ++bj)
#pragma unroll
                    for (int n = 0; n < 2; ++n) { const f32x4 x1 = acc[ai][bj][m][n]; *(f32x4*)(out + off + bj * HALF + n * 16) = bad1 ? (f32x4){qnan, qnan, qnan, qnan} : x1;
                        const f32x4 o = (x1 - sr.x) * sr.y; u32x2v w; w.x = cvt_pk_bf16(o[0], o[1]); w.y = cvt_pk_bf16(o[2], o[3]);
                        if (bad) { w.x = 0x7fc07fc0u; w.y = 0x7fc07fc0u; } *(u32x2v*)(xn + off + bj * HALF + n * 16) = w; }
                asm volatile("" ::: "memory"); }
    }
};

template <class Epi, class Sched, bool ALIGN_EPI = false, bool SP2 = false>
__device__ __forceinline__ void gemm_phase(PG8_LAS unsigned char* lds, const Gemm g, const Sched& S, const Epi& E) {
    int tid_ = threadIdx.x; asm volatile("" : "+v"(tid_));
    const int tid = tid_, wid = __builtin_amdgcn_readfirstlane(tid >> 6), lane = tid & 63, wr = wid >> 2, wc = wid & 3, fr = lane & 15, fq = lane >> 4;
    const int K = g.K, nt = K / BK;
    unsigned voffA[2], voffB[2];
#pragma unroll
    for (int i = 0; i < 2; ++i) { int R, C; stage_rc(tid * 16 + i * 8192, R, C); const int Rb = Epi::PERM ? ((R & ~31) + perm32(R & 31)) : R;
        voffA[i] = (unsigned)(R * K + C) * 2u; voffB[i] = (unsigned)(Rb * K + C) * 2u; }
    const size_t kstep = (size_t)(BK * 2);
    const size_t hstep = (size_t)HALF * K * 2;
    const size_t tstep = 2 * hstep;
    const unsigned ldsw = (unsigned)wid * 1024u;
    const int aoff = lds_byte(wr * 64 + fr, fq * 8), boff = lds_byte(wc * 32 + fr, fq * 8);
#define PG8_SA(b, h) (((b) * 2 + (h)) * HTB)
#define PG8_SB(b, h) ((4 + (b) * 2 + (h)) * HTB)
#define PG8_STAGE(bufoff, gbase, voff) do { _Pragma("unroll") for (int _i = 0; _i < 2; ++_i) \
        __builtin_amdgcn_global_load_lds((const unsigned*)((const char*)(gbase) + (voff)[_i]), (PG8_LAS unsigned*)(lds + (bufoff) + ldsw + _i * 8192), 16, 0, 0); } while (0)
#define PG8_LDA(dst, b, h) do { _Pragma("unroll") for (int m = 0; m < 4; ++m) _Pragma("unroll") for (int k = 0; k < 2; ++k) dst[m][k] = *(const PG8_LAS bf16x8*)(lds + PG8_SA(b, h) + aoff + m * 2048 + k * 1024); } while (0)
#define PG8_LDB(dst, b, h) do { _Pragma("unroll") for (int n = 0; n < 2; ++n) _Pragma("unroll") for (int k = 0; k < 2; ++k) dst[n][k] = *(const PG8_LAS bf16x8*)(lds + PG8_SB(b, h) + boff + n * 2048 + k * 1024); } while (0)
#define PG8_MMA(ai, bj, At, Bt) do { __builtin_amdgcn_s_setprio(1); _Pragma("unroll") for (int m = 0; m < 4; ++m) _Pragma("unroll") for (int n = 0; n < 2; ++n) _Pragma("unroll") for (int k = 0; k < 2; ++k) \
        acc[ai][bj][m][n] = __builtin_amdgcn_mfma_f32_16x16x32_bf16(Bt[n][k], At[m][k], acc[ai][bj][m][n], 0, 0, 0); __builtin_amdgcn_s_setprio(0); } while (0)
#define PG8_WAIT_V(n) asm volatile("s_waitcnt vmcnt(" #n ")" ::: "memory")
#define PG8_WAIT_L(n) asm volatile("s_waitcnt lgkmcnt(" #n ")" ::: "memory")
#define PG8_BAR __builtin_amdgcn_s_barrier()
#define PG8_SCHED __builtin_amdgcn_sched_barrier(0)
    Unit cur, nxt; int ui = 0;
    if (!S.next(0, cur)) return;
    f32x4 acc[2][2][4][2];
#pragma unroll
    for (int a = 0; a < 2; ++a)
#pragma unroll
        for (int b = 0; b < 2; ++b)
#pragma unroll
            for (int m = 0; m < 4; ++m)
#pragma unroll
                for (int n = 0; n < 2; ++n) acc[a][b][m][n] = (f32x4){0.f, 0.f, 0.f, 0.f};
    bf16x8 At[4][2], B0[2][2], B1[2][2];
    const char* cA = (const char*)g.A + (size_t)cur.pm * tstep; const char* cB = (const char*)g.Bt + (size_t)cur.pn * tstep;
    S.a_ready(cur);
    if constexpr (SP2) {
        PG8_STAGE(PG8_SB(0, 0), cB, voffB); PG8_STAGE(PG8_SB(0, 1), cB + hstep, voffB); PG8_STAGE(PG8_SA(0, 0), cA, voffA); PG8_STAGE(PG8_SA(0, 1), cA + hstep, voffA);
        if (wr == 1) PG8_BAR;
        PG8_WAIT_V(2); PG8_BAR;
        PG8_STAGE(PG8_SB(1, 0), cB + kstep, voffB); PG8_STAGE(PG8_SA(1, 0), cA + kstep, voffA); PG8_STAGE(PG8_SB(1, 1), cB + hstep + kstep, voffB);
        PG8_WAIT_V(6); PG8_BAR;
    } else {
        PG8_STAGE(PG8_SB(0, 0), cB, voffB); PG8_STAGE(PG8_SA(0, 0), cA, voffA); PG8_STAGE(PG8_SB(0, 1), cB + hstep, voffB); PG8_STAGE(PG8_SA(0, 1), cA + hstep, voffA);
        if (wr == 1) PG8_BAR;
        PG8_WAIT_V(4); PG8_BAR;
        PG8_STAGE(PG8_SB(1, 0), cB + kstep, voffB); PG8_STAGE(PG8_SA(1, 0), cA + kstep, voffA); PG8_STAGE(PG8_SB(1, 1), cB + hstep + kstep, voffB);
        PG8_WAIT_V(6); PG8_BAR;
    }
    for (;;) {
        const bool has_next = S.next(ui + 1, nxt);
        const char* nA = has_next ? (const char*)g.A + (size_t)nxt.pm * tstep : cA; const char* nB = has_next ? (const char*)g.Bt + (size_t)nxt.pn * tstep : cB;
        for (int t = 0; t < nt; t += 2) {
            const bool last = (t == nt - 2);
            const char* a1 = cA + (size_t)(t + 1) * kstep;
            const char* a2 = last ? nA : cA + (size_t)(t + 2) * kstep; const char* b2 = last ? nB : cB + (size_t)(t + 2) * kstep;
            const char* a3 = a2 + kstep; const char* b3 = b2 + kstep;
            if (last && has_next) S.a_ready(nxt);
            if constexpr (SP2) {
            PG8_LDB(B0, 0, 0); PG8_LDB(B1, 0, 1); PG8_SCHED; PG8_LDA(At, 0, 0); PG8_STAGE(PG8_SA(1, 1), a1 + hstep, voffA);
            PG8_WAIT_V(8); PG8_WAIT_L(0); PG8_BAR; PG8_MMA(0, 0, At, B0); PG8_MMA(0, 1, At, B1); PG8_BAR; PG8_SCHED;
            PG8_LDA(At, 0, 1); PG8_STAGE(PG8_SB(0, 0), b2, voffB); PG8_STAGE(PG8_SB(0, 1), b2 + hstep, voffB); PG8_STAGE(PG8_SA(0, 0), a2, voffA);
            PG8_WAIT_V(8); PG8_WAIT_L(0); PG8_BAR; PG8_MMA(1, 0, At, B0); PG8_MMA(1, 1, At, B1); PG8_BAR; PG8_SCHED;
            PG8_LDB(B0, 1, 0); PG8_LDB(B1, 1, 1); PG8_SCHED; PG8_LDA(At, 1, 0); PG8_STAGE(PG8_SA(0, 1), a2 + hstep, voffA);
            PG8_WAIT_V(8); PG8_WAIT_L(0); PG8_BAR; PG8_MMA(0, 0, At, B0); PG8_MMA(0, 1, At, B1); PG8_BAR; PG8_SCHED;
            PG8_LDA(At, 1, 1); PG8_STAGE(PG8_SB(1, 0), b3, voffB); PG8_STAGE(PG8_SB(1, 1), b3 + hstep, voffB); PG8_STAGE(PG8_SA(1, 0), a3, voffA);
            PG8_WAIT_V(8); PG8_WAIT_L(0); PG8_BAR; PG8_MMA(1, 0, At, B0); PG8_MMA(1, 1, At, B1); PG8_BAR; PG8_SCHED;
            } else {
            PG8_LDB(B0, 0, 0); PG8_SCHED; PG8_LDA(At, 0, 0); PG8_STAGE(PG8_SA(1, 1), a1 + hstep, voffA);
            PG8_WAIT_L(8); PG8_BAR; PG8_WAIT_L(0); PG8_MMA(0, 0, At, B0); PG8_BAR; PG8_SCHED;
            PG8_LDB(B1, 0, 1); PG8_STAGE(PG8_SB(0, 0), b2, voffB);
            PG8_BAR; PG8_WAIT_L(0); PG8_MMA(0, 1, At, B1); PG8_BAR;
            PG8_LDA(At, 0, 1); PG8_STAGE(PG8_SA(0, 0), a2, voffA);
            PG8_BAR; PG8_WAIT_L(0); PG8_MMA(1, 0, At, B0); PG8_BAR; PG8_SCHED;
            PG8_STAGE(PG8_SB(0, 1), b2 + hstep, voffB);
            PG8_WAIT_V(6); PG8_BAR; PG8_MMA(1, 1, At, B1); PG8_BAR;
            PG8_LDB(B0, 1, 0); PG8_SCHED; PG8_LDA(At, 1, 0); PG8_STAGE(PG8_SA(0, 1), a2 + hstep, voffA);
            PG8_WAIT_L(8); PG8_BAR; PG8_WAIT_L(0); PG8_MMA(0, 0, At, B0); PG8_BAR; PG8_SCHED;
            PG8_LDB(B1, 1, 1); PG8_STAGE(PG8_SB(1, 0), b3, voffB);
            PG8_BAR; PG8_WAIT_L(0); PG8_MMA(0, 1, At, B1); PG8_BAR;
            PG8_LDA(At, 1, 1); PG8_STAGE(PG8_SA(1, 0), a3, voffA);
            PG8_BAR; PG8_WAIT_L(0); PG8_MMA(1, 0, At, B0); PG8_BAR; PG8_SCHED;
            PG8_STAGE(PG8_SB(1, 1), b3 + hstep, voffB);
            PG8_WAIT_V(6); PG8_BAR; PG8_MMA(1, 1, At, B1); PG8_BAR;
            }
        }
        if constexpr (ALIGN_EPI) { if (wr == 0) PG8_BAR; }
        if constexpr (!Epi::AFTER_DRAIN) { E(acc, cur, wr, wc, fr, fq); S.done(cur); }
        if (!has_next) break;
#pragma unroll
        for (int a = 0; a < 2; ++a)
#pragma unroll
            for (int b = 0; b < 2; ++b)
#pragma unroll
                for (int m = 0; m < 4; ++m)
#pragma unroll
                    for (int n = 0; n < 2; ++n) acc[a][b][m][n] = (f32x4){0.f, 0.f, 0.f, 0.f};
        cur = nxt; cA = nA; cB = nB; ++ui;
        if constexpr (ALIGN_EPI) { if (wr == 1) PG8_BAR; }
    }
    PG8_WAIT_V(0);
    if constexpr (!ALIGN_EPI) { if (wr == 0) PG8_BAR; }
    PG8_BAR;
    if constexpr (Epi::AFTER_DRAIN) { E.fused(acc, cur, wr, wc, fr, fq, lds, wid, lane); S.done(cur); }
#undef PG8_SA
#undef PG8_SB
#undef PG8_STAGE
#undef PG8_LDA
#undef PG8_LDB
#undef PG8_MMA
#undef PG8_WAIT_V
#undef PG8_WAIT_L
#undef PG8_BAR
#undef PG8_SCHED
}
}
#define GAS __attribute__((address_space(1)))
#define LAS __attribute__((address_space(3)))
typedef unsigned short bf16;
typedef unsigned v4u __attribute__((ext_vector_type(4)));
typedef float f32x4 __attribute__((ext_vector_type(4)));
typedef short bf16x8 __attribute__((ext_vector_type(8)));
typedef GAS unsigned gu32;
typedef GAS unsigned long long gu64;
#define RLX_AGENT __ATOMIC_RELAXED, __HIP_MEMORY_SCOPE_AGENT
#define LDS_WAIT() asm volatile("s_waitcnt lgkmcnt(0)" ::: "memory")
#define VM_WAIT() asm volatile("s_waitcnt vmcnt(0)" ::: "memory")
__device__ __forceinline__ unsigned long long rt() { return __builtin_amdgcn_s_memrealtime(); }
#define XB_TMO      128
#define XB_XCNT(j)  (256  + 64 * (j))
#define XB_XSUB(j)  (1280 + 64 * (j))
#define XB_XGEN(j)  (2304 + 64 * (j))
#define XB_TOP      3328
#define XB_TOPGEN   3392
#define XCD_BAR_WORDS 3456
#define XB_SPIN_CAP (1u << 18)

__device__ __forceinline__ unsigned xb_ld(unsigned* p)              { return __hip_atomic_load(p, __ATOMIC_RELAXED, __HIP_MEMORY_SCOPE_AGENT); }
__device__ __forceinline__ unsigned xb_add(unsigned* p, unsigned v) { return __hip_atomic_fetch_add(p, v, __ATOMIC_RELAXED, __HIP_MEMORY_SCOPE_AGENT); }
__device__ __forceinline__ unsigned xb_xcc_id() { return (unsigned)__builtin_amdgcn_s_getreg((3 << 11) | 20) & 0xFu; }
#define XB_SPIN(cond, bar) do { unsigned _sp = 0; while (cond) { __builtin_amdgcn_s_sleep(1); \
    if ((++_sp & 255u) == 0u) { if (xb_ld(&(bar)[XB_TMO])) break; if (_sp > XB_SPIN_CAP) { atomicAdd(&(bar)[XB_TMO], 1u); break; } } } } while (0)

struct XcdBarrier {
    unsigned* bar; unsigned x;
    volatile LAS unsigned* st;
};

__device__ __forceinline__ XcdBarrier xcd_barrier_post(unsigned* bar, volatile LAS unsigned* st) {
    XcdBarrier b; b.bar = bar; b.x = xb_xcc_id(); b.st = st;
    if (threadIdx.x == 0) (void)xb_add(&bar[XB_XCNT(b.x)], 1u);
    return b;
}
__device__ __forceinline__ void xcd_barrier_complete(unsigned* bar, unsigned x, unsigned& nloc, unsigned& nx) {
    const unsigned G = gridDim.x * gridDim.y * gridDim.z;
    unsigned sum, cnt, mine, sp = 0u;
    for (;;) {
        sum = 0u; cnt = 0u; mine = 0u;
#pragma unroll
        for (unsigned j = 0; j < 16; ++j) { const unsigned c = xb_ld(&bar[XB_XCNT(j)]); sum += c; cnt += (c > 0u) ? 1u : 0u; mine = (j == x) ? c : mine; }
        if (sum == G) break;
        __builtin_amdgcn_s_sleep(1);
        if ((++sp & 255u) == 0u) { if (xb_ld(&bar[XB_TMO])) break; if (sp > XB_SPIN_CAP) { atomicAdd(&bar[XB_TMO], 1u); break; } }
    }
    nloc = mine > 0u ? mine : 1u; nx = cnt > 0u ? cnt : 1u;
}

__device__ __forceinline__ void xcd_barrier(const XcdBarrier& b) {
    asm volatile("s_waitcnt vmcnt(0)" ::: "memory");
    __syncthreads();
    if (threadIdx.x == 0) {
        unsigned* bar = b.bar;
        __builtin_amdgcn_s_waitcnt(0);
        unsigned nloc = b.st[0], nx = b.st[1];
        if (nloc == 0u) { xcd_barrier_complete(bar, b.x, nloc, nx); b.st[0] = nloc; b.st[1] = nx; }
        const unsigned old = xb_add(&bar[XB_XSUB(b.x)], 1u);
        const unsigned gen = old / nloc;
        if (old + 1u == (gen + 1u) * nloc) {
            __builtin_amdgcn_fence(__ATOMIC_RELEASE, "agent");
            asm volatile("s_waitcnt vmcnt(0)" ::: "memory");
            const unsigned og = xb_add(&bar[XB_TOP], 1u);
            const unsigned tg = og / nx;
            if (og + 1u == (tg + 1u) * nx) xb_add(&bar[XB_TOPGEN], 1u);
            else XB_SPIN(xb_ld(&bar[XB_TOPGEN]) == tg, bar);
            __builtin_amdgcn_fence(__ATOMIC_ACQUIRE, "agent");
            xb_add(&bar[XB_XGEN(b.x)], 1u);
            asm volatile("s_waitcnt vmcnt(0)" ::: "memory");
        } else {
            XB_SPIN(xb_ld(&bar[XB_XGEN(b.x)]) == gen, bar);
            __builtin_amdgcn_fence(__ATOMIC_ACQUIRE, "agent");
            asm volatile("s_waitcnt vmcnt(0)" ::: "memory");
        }
    }
    __syncthreads();
}
__device__ __forceinline__ int fresh_tid() { int t = threadIdx.x; asm volatile("" : "+v"(t)); return t; }

constexpr int NB = 8, S = 8192, M = NB * S, D = 1024, FF = 4096, NMEMT = 256;
constexpr int NDIFF = 2560, NDSA_L = 1736, NDSA = 1792;
constexpr float EPS = 1e-6f;
constexpr float C2 = 0.125f * 1.4426950408889634f;
constexpr int DQ = 0, DK = 768, DV = 832, DIQ = 896, DIK = 1408, DIW = 1472, DQM = 1480;

typedef unsigned short bf16_t;
typedef unsigned u32x4 __attribute__((ext_vector_type(4)));
typedef float f32x4 __attribute__((ext_vector_type(4)));

constexpr size_t MiB = 1u << 20;
constexpr size_t WS_CTL = 0;
constexpr size_t WS_WIN0 = 1 * MiB, WS_WIN1 = 6 * MiB, WS_WOUT = 10 * MiB, WS_WUP = 14 * MiB, WS_WDN = 30 * MiB, WS_WKV = 46 * MiB;
constexpr size_t WS_MEMN = 48 * MiB, WS_MEMKV = 56 * MiB, WS_ROPE = 60 * MiB, WS_TOPK = 76 * MiB;
constexpr size_t WS_H = 108 * MiB, WS_PROJ = 236 * MiB, WS_O = 556 * MiB, WS_HID = 236 * MiB, WS_Y = 748 * MiB, WS_END = 1004 * MiB;

constexpr size_t P0_Q = 0, P0_K = (size_t)M * 768, P0_V = (size_t)M * 1536, P0_QM = (size_t)M * 2304;
constexpr size_t MKV_K = 0, MKV_V = 524288, MKV_LAYER = 1048576;
__device__ __forceinline__ float bf2f(bf16_t v) { return __uint_as_float((unsigned)v << 16); }
__device__ __forceinline__ unsigned f2bf(float f) { unsigned u = __float_as_uint(f); return (u + 0x7fffu + ((u >> 16) & 1u)) >> 16; }
__device__ __forceinline__ unsigned pk2(float lo, float hi) { return f2bf(lo) | (f2bf(hi) << 16); }
__device__ __forceinline__ float wave_sum(float v) {
#pragma unroll
    for (int o = 1; o < 64; o <<= 1) v += __shfl_xor(v, o);
    return v;
}

template <int ACT> struct EpiB {
    static constexpr bool PERM = true, AFTER_DRAIN = false;
    bf16_t* O; int ldc;
    __device__ __forceinline__ void operator()(const pg8::f32x4 (&acc)[2][2][4][2], const pg8::Unit& u, int wr, int wc, int fr, int fq) const {
        const int row0 = u.pm * 256 + wr * 64 + fr, col0 = u.pn * 256 + wc * 32 + 8 * fq;
#pragma unroll
        for (int ai = 0; ai < 2; ++ai)
#pragma unroll
            for (int m = 0; m < 4; ++m) { bf16_t* rowp = O + (size_t)(row0 + ai * 128 + m * 16) * ldc + col0;
#pragma unroll
                for (int bj = 0; bj < 2; ++bj) { pg8::f32x4 v0 = acc[ai][bj][m][0], v1 = acc[ai][bj][m][1];
                    if (ACT == 2) {
#pragma unroll
                        for (int e = 0; e < 4; ++e) { float a = fmaxf(v0[e], 0.f); v0[e] = a * a; float b = fmaxf(v1[e], 0.f); v1[e] = b * b; } }
                    u32x4 w; w.x = pg8::cvt_pk_bf16(v0[0], v0[1]); w.y = pg8::cvt_pk_bf16(v0[2], v0[3]); w.z = pg8::cvt_pk_bf16(v1[0], v1[1]); w.w = pg8::cvt_pk_bf16(v1[2], v1[3]);
                    *(u32x4*)(rowp + bj * 128) = w; } }
    }
};
struct EpiF {
    static constexpr bool PERM = false, AFTER_DRAIN = false;
    float* C; int ldc;
    __device__ __forceinline__ void operator()(const pg8::f32x4 (&acc)[2][2][4][2], const pg8::Unit& u, int wr, int wc, int fr, int fq) const {
        const int row0 = u.pm * 256 + wr * 64 + fr, col0 = u.pn * 256 + wc * 32 + 4 * fq;
#pragma unroll
        for (int ai = 0; ai < 2; ++ai)
#pragma unroll
            for (int m = 0; m < 4; ++m) { float* rowp = C + (size_t)(row0 + ai * 128 + m * 16) * ldc + col0;
#pragma unroll
                for (int bj = 0; bj < 2; ++bj)
#pragma unroll
                    for (int n = 0; n < 2; ++n) *(pg8::f32x4*)(rowp + bj * 128 + n * 16) = acc[ai][bj][m][n]; }
    }
};


struct EpiProj0 {
    static constexpr bool PERM = true, AFTER_DRAIN = false;
    bf16_t* P; const float2* rope;
    __device__ __forceinline__ void operator()(const pg8::f32x4 (&acc)[2][2][4][2], const pg8::Unit& u, int wr, int wc, int fr, int fq) const {
        const int pn = u.pn;
        const int b = (u.pm * 256) / S;
        const int m0 = u.pm * 256 + wr * 64 + fr;
#pragma unroll
        for (int ai = 0; ai < 2; ++ai)
#pragma unroll
            for (int mm = 0; mm < 4; ++mm) {
                const int mrow = m0 + ai * 128 + mm * 16; const int s = mrow - b * S; const int t = s >> 6, r = s & 63;
                float x1[8], x2[8];
#pragma unroll
                for (int j = 0; j < 8; ++j) { x1[j] = acc[ai][0][mm][j >> 2][j & 3]; x2[j] = acc[ai][1][mm][j >> 2][j & 3]; }
                if (pn < 6) {
                    const pg8::f32x4* cs = (const pg8::f32x4*)(rope + (size_t)mrow * 32 + 8 * fq);
                    pg8::f32x4 cv[4];
#pragma unroll
                    for (int k = 0; k < 4; ++k) cv[k] = cs[k];
#pragma unroll
                    for (int j = 0; j < 8; ++j) { const float c = cv[j >> 1][(j & 1) * 2], sn = cv[j >> 1][(j & 1) * 2 + 1];
                        const float a = x1[j] * c - x2[j] * sn, bb = x2[j] * c + x1[j] * sn; x1[j] = a; x2[j] = bb; }
                }
                if (pn < 3 || pn == 9) {
#pragma unroll
                    for (int j = 0; j < 8; ++j) { x1[j] *= C2; x2[j] *= C2; }
                }
                u32x4 w1, w2;
                w1.x = pg8::cvt_pk_bf16(x1[0], x1[1]); w1.y = pg8::cvt_pk_bf16(x1[2], x1[3]); w1.z = pg8::cvt_pk_bf16(x1[4], x1[5]); w1.w = pg8::cvt_pk_bf16(x1[6], x1[7]);
                w2.x = pg8::cvt_pk_bf16(x2[0], x2[1]); w2.y = pg8::cvt_pk_bf16(x2[2], x2[3]); w2.z = pg8::cvt_pk_bf16(x2[4], x2[5]); w2.w = pg8::cvt_pk_bf16(x2[6], x2[7]);
                bf16_t *d1, *d2;
                if (pn < 3) { bf16_t* q = P + P0_Q + ((size_t)(b * 12 + 4 * pn + wc) * S + s) * 64 + 8 * fq; d1 = q; d2 = q + 32; }
                else if (pn < 6) { bf16_t* k = P + P0_K + ((((size_t)(b * 12 + 4 * (pn - 3) + wc) * 128 + t) * 8 + fq) * 512 + r * 8); d1 = k; d2 = k + 4 * 512; }
                else if (pn < 9) { const int hsv = 4 * (pn - 6) + wc; bf16_t* v = P + P0_V + (((((size_t)(b * 6 + (hsv >> 1)) * 128 + t) * 4 + 2 * (hsv & 1)) * 64 + r) * 32 + 8 * fq); d1 = v; d2 = v + 64 * 32; }
                else { bf16_t* q = P + P0_QM + ((size_t)(b * 4 + wc) * S + s) * 64 + 8 * fq; d1 = q; d2 = q + 32; }
                *(u32x4*)d1 = w1; *(u32x4*)d2 = w2;
            }
    }
};
struct EpiMemKV {
    static constexpr bool PERM = true, AFTER_DRAIN = false;
    bf16_t* P;
    __device__ __forceinline__ void operator()(const pg8::f32x4 (&acc)[2][2][4][2], const pg8::Unit& u, int wr, int wc, int fr, int fq) const {
        const int b = u.pm;
#pragma unroll
        for (int ai = 0; ai < 2; ++ai)
#pragma unroll
            for (int mm = 0; mm < 4; ++mm) {
                const int mt = ai * 128 + wr * 64 + mm * 16 + fr; const int t = mt >> 6, r = mt & 63;
#pragma unroll
                for (int bj = 0; bj < 2; ++bj) {
                    const pg8::f32x4 v0 = acc[ai][bj][mm][0], v1 = acc[ai][bj][mm][1];
                    u32x4 w; w.x = pg8::cvt_pk_bf16(v0[0], v0[1]); w.y = pg8::cvt_pk_bf16(v0[2], v0[3]); w.z = pg8::cvt_pk_bf16(v1[0], v1[1]); w.w = pg8::cvt_pk_bf16(v1[2], v1[3]);
                    bf16_t* dst = (u.pn == 0) ? P + MKV_K + ((((size_t)(b * 4 + wc) * 4 + t) * 8 + 4 * bj + fq) * 512 + r * 8)
                                              : P + MKV_V + (((((size_t)(b * 4 + wc) * 4 + t) * 2 + bj) * 64 + r) * 32 + 8 * fq);
                    *(u32x4*)dst = w;
                }
            }
    }
};

#ifndef FA_DEBUG_SYNC
#define FA_DEBUG_SYNC 0
#endif
namespace fa {
typedef short bf16x8 __attribute__((ext_vector_type(8)));
typedef short s16x4 __attribute__((ext_vector_type(4)));
typedef float f32x16 __attribute__((ext_vector_type(16)));
typedef __attribute__((address_space(3))) const char* lds_cptr;
typedef short v4i16_t __attribute__((ext_vector_type(4)));
__device__ __forceinline__ int crow(int r, int hi) { return (r & 3) + 8 * (r >> 2) + 4 * hi; }
__device__ __forceinline__ void glds16(const void* gsrc, unsigned lds_dst) { unsigned keep;
    asm volatile("s_mov_b32 %0, m0\n\ts_mov_b32 m0, %2\n\ts_nop 0\n\tglobal_load_lds_dwordx4 %1, off\n\ts_mov_b32 m0, %0" : "=&s"(keep) : "v"(gsrc), "s"(lds_dst) : "memory"); }
typedef float f32x2_t __attribute__((ext_vector_type(2))); typedef __bf16 bf16x2_t __attribute__((ext_vector_type(2)));
__device__ __forceinline__ unsigned cvtpk(float lo, float hi) { const f32x2_t v = {lo, hi}; return __builtin_bit_cast(unsigned, __builtin_convertvector(v, bf16x2_t)); }
__device__ __forceinline__ s16x4 vtr(lds_cptr p) { return __builtin_bit_cast(s16x4, __builtin_amdgcn_ds_read_tr16_b64_v4i16((__attribute__((address_space(3))) v4i16_t*)p)); }
__device__ __forceinline__ float swapmax(float m) { auto rr = __builtin_amdgcn_permlane32_swap(__float_as_uint(m), __float_as_uint(m), false, false); return fmaxf(__uint_as_float(rr[0]), __uint_as_float(rr[1])); }
__device__ __forceinline__ float swapsum(float m) { auto rr = __builtin_amdgcn_permlane32_swap(__float_as_uint(m), __float_as_uint(m), false, false); return __uint_as_float(rr[0]) + __uint_as_float(rr[1]); }

template <int NBR, int DV> struct Cfg {
    static constexpr int NVB = DV / 32, VBYTES = 64 * DV * 2, STG = NBR * 8192 + VBYTES, PPW = STG / 8192, ROWS = 256 / NBR;
    static constexpr int EXCH_OFF = 65536;
};
struct Unit { const bf16_t* q0; const bf16_t* q1; const bf16_t* k0; const bf16_t* k1; const bf16_t* v; int qrow0; int nt; };

template <int NBR, int DV> __device__ __forceinline__ void tile_compute(lds_cptr stage, int br, const bf16x8 (&qr)[4], f32x16 (&o)[DV / 32], float& m, float& l, int r32, int hi, int lane) {
    typedef Cfg<NBR, DV> C;
    const lds_cptr kp = stage + br * 8192 + hi * 1024 + r32 * 16;
    f32x16 p0 = {}, p1 = {};
#pragma unroll
    for (int d0 = 0; d0 < 4; ++d0) {
        const bf16x8 k0 = *(const __attribute__((address_space(3))) bf16x8*)(kp + d0 * 2048);
        const bf16x8 k1 = *(const __attribute__((address_space(3))) bf16x8*)(kp + d0 * 2048 + 512);
        p0 = __builtin_amdgcn_mfma_f32_32x32x16_bf16(k0, qr[d0], p0, 0, 0, 0);
        p1 = __builtin_amdgcn_mfma_f32_32x32x16_bf16(k1, qr[d0], p1, 0, 0, 0);
    }
    __builtin_amdgcn_sched_barrier(0);
    float mx = fmaxf(p0[0], p1[0]);
#pragma unroll
    for (int r = 1; r < 16; ++r) mx = fmaxf(mx, fmaxf(p0[r], p1[r]));
    mx = swapmax(mx);
    const float mn = fmaxf(m, mx), alpha = __builtin_amdgcn_exp2f(m - mn); m = mn;
    float ls = 0.f;
#pragma unroll
    for (int r = 0; r < 16; ++r) { p0[r] = __builtin_amdgcn_exp2f(p0[r] - mn); p1[r] = __builtin_amdgcn_exp2f(p1[r] - mn); ls += p0[r] + p1[r]; }
    l = l * alpha + ls;
#pragma unroll
    for (int db = 0; db < C::NVB; ++db)
#pragma unroll
        for (int r = 0; r < 16; ++r) o[db][r] *= alpha;
    u32x4 pw[4];
#pragma unroll
    for (int i = 0; i < 4; ++i) { pw[0][i] = cvtpk(p0[2 * i], p0[2 * i + 1]); pw[1][i] = cvtpk(p0[8 + 2 * i], p0[9 + 2 * i]); pw[2][i] = cvtpk(p1[2 * i], p1[2 * i + 1]); pw[3][i] = cvtpk(p1[8 + 2 * i], p1[9 + 2 * i]); }
    const lds_cptr vp = stage + NBR * 8192 + ((lane >> 4) & 1) * 32 + (lane & 3) * 8 + (4 * hi + ((lane & 15) >> 2)) * 64;
#pragma unroll
    for (int db = 0; db < C::NVB; ++db) {
        __builtin_amdgcn_sched_barrier(0);
#pragma unroll
        for (int ks = 0; ks < 4; ++ks) {
            const s16x4 lo = vtr(vp + db * 4096 + ks * 1024), hh = vtr(vp + db * 4096 + ks * 1024 + 512);
            const bf16x8 vf = (bf16x8){lo[0], lo[1], lo[2], lo[3], hh[0], hh[1], hh[2], hh[3]};
            o[db] = __builtin_amdgcn_mfma_f32_32x32x16_bf16(vf, __builtin_bit_cast(bf16x8, pw[ks]), o[db], 0, 0, 0);
        }
    }
    __builtin_amdgcn_sched_barrier(0);
}

template <int NBR, int DV> __device__ __forceinline__ void attn_unit(const Unit& U, bool causal, bf16_t* out, int out_row0, int ocol, float lam, const float* gsub, float oscale, LAS unsigned char* lds_) {
    typedef Cfg<NBR, DV> C;
    const int tid = fresh_tid(), lane = tid & 63, r32 = lane & 31, hi = lane >> 5; const int wid = __builtin_amdgcn_readfirstlane(tid >> 6);
    const int br = (NBR == 2) ? (wid >> 2) : 0, rw = (NBR == 2) ? (wid & 3) : wid;
    const lds_cptr lds = (lds_cptr)lds_;
    const unsigned lds0 = (unsigned)(uintptr_t)lds_;
    const int myrow0 = U.qrow0 + 32 * rw;
    const int NT = U.nt, my_nt = causal ? ((myrow0 >> 6) + 1) : NT;
    const int pc0 = wid * C::PPW;
    const char* src; int srcstep;
    if (pc0 < 8 * NBR) { src = (const char*)((pc0 >> 3) ? U.k1 : U.k0) + (pc0 & 7) * 1024; srcstep = 8192; }
    else { src = (const char*)U.v + (pc0 - 8 * NBR) * 1024; srcstep = C::VBYTES; }
    src += lane * 16;
    const unsigned dst0 = lds0 + pc0 * 1024;
#if FA_DEBUG_SYNC == 2
#define FA_DMA(t, slot) do { _Pragma("unroll") for (int i_ = 0; i_ < C::PPW; ++i_) { const u32x4 v_ = *(const u32x4*)(src + (size_t)(t) * srcstep + i_ * 1024); \
        *(LAS u32x4*)(lds_ + pc0 * 1024 + (slot) * C::STG + i_ * 1024 + lane * 16) = v_; } } while (0)
#else
#define FA_DMA(t, slot) do { _Pragma("unroll") for (int i_ = 0; i_ < C::PPW; ++i_) glds16(src + (size_t)(t) * srcstep + i_ * 1024, (unsigned)__builtin_amdgcn_readfirstlane(dst0 + (slot) * C::STG + i_ * 1024)); } while (0)
#endif
    bf16x8 qr[4];
    { const bf16_t* qp = (br ? U.q1 : U.q0) + (size_t)(myrow0 + r32) * 64 + hi * 8;
#pragma unroll
      for (int d0 = 0; d0 < 4; ++d0) qr[d0] = *(const bf16x8*)(qp + d0 * 16); }
    FA_DMA(0, 0);
    if (NT > 1) FA_DMA(1, 1);
    f32x16 o[C::NVB];
#pragma unroll
    for (int db = 0; db < C::NVB; ++db) o[db] = (f32x16){};
    float m = -INFINITY, l = 0.f;
    int slot = 0, slot2 = 2;
#pragma unroll 1
    for (int t = 0; t < NT; ++t) {
#if FA_DEBUG_SYNC >= 1
        asm volatile("s_waitcnt vmcnt(0) lgkmcnt(0)\n\ts_barrier" ::: "memory");
        if (t + 2 < NT) FA_DMA(t + 2, slot2);
        asm volatile("s_waitcnt vmcnt(0) lgkmcnt(0)\n\ts_barrier" ::: "memory");
        if (t < my_nt) tile_compute<NBR, DV>(lds + slot * C::STG, br, qr, o, m, l, r32, hi, lane);
        asm volatile("s_waitcnt vmcnt(0) lgkmcnt(0)\n\ts_barrier" ::: "memory");
#else
        if (t + 1 < NT) { if (C::PPW == 4) asm volatile("s_waitcnt vmcnt(4) lgkmcnt(0)\n\ts_barrier" ::: "memory"); else asm volatile("s_waitcnt vmcnt(2) lgkmcnt(0)\n\ts_barrier" ::: "memory"); }
        else asm volatile("s_waitcnt vmcnt(0) lgkmcnt(0)\n\ts_barrier" ::: "memory");
        if (t + 2 < NT) FA_DMA(t + 2, slot2);
        if (t < my_nt) tile_compute<NBR, DV>(lds + slot * C::STG, br, qr, o, m, l, r32, hi, lane);
#endif
        slot = (slot == 2) ? 0 : slot + 1; slot2 = (slot2 == 2) ? 0 : slot2 + 1;
    }
#undef FA_DMA
    asm volatile("s_waitcnt vmcnt(0) lgkmcnt(0)\n\ts_barrier" ::: "memory");
    l = swapsum(l);
    if (NBR == 2) {
        LAS float* ex = (LAS float*)(lds_ + C::EXCH_OFF) + rw * 4096 + lane;
        if (br == 1) {
            const float f = lam / l;
#pragma unroll
            for (int db = 0; db < C::NVB; ++db)
#pragma unroll
                for (int r = 0; r < 16; ++r) ex[(db * 16 + r) * 64] = o[db][r] * f;
        }
        asm volatile("s_waitcnt lgkmcnt(0)\n\ts_barrier" ::: "memory");
        if (br == 0) {
            const float il = 1.f / l; float ss = 0.f;
#pragma unroll
            for (int db = 0; db < C::NVB; ++db)
#pragma unroll
                for (int r = 0; r < 16; ++r) { const float v = o[db][r] * il - ex[(db * 16 + r) * 64]; o[db][r] = v; ss += v * v; }
            ss = swapsum(ss);
            const float rstd = oscale / sqrtf(ss * (1.f / (float)DV) + EPS);
            bf16_t* orow = out + (size_t)(out_row0 + myrow0 + r32) * D + ocol + 4 * hi;
#pragma unroll
            for (int db = 0; db < C::NVB; ++db)
#pragma unroll
                for (int g = 0; g < 4; ++g) { const f32x4 gg = *(const f32x4*)(gsub + db * 32 + 8 * g + 4 * hi);
                    uint2 w; w.x = cvtpk(o[db][4 * g] * rstd * gg.x, o[db][4 * g + 1] * rstd * gg.y); w.y = cvtpk(o[db][4 * g + 2] * rstd * gg.z, o[db][4 * g + 3] * rstd * gg.w);
                    *(uint2*)(orow + db * 32 + 8 * g) = w; }
        }
    } else {
        const float il = 1.f / l;
        bf16_t* orow = out + (size_t)(out_row0 + myrow0 + r32) * D + ocol + 4 * hi;
#pragma unroll
        for (int db = 0; db < C::NVB; ++db)
#pragma unroll
            for (int g = 0; g < 4; ++g) { uint2 w; w.x = cvtpk(o[db][4 * g] * il, o[db][4 * g + 1] * il); w.y = cvtpk(o[db][4 * g + 2] * il, o[db][4 * g + 3] * il);
                *(uint2*)(orow + db * 32 + 8 * g) = w; }
    }
    asm volatile("s_waitcnt lgkmcnt(0)\n\ts_barrier" ::: "memory");
}
}

constexpr int NWAVES = 8, NTHR = 512;
constexpr int RING_BYTES = 131072, LDSCTL_OFF = RING_BYTES, LDS_BYTES = 147456;
constexpr size_t CTL_ZERO_BYTES = 1 * MiB;
constexpr int CW_TMO = 0, CW_BAR = 4096;

struct Args { const void* in[19]; float* out; unsigned char* ws; };

#define FRESH_IDS const int tid = fresh_tid(), lane = tid & 63, wave = __builtin_amdgcn_readfirstlane(tid >> 6); (void)lane; (void)wave
#define GSTRIDE_WAVES(gw, NGW) const int gw = (int)blockIdx.x * NWAVES + wave, NGW = (int)gridDim.x * NWAVES

__device__ __forceinline__ int src_col(int p, int N, int mode) {
    if (mode == 0) return (p < N) ? p : -1;
    return (p & ~255) + 64 * ((p >> 5) & 3) + 32 * ((p >> 7) & 1) + (p & 31);
}
__device__ __forceinline__ void prep_item(const float* __restrict__ W, int K, int N, bf16_t* __restrict__ Wt, int Nout, int mode, LAS float* scr, int item, int lane) {
    const int nblk = Nout / 32, kb = item / nblk, nb = item % nblk, k0 = 64 * kb, p0 = 32 * nb;
    const int p = src_col(p0 + (lane & 31), N, mode);
#pragma unroll 8
    for (int i = 0; i < 32; ++i) { const int kk = 2 * i + (lane >> 5); scr[kk * 33 + (lane & 31)] = (p >= 0) ? W[(size_t)(k0 + kk) * N + p] : 0.f; }
    LDS_WAIT(); asm volatile("" ::: "memory");
    const int c = lane & 7;
#pragma unroll
    for (int j = 0; j < 4; ++j) { const int n = (lane >> 3) + 8 * j; const LAS float* s = scr + (8 * c) * 33 + n;
        u32x4 o; o.x = pk2(s[0 * 33], s[1 * 33]); o.y = pk2(s[2 * 33], s[3 * 33]); o.z = pk2(s[4 * 33], s[5 * 33]); o.w = pk2(s[6 * 33], s[7 * 33]);
        *(u32x4*)(Wt + (size_t)(p0 + n) * K + k0 + 8 * c) = o; }
    LDS_WAIT(); asm volatile("" ::: "memory");
}
__device__ __forceinline__ void prep_matrix(const float* W, int K, int N, bf16_t* Wt, int Nout, int mode, LAS float* scr, int gw, int NGW, int lane) {
    const int nitems = (K / 64) * (Nout / 32);
    for (int it = gw; it < nitems; it += NGW) prep_item(W, K, N, Wt, Nout, mode, scr, it, lane);
}
__device__ __forceinline__ void rms_row_bf16(const float* xrow, const float* g, bf16_t* orow, int lane) {
    const f32x4* xr = (const f32x4*)xrow + lane; const f32x4* gr = (const f32x4*)g + lane;
    f32x4 v[4]; float s = 0.f;
#pragma unroll
    for (int j = 0; j < 4; ++j) { v[j] = xr[64 * j]; s += (v[j].x * v[j].x + v[j].y * v[j].y) + (v[j].z * v[j].z + v[j].w * v[j].w); }
    const float rstd = 1.f / sqrtf(wave_sum(s) * (1.f / D) + EPS);
    unsigned long long* o8 = (unsigned long long*)orow + lane;
#pragma unroll
    for (int j = 0; j < 4; ++j) { const f32x4 gg = gr[64 * j];
        o8[64 * j] = (unsigned long long)pk2(v[j].x * rstd * gg.x, v[j].y * rstd * gg.y) | ((unsigned long long)pk2(v[j].z * rstd * gg.z, v[j].w * rstd * gg.w) << 32); }
}
__device__ __forceinline__ void norm_res_row(const float* yrow, const float* xin, const float* g1, float* xout, const float* g2, bf16_t* hrow, int lane) {
    const f32x4* yr = (const f32x4*)yrow + lane; const f32x4* xr = (const f32x4*)xin + lane;
    f32x4 v[4], xv[4]; float s = 0.f;
#pragma unroll
    for (int j = 0; j < 4; ++j) { v[j] = yr[64 * j]; xv[j] = xr[64 * j]; s += (v[j].x * v[j].x + v[j].y * v[j].y) + (v[j].z * v[j].z + v[j].w * v[j].w); }
    const float rstd = 1.f / sqrtf(wave_sum(s) * (1.f / D) + EPS);
    float s2 = 0.f;
#pragma unroll
    for (int j = 0; j < 4; ++j) { const f32x4 gg = ((const f32x4*)g1 + lane)[64 * j]; xv[j] = xv[j] + v[j] * rstd * gg;
        s2 += (xv[j].x * xv[j].x + xv[j].y * xv[j].y) + (xv[j].z * xv[j].z + xv[j].w * xv[j].w);
        ((f32x4*)xout + lane)[64 * j] = xv[j]; }
    if (g2) {
        const float r2 = 1.f / sqrtf(wave_sum(s2) * (1.f / D) + EPS);
        unsigned long long* o8 = (unsigned long long*)hrow + lane;
#pragma unroll
        for (int j = 0; j < 4; ++j) { const f32x4 gg = ((const f32x4*)g2 + lane)[64 * j];
            o8[64 * j] = (unsigned long long)pk2(xv[j].x * r2 * gg.x, xv[j].y * r2 * gg.y) | ((unsigned long long)pk2(xv[j].z * r2 * gg.z, xv[j].w * r2 * gg.w) << 32); }
    }
}
__device__ __forceinline__ void ph_norm_res(const float* Y, const float* xin, const float* g1, float* xout, const float* g2, bf16_t* H, int wave, int lane) {
    GSTRIDE_WAVES(gw, NGW);
    for (int m = gw; m < M; m += NGW) norm_res_row(Y + (size_t)m * D, xin + (size_t)m * D, g1, xout + (size_t)m * D, g2, H + (size_t)m * D, lane);
}
__device__ __forceinline__ void ph_rope(bf16_t* buf, int ld, const float2* __restrict__ tab, int mode, int nheads) {
    const size_t tot = (size_t)M * nheads * 32;
    const int tid_r = fresh_tid();
    for (size_t idx = (size_t)blockIdx.x * NTHR + tid_r; idx < tot; idx += (size_t)gridDim.x * NTHR) {
        const int i = (int)(idx & 31); const size_t r = idx >> 5; const int hs = (int)(r % nheads); const size_t m = r / nheads;
        int col0;
        if (mode == 0) col0 = 64 * hs; else col0 = (hs < 12) ? 64 * hs : (hs == 12) ? DK : (hs < 21) ? DIQ + 64 * (hs - 13) : DIK;
        bf16_t* p = buf + m * ld + col0 + i; const float2 cs = tab[m * 32 + i];
        const float x1 = bf2f(p[0]), x2 = bf2f(p[32]);
        p[0] = (bf16_t)f2bf(x1 * cs.x - x2 * cs.y); p[32] = (bf16_t)f2bf(x2 * cs.x + x1 * cs.y);
    }
}

__device__ __forceinline__ void ph_attn_diff_naive(const bf16_t* __restrict__ proj, bf16_t* __restrict__ o, const float* __restrict__ lq1, const float* __restrict__ lk1,
                                                   const float* __restrict__ lq2, const float* __restrict__ lk2, const float* __restrict__ gsub) {
    float a1 = 0.f, a2 = 0.f;
    for (int i = 0; i < 64; ++i) { a1 += lq1[i] * lk1[i]; a2 += lq2[i] * lk2[i]; }
    const float lam = expf(a1) - expf(a2) + 0.2f;
    const int tidx = fresh_tid();
    const int half = __builtin_amdgcn_readfirstlane(tidx >> 8), tid = tidx & 255;
    const int NU = NB * 6 * (S / 64);
    for (int u = (int)blockIdx.x * 2 + half; u < NU; u += (int)gridDim.x * 2) {
        const int c = (S / 64 - 1) - (u / (NB * 6)), bh = u % (NB * 6), h = bh % 6, b = bh / 6;
        const int t = c * 64 + (tid >> 2), dq = tid & 3;
        const int nk = 64 * (c + 1);
        float res[32];
#pragma unroll
        for (int br = 0; br < 2; ++br) {
            float q[64];
            const int hs = 2 * h + br;
            const bf16_t* qp = proj + P0_Q + ((size_t)(b * 12 + hs) * S + t) * 64;
#pragma unroll
            for (int d = 0; d < 64; ++d) q[d] = bf2f(qp[d]);
            float acc[32];
#pragma unroll
            for (int i = 0; i < 32; ++i) acc[i] = 0.f;
            float mx = -INFINITY, l = 0.f;
            for (int j = 0; j < nk; ++j) {
                const bf16_t* kp = proj + P0_K + (((size_t)(b * 12 + hs) * 128 + (j >> 6)) * 8) * 512 + (j & 63) * 8;
                const bf16_t* vp = proj + P0_V + (((((size_t)(b * 6 + h) * 128 + (j >> 6)) * 4 + dq) * 64 + (j & 63)) * 32);
                float s = 0.f;
#pragma unroll
                for (int d = 0; d < 64; ++d) s += q[d] * bf2f(kp[(d >> 3) * 512 + (d & 7)]);
                const float mn = fmaxf(mx, s); const float f = exp2f(mx - mn), p = exp2f(s - mn);
                l = l * f + p; mx = mn;
#pragma unroll
                for (int i = 0; i < 32; ++i) acc[i] = acc[i] * f + p * bf2f(vp[i]);
            }
            const float il = 1.f / l;
            if (br == 0) {
#pragma unroll
                for (int i = 0; i < 32; ++i) res[i] = acc[i] * il;
            } else {
#pragma unroll
                for (int i = 0; i < 32; ++i) res[i] -= lam * acc[i] * il;
            }
        }
        float ss = 0.f;
#pragma unroll
        for (int i = 0; i < 32; ++i) ss += res[i] * res[i];
        ss += __shfl_xor(ss, 1); ss += __shfl_xor(ss, 2);
        const float rstd = 1.f / sqrtf(ss * (1.f / 128.f) + EPS);
        bf16_t* op = o + (size_t)(b * S + t) * D + h * 128 + dq * 32;
#pragma unroll
        for (int i = 0; i < 32; ++i) op[i] = (bf16_t)f2bf(res[i] * rstd * gsub[dq * 32 + i] * 0.8f);
    }
}
__device__ __forceinline__ void ph_attn_mem_naive(const bf16_t* __restrict__ qbuf, int qmode, int ld, int qcol0, const bf16_t* __restrict__ kv, bf16_t* __restrict__ o) {
    const int tidx = fresh_tid();
    const int half = __builtin_amdgcn_readfirstlane(tidx >> 8), tid = tidx & 255;
    const int NU = NB * 4 * (S / 64);
    for (int u = (int)blockIdx.x * 2 + half; u < NU; u += (int)gridDim.x * 2) {
        const int c = u % (S / 64), h = (u / (S / 64)) % 4, b = u / ((S / 64) * 4);
        const int t = c * 64 + (tid >> 2), dq = tid & 3;
        float q[64];
        const bf16_t* qp = qmode ? qbuf + ((size_t)(b * 4 + h) * S + t) * 64 : qbuf + (size_t)(b * S + t) * ld + qcol0 + h * 64;
        const float qs = qmode ? 1.f : C2;
#pragma unroll
        for (int d = 0; d < 64; ++d) q[d] = bf2f(qp[d]) * qs;
        float acc[16];
#pragma unroll
        for (int i = 0; i < 16; ++i) acc[i] = 0.f;
        float mx = -INFINITY, l = 0.f;
        for (int j = 0; j < NMEMT; ++j) {
            const bf16_t* kp = kv + MKV_K + (((size_t)(b * 4 + h) * 4 + (j >> 6)) * 8) * 512 + (j & 63) * 8;
            const bf16_t* vp = kv + MKV_V + (((((size_t)(b * 4 + h) * 4 + (j >> 6)) * 2 + (dq >> 1)) * 64 + (j & 63)) * 32) + (dq & 1) * 16;
            float s = 0.f;
#pragma unroll
            for (int d = 0; d < 64; ++d) s += q[d] * bf2f(kp[(d >> 3) * 512 + (d & 7)]);
            const float mn = fmaxf(mx, s); const float f = exp2f(mx - mn), p = exp2f(s - mn);
            l = l * f + p; mx = mn;
#pragma unroll
            for (int i = 0; i < 16; ++i) acc[i] = acc[i] * f + p * bf2f(vp[i]);
        }
        const float il = 1.f / l;
        bf16_t* op = o + (size_t)(b * S + t) * D + 768 + h * 64 + dq * 16;
#pragma unroll
        for (int i = 0; i < 16; ++i) op[i] = (bf16_t)f2bf(acc[i] * il);
    }
}
__device__ __forceinline__ unsigned f2key(float f) { const unsigned u = __float_as_uint(f); return (u & 0x80000000u) ? ~u : (u | 0x80000000u); }
__device__ __forceinline__ void ph_topk_naive(const bf16_t* __restrict__ proj, unsigned short* __restrict__ topk, LAS unsigned char* lds) {
    LAS unsigned* keys = (LAS unsigned*)lds;
    LAS float* iqs = (LAS float*)(lds + 32768);
    LAS float* ws = (LAS float*)(lds + 32768 + 2048);
    LAS unsigned* cnt_s = (LAS unsigned*)(lds + 32768 + 2048 + 64);
    LAS unsigned* scan_g = (LAS unsigned*)(lds + 36864);
    LAS unsigned* scan_e = (LAS unsigned*)(lds + 36864 + 2048);
    const int tid = fresh_tid();
    for (int m = blockIdx.x; m < M; m += gridDim.x) {
        const int b = m / S, t = m % S; const int c = t / 64; const int n = 64 * (c + 1);
        unsigned short* out = topk + (size_t)m * 256;
        if (n <= 256) { if (tid < 256) out[tid] = (tid < n) ? (unsigned short)tid : (unsigned short)0xFFFFu; continue; }
        const bf16_t* row = proj + (size_t)m * NDSA;
        __syncthreads();
        iqs[tid] = bf2f(row[DIQ + tid]);
        if (tid < 8) ws[tid] = bf2f(row[DIW + tid]) * 0.04419417382415922f;
        __syncthreads();
        for (int j = tid; j < n; j += NTHR) {
            const bf16_t* kp = proj + (size_t)(b * S + j) * NDSA + DIK;
            float kf[64];
#pragma unroll
            for (int d = 0; d < 64; ++d) kf[d] = bf2f(kp[d]);
            float sc = 0.f;
#pragma unroll 1
            for (int hh = 0; hh < 8; ++hh) { float lg = 0.f;
#pragma unroll
                for (int d = 0; d < 64; ++d) lg += iqs[hh * 64 + d] * kf[d];
                sc += fmaxf(lg, 0.f) * ws[hh]; }
            sc += 0.0f;
            keys[j] = f2key(sc);
        }
        __syncthreads();
        unsigned T = 0u;
        for (int bit = 31; bit >= 0; --bit) {
            const unsigned cand = T | (1u << bit);
            if (tid == 0) cnt_s[0] = 0u;
            __syncthreads();
            unsigned c0 = 0u;
            for (int j = tid; j < n; j += NTHR) c0 += (keys[j] >= cand) ? 1u : 0u;
            c0 = (unsigned)wave_sum((float)c0);
            if ((tid & 63) == 0) atomicAdd((unsigned*)cnt_s, c0);
            __syncthreads();
            if (cnt_s[0] >= 256u) T = cand;
            __syncthreads();
        }
        const int per = (n + NTHR - 1) / NTHR; const int j0 = tid * per, j1 = (j0 + per < n) ? j0 + per : n;
        unsigned g = 0u, e = 0u;
        for (int j = j0; j < j1; ++j) { const unsigned k = keys[j]; g += (k > T) ? 1u : 0u; e += (k == T) ? 1u : 0u; }
        scan_g[tid] = g; scan_e[tid] = e;
        __syncthreads();
        unsigned pg = 0u, pe = 0u, tg = 0u;
        for (int i = 0; i < NTHR; ++i) { const unsigned gi = scan_g[i], ei = scan_e[i]; if (i < tid) { pg += gi; pe += ei; } tg += gi; }
        const unsigned R = 256u - tg;
        unsigned og = pg, oe = pe;
        for (int j = j0; j < j1; ++j) { const unsigned k = keys[j];
            if (k > T) { out[og] = (unsigned short)j; ++og; }
            else if (k == T) { if (oe < R) out[tg + oe] = (unsigned short)j; ++oe; } }
    }
}
__device__ __forceinline__ void ph_dsa_attn_naive(const bf16_t* __restrict__ proj, const unsigned short* __restrict__ topk, bf16_t* __restrict__ o, int wave, int lane) {
    GSTRIDE_WAVES(gw, NGW);
    const int hd = (lane < 48) ? (lane >> 2) : 0, dq = lane & 3;
    for (int m = gw; m < M; m += NGW) {
        const int b = m / S;
        const bf16_t* row = proj + (size_t)m * NDSA;
        float q[64];
#pragma unroll
        for (int d = 0; d < 64; ++d) q[d] = bf2f(row[DQ + hd * 64 + d]) * C2;
        float acc[16];
#pragma unroll
        for (int i = 0; i < 16; ++i) acc[i] = 0.f;
        float mx = -INFINITY, l = 0.f;
        const unsigned short* ix = topk + (size_t)m * 256;
        for (int jj = 0; jj < 256; ++jj) {
            const unsigned j = ix[jj]; if (j == 0xFFFFu) continue;
            const bf16_t* kp = proj + (size_t)(b * S + j) * NDSA + DK;
            const bf16_t* vp = proj + (size_t)(b * S + j) * NDSA + DV + dq * 16;
            float s = 0.f;
#pragma unroll
            for (int d = 0; d < 64; ++d) s += q[d] * bf2f(kp[d]);
            const float mn = fmaxf(mx, s); const float f = exp2f(mx - mn), p = exp2f(s - mn);
            l = l * f + p; mx = mn;
#pragma unroll
            for (int i = 0; i < 16; ++i) acc[i] = acc[i] * f + p * bf2f(vp[i]);
        }
        if (lane < 48) {
            const float il = 1.f / l;
            bf16_t* op = o + (size_t)m * D + hd * 64 + dq * 16;
#pragma unroll
            for (int i = 0; i < 16; ++i) op[i] = (bf16_t)f2bf(acc[i] * il);
        }
    }
}

__device__ __forceinline__ void ph_attn_diff(const bf16_t* P, bf16_t* O, const float* lq1, const float* lk1, const float* lq2, const float* lk2, const float* gsub, LAS unsigned char* lds) {
    float a1 = 0.f, a2 = 0.f;
    for (int i = 0; i < 64; ++i) { a1 += lq1[i] * lk1[i]; a2 += lq2[i] * lk2[i]; }
    const float lam = expf(a1) - expf(a2) + 0.2f;
    const int G = (int)gridDim.x, bid = (int)blockIdx.x; const int vcu = (G % 8 == 0) ? (bid % 8) * (G / 8) + bid / 8 : bid;
    for (int i = 0; ; ++i) {
        const int pu = vcu + (i >> 1) * G; if (pu >= NB * 6 * 32) break;
        const int bh = pu >> 5, pair = pu & 31, b = bh / 6, h = bh % 6; const int qblk = (i & 1) ? pair : 63 - pair;
        fa::Unit U;
        U.q0 = P + P0_Q + (size_t)(b * 12 + 2 * h) * S * 64; U.q1 = U.q0 + (size_t)S * 64;
        U.k0 = P + P0_K + (size_t)(b * 12 + 2 * h) * S * 64; U.k1 = U.k0 + (size_t)S * 64;
        U.v = P + P0_V + (size_t)(b * 6 + h) * S * 128; U.qrow0 = qblk * 128; U.nt = 2 * qblk + 2;
        fa::attn_unit<2, 128>(U, true, O, b * S, h * 128, lam, gsub, 0.8f, lds);
    }
}
__device__ __forceinline__ void ph_attn_mem(const bf16_t* QM, const bf16_t* kv, bf16_t* O, LAS unsigned char* lds) {
    for (int u = (int)blockIdx.x; u < NB * 4 * (S / 256); u += (int)gridDim.x) {
        const int b = u >> 7, mh = (u >> 5) & 3, qb = u & 31;
        fa::Unit U;
        U.q0 = QM + (size_t)(b * 4 + mh) * S * 64; U.q1 = U.q0;
        U.k0 = kv + MKV_K + (size_t)(b * 4 + mh) * NMEMT * 64; U.k1 = U.k0;
        U.v = kv + MKV_V + (size_t)(b * 4 + mh) * NMEMT * 64; U.qrow0 = qb * 256; U.nt = 4;
        fa::attn_unit<1, 64>(U, false, O, b * S, 768 + mh * 64, 0.f, nullptr, 1.f, lds);
    }
}

#define GEMM_PHASE(EPI, Aptr, Bptr, Mr, Nn, Kk, ...) do { pg8::Gemm g_{(Aptr), (Bptr), (Mr), (Nn), (Kk)}; pg8::StaticOrder S_; S_.init((Mr), (Nn), (int)gridDim.x, (int)blockIdx.x); \
    EPI E_{__VA_ARGS__}; pg8::gemm_phase<EPI, pg8::StaticOrder, true, true>(lds, g_, S_, E_); } while (0)

__global__ void __launch_bounds__(NTHR, 2) mk_fwd(Args args) {
    extern __shared__ __attribute__((aligned(16))) unsigned char lds_raw[];
    LAS unsigned char* lds = (LAS unsigned char*)lds_raw;
    unsigned char* ws = args.ws; float* out = args.out;
    const float* x = (const float*)args.in[0]; const float* mem = (const float*)args.in[1]; const int* pos = (const int*)args.in[2];
    const float* g_pre_mix = (const float*)args.in[3]; const float* g_post_mix = (const float*)args.in[4]; const float* g_mem = (const float*)args.in[5];
    const float* w_mem_kv = (const float*)args.in[6]; const float* w_out = (const float*)args.in[7]; const float* g_pre_mlp = (const float*)args.in[8];
    const float* g_post_mlp = (const float*)args.in[9]; const float* w_up = (const float*)args.in[10]; const float* w_dn = (const float*)args.in[11];
    const float* w_in_diff = (const float*)args.in[12]; const float* lq1 = (const float*)args.in[13]; const float* lk1 = (const float*)args.in[14];
    const float* lq2 = (const float*)args.in[15]; const float* lk2 = (const float*)args.in[16]; const float* gsub = (const float*)args.in[17]; const float* w_in_dsa = (const float*)args.in[18];
    bf16_t* Win0 = (bf16_t*)(ws + WS_WIN0); bf16_t* Win1 = (bf16_t*)(ws + WS_WIN1); bf16_t* Wout = (bf16_t*)(ws + WS_WOUT);
    bf16_t* Wup = (bf16_t*)(ws + WS_WUP); bf16_t* Wdn = (bf16_t*)(ws + WS_WDN); bf16_t* Wkv = (bf16_t*)(ws + WS_WKV);
    bf16_t* memn = (bf16_t*)(ws + WS_MEMN); bf16_t* memkv = (bf16_t*)(ws + WS_MEMKV); float2* rope = (float2*)(ws + WS_ROPE);
    unsigned short* topk = (unsigned short*)(ws + WS_TOPK); bf16_t* H = (bf16_t*)(ws + WS_H); bf16_t* proj = (bf16_t*)(ws + WS_PROJ);
    bf16_t* O = (bf16_t*)(ws + WS_O); bf16_t* hid = (bf16_t*)(ws + WS_HID); float* Y = (float*)(ws + WS_Y);
    gu32* ctl = (gu32*)(ws + WS_CTL);

    for (int u = threadIdx.x; u < (LDS_BYTES - LDSCTL_OFF) / 4; u += NTHR) ((LAS unsigned*)(lds + LDSCTL_OFF))[u] = 0u;
    __syncthreads();
    XcdBarrier bar = xcd_barrier_post((unsigned*)(ctl + CW_BAR), (volatile LAS unsigned*)(lds + LDSCTL_OFF + 64));
#define GRID_BAR() xcd_barrier(bar)

    {
        FRESH_IDS;
        LAS float* scr = (LAS float*)(lds + wave * 16384);
        GSTRIDE_WAVES(gw, NGW);
        prep_matrix(w_in_diff, D, NDIFF, Win0, NDIFF, 1, scr, gw, NGW, lane);
        prep_matrix(w_in_dsa, D, NDSA_L, Win1, NDSA, 0, scr, gw, NGW, lane);
#pragma unroll 1
        for (int l = 0; l < 2; ++l) {
            prep_matrix(w_out + (size_t)l * D * D, D, D, Wout + (size_t)l * D * D, D, 0, scr, gw, NGW, lane);
            prep_matrix(w_up + (size_t)l * D * FF, D, FF, Wup + (size_t)l * D * FF, FF, 0, scr, gw, NGW, lane);
            prep_matrix(w_dn + (size_t)l * D * FF, FF, D, Wdn + (size_t)l * D * FF, D, 0, scr, gw, NGW, lane);
            prep_matrix(w_mem_kv + (size_t)l * D * 512, D, 512, Wkv + (size_t)l * D * 512, 512, 1, scr, gw, NGW, lane);
            for (int m = gw; m < NB * NMEMT; m += NGW) rms_row_bf16(mem + (size_t)m * D, g_mem + l * D, memn + ((size_t)l * NB * NMEMT + m) * D, lane);
        }
        for (int idx = (int)blockIdx.x * NTHR + tid; idx < M * 32; idx += (int)gridDim.x * NTHR) {
            const int m = idx >> 5, i = idx & 31;
            const double inv = pow(10000.0, -(double)i / 32.0); const double ang = (double)pos[m] * inv;
            rope[idx] = make_float2((float)cos(ang), (float)sin(ang));
        }
        for (int m = gw; m < M; m += NGW) rms_row_bf16(x + (size_t)m * D, g_pre_mix, H + (size_t)m * D, lane);
    }
    GRID_BAR();
    GEMM_PHASE(EpiMemKV, memn, Wkv, NB * NMEMT, 512, D, memkv);
    GEMM_PHASE(EpiMemKV, memn + (size_t)NB * NMEMT * D, Wkv + (size_t)D * 512, NB * NMEMT, 512, D, memkv + MKV_LAYER);
    GEMM_PHASE(EpiProj0, H, Win0, M, NDIFF, D, proj, rope);
    GRID_BAR();
    ph_attn_diff(proj, O, lq1, lk1, lq2, lk2, gsub, lds);
    ph_attn_mem(proj + P0_QM, memkv, O, lds);
    GRID_BAR();
    GEMM_PHASE(EpiF, O, Wout, M, D, D, Y, D);
    GRID_BAR();
    { FRESH_IDS; ph_norm_res(Y, x, g_post_mix, out, g_pre_mlp, H, wave, lane); }
    GRID_BAR();
    GEMM_PHASE(EpiB<2>, H, Wup, M, FF, D, hid, FF);
    GRID_BAR();
    GEMM_PHASE(EpiF, hid, Wdn, M, D, FF, Y, D);
    GRID_BAR();
    { FRESH_IDS; ph_norm_res(Y, out, g_post_mlp, out, g_pre_mix + D, H, wave, lane); }
    GRID_BAR();
    GEMM_PHASE(EpiB<0>, H, Win1, M, NDSA, D, proj, NDSA);
    GRID_BAR();
    ph_rope(proj, NDSA, rope, 1, 22);
    GRID_BAR();
    ph_topk_naive(proj, topk, lds);
    GRID_BAR();
    { FRESH_IDS; ph_dsa_attn_naive(proj, topk, O, wave, lane); }
    ph_attn_mem_naive(proj, 0, NDSA, DQM, memkv + MKV_LAYER, O);
    GRID_BAR();
    GEMM_PHASE(EpiF, O, Wout + (size_t)D * D, M, D, D, Y, D);
    GRID_BAR();
    { FRESH_IDS; ph_norm_res(Y, out, g_post_mix + D, out, g_pre_mlp + D, H, wave, lane); }
    GRID_BAR();
    GEMM_PHASE(EpiB<2>, H, Wup + (size_t)D * FF, M, FF, D, hid, FF);
    GRID_BAR();
    GEMM_PHASE(EpiF, hid, Wdn + (size_t)D * FF, M, D, FF, Y, D);
    GRID_BAR();
    { FRESH_IDS; ph_norm_res(Y, out, g_post_mlp + D, out, (const float*)nullptr, H, wave, lane); }
}

extern "C" void kernel_launch(void* const* d_in, const int* in_sizes, int n_in, void* d_out, int out_size, void* d_ws, size_t ws_size, hipStream_t stream) {
    static int grid = 0;
    if (grid == 0) {
        if (n_in != 19 || out_size != M * D || ws_size < WS_END) { fprintf(stderr, "kernel_launch: unexpected shapes n_in %d out %d ws %zu\n", n_in, out_size, ws_size); grid = -1; return; }
        int dev = 0, cus = 0, per_cu = 0;
        if (hipGetDevice(&dev) != hipSuccess || hipDeviceGetAttribute(&cus, hipDeviceAttributeMultiprocessorCount, dev) != hipSuccess) { grid = -1; return; }
        if (hipFuncSetAttribute((const void*)mk_fwd, hipFuncAttributeMaxDynamicSharedMemorySize, LDS_BYTES) != hipSuccess) { fprintf(stderr, "kernel_launch: hipFuncSetAttribute failed\n"); grid = -1; return; }
        if (hipOccupancyMaxActiveBlocksPerMultiprocessor(&per_cu, (const void*)mk_fwd, NTHR, LDS_BYTES) != hipSuccess || per_cu < 1) { fprintf(stderr, "kernel_launch: occupancy query says %d blocks per CU\n", per_cu); grid = -1; (void)hipGetLastError(); return; }
        grid = cus;
    }
    if (grid < 0) return;
    (void)hipMemsetAsync((char*)d_ws + WS_CTL, 0, CTL_ZERO_BYTES, stream);
    Args a; memset(&a, 0, sizeof(a));
    for (int i = 0; i < 19; ++i) a.in[i] = d_in[i];
    a.out = (float*)d_out; a.ws = (unsigned char*)d_ws;
    hipLaunchKernelGGL(mk_fwd, dim3(grid), dim3(NTHR), LDS_BYTES, stream, a);
}
```

```cpp
#include <hip/hip_runtime.h>
#include <cstdio>
#include <cstdint>
#include <cstring>
namespace pg8 {
#define PG8_LAS __attribute__((address_space(3)))
typedef unsigned short bf16_t;
typedef short bf16x8 __attribute__((ext_vector_type(8)));
typedef float f32x4 __attribute__((ext_vector_type(4)));
typedef unsigned u32x4 __attribute__((ext_vector_type(4)));
constexpr int BM = 256, BK = 64, HALF = 128, HTB = HALF * BK * 2  , STAGE_BYTES = 8 * HTB, NXCD = 8, WGM = 8;

__host__ __device__ __forceinline__ int lds_byte(int r, int c) { const int st = (r >> 4) * 2 + (c >> 5), rr = r & 15, cc = c & 31, ob = rr * 64 + cc * 2; return st * 1024 + (ob ^ (((ob >> 9) & 1) << 5)); }
__host__ __device__ __forceinline__ void stage_rc(int b, int& R, int& C) { const int st = b / 1024, sb = b % 1024, swz = sb ^ (((sb >> 9) & 1) << 5); R = (st >> 1) * 16 + swz / 64; C = (st & 1) * 32 + (swz % 64) / 2; }
__host__ __device__ __forceinline__ int perm32(int rho) { const int n = rho >> 4, i = rho & 15; return 8 * (i >> 2) + 4 * n + (i & 3); }

struct Unit { int pm, pn; };
struct Gemm { const bf16_t* A; const bf16_t* Bt; int M, N, K; };

struct StaticOrder {
    int nM, nN, nwg, G, c;
    __host__ __device__ void init(int M, int N, int G_, int c_) { nM = M / BM; nN = N / BM; nwg = nM * nN; G = G_; c = c_; }
    __host__ __device__ bool next(int i, Unit& u) const {
        const long L = (long)i * G + c; if (L >= nwg) return false;
        int wgid = (int)L; { const int q = nwg / NXCD, r = nwg % NXCD, xcd = wgid % NXCD, off = wgid / NXCD; wgid = (xcd < r ? xcd * (q + 1) : r * (q + 1) + (xcd - r) * q) + off; }
        const int nig = WGM * nN, gid = wgid / nig, fm = gid * WGM, gsz = (nM - fm) < WGM ? (nM - fm) : WGM;
        u.pm = fm + ((wgid % nig) % gsz); u.pn = (wgid % nig) / gsz; return true;
    }
    __device__ __forceinline__ void a_ready(const Unit&) const {}
    __device__ __forceinline__ void done(const Unit&) const {}
};

__device__ __forceinline__ unsigned cvt_pk_bf16(float lo, float hi) { unsigned r; asm volatile("v_cvt_pk_bf16_f32 %0, %1, %2" : "=v"(r) : "v"(lo), "v"(hi)); return r; }
typedef float f32x2 __attribute__((ext_vector_type(2)));
__device__ __forceinline__ f32x2 gelu_pk(f32x2 v) {
    const f32x2 av = __builtin_elementwise_abs(v), d = av * 0.2316418882f + 1.0f;
    f32x2 t; t.x = __builtin_amdgcn_rcpf(d.x); t.y = __builtin_amdgcn_rcpf(d.y);
    f32x2 q = t * 0.5307027145f + (-0.7265760135f); q = q * t + 0.7107068705f; q = q * t + (-0.142248368f); q = q * t + 0.127414796f; q = q * t;
    const f32x2 s = (v * v) * (-0.72134752044f);
    f32x2 e; e.x = __builtin_amdgcn_exp2f(s.x); e.y = __builtin_amdgcn_exp2f(s.y);
    const f32x2 m = v * (q * e), r = v - m;
    f32x2 o; o.x = v.x < 0.f ? m.x : r.x; o.y = v.y < 0.f ? m.y : r.y; return o;
}

template <int ACT  > struct EpiBf16 {
    static constexpr bool PERM = true, AFTER_DRAIN = false; static_assert(ACT == 0 || ACT == 1, "EpiBf16: ACT is 0 (none) or 1 (gelu_pk)");
    bf16_t* O; int ldc; const float* bias; int split_cols; size_t split_stride; float scale0;
    __device__ __forceinline__ void operator()(const f32x4 (&acc)[2][2][4][2], const Unit& u, int wr, int wc, int fr, int fq) const {
        const int row0 = u.pm * BM + wr * 64 + fr; int colt = u.pn * BM; bf16_t* base = O;
        float sc = 1.f; if (split_cols) { const int t = colt / split_cols; base += (size_t)t * split_stride; colt -= t * split_cols; if (t == 0) sc = scale0; }
        const int col0 = colt + wc * 32 + 8 * fq, bcol0 = u.pn * BM + wc * 32 + 8 * fq;
        f32x4 bv[2][2];
#pragma unroll
        for (int bj = 0; bj < 2; ++bj)
#pragma unroll
            for (int n = 0; n < 2; ++n) bv[bj][n] = bias ? *(const f32x4*)(bias + bcol0 + bj * HALF + 4 * n) : (f32x4){0.f, 0.f, 0.f, 0.f};
#pragma unroll
        for (int ai = 0; ai < 2; ++ai)
#pragma unroll
            for (int m = 0; m < 4; ++m) { bf16_t* rowp = base + (size_t)(row0 + ai * HALF + m * 16) * ldc + col0;
#pragma unroll
                for (int bj = 0; bj < 2; ++bj) { f32x4 v0 = acc[ai][bj][m][0] + bv[bj][0], v1 = acc[ai][bj][m][1] + bv[bj][1];
                    if (ACT == 1) { f32x2 a = gelu_pk((f32x2){v0[0], v0[1]}), b = gelu_pk((f32x2){v0[2], v0[3]}), c = gelu_pk((f32x2){v1[0], v1[1]}), d = gelu_pk((f32x2){v1[2], v1[3]});
                        v0 = (f32x4){a.x, a.y, b.x, b.y}; v1 = (f32x4){c.x, c.y, d.x, d.y}; }
                    v0 = v0 * sc; v1 = v1 * sc; u32x4 w; w.x = cvt_pk_bf16(v0[0], v0[1]); w.y = cvt_pk_bf16(v0[2], v0[3]); w.z = cvt_pk_bf16(v1[0], v1[1]); w.w = cvt_pk_bf16(v1[2], v1[3]);
                    *(u32x4*)(rowp + bj * HALF) = w; } }
    }
};

struct PanelStats {
    unsigned* xbuf;
    unsigned* cnt;
    unsigned* tmo;
    int ntn; float eps;
    unsigned code;
    __device__ __forceinline__ bool run(const f32x4 (&v)[2][2][4][2], const Unit& u, int wr, int wc, int fr, int fq, PG8_LAS unsigned char* lds, int wid, int lane) const {
        typedef float f32x2v __attribute__((ext_vector_type(2)));
        PG8_LAS f32x2v* P = (PG8_LAS f32x2v*)lds;
        PG8_LAS f32x2v* S = (PG8_LAS f32x2v*)(lds + 8192);
        PG8_LAS unsigned* flag = (PG8_LAS unsigned*)(lds + 8192 + 2048);
#pragma unroll
        for (int ai = 0; ai < 2; ++ai)
#pragma unroll
            for (int m = 0; m < 4; ++m) {
                float s = 0.f;
#pragma unroll
                for (int bj = 0; bj < 2; ++bj)
#pragma unroll
                    for (int n = 0; n < 2; ++n) { const f32x4 x = v[ai][bj][m][n]; s += (x[0] + x[1]) + (x[2] + x[3]); }
                s += __shfl_xor(s, 16); s += __shfl_xor(s, 32);
                const float mw = s * (1.0f / 64.0f); float q = 0.f;
#pragma unroll
                for (int bj = 0; bj < 2; ++bj)
#pragma unroll
                    for (int n = 0; n < 2; ++n) { const f32x4 d = v[ai][bj][m][n] - mw; q += (d[0] * d[0] + d[1] * d[1]) + (d[2] * d[2] + d[3] * d[3]); }
                q += __shfl_xor(q, 16); q += __shfl_xor(q, 32);
                if (fq == 0) P[(ai * HALF + wr * 64 + m * 16 + fr) * 4 + wc] = (f32x2v){mw, q};
            }
        asm volatile("s_waitcnt lgkmcnt(0)" ::: "memory"); __builtin_amdgcn_s_barrier(); asm volatile("" ::: "memory");
#if defined(BROKEN_EXCHANGE_NO_WAIT)
#warning BROKEN CONTROL BUILD: the row-statistics exchange does not wait; results are wrong by design
        if (blockIdx.x >= 64) { const long long t0_ = clock64(); while (clock64() - t0_ < 60000) __builtin_amdgcn_s_sleep(8); }
#endif
        const int row = wid * 32 + (lane & 31);
        if (lane < 32) {
            const f32x2v a = P[row * 4 + 0], b = P[row * 4 + 1], c = P[row * 4 + 2], d = P[row * 4 + 3];
            const float mt = (a.x + b.x + c.x + d.x) * 0.25f;
            const float da = a.x - mt, db = b.x - mt, dc = c.x - mt, dd = d.x - mt;
            const float m2 = (a.y + b.y) + (c.y + d.y) + 64.0f * ((da * da + db * db) + (dc * dc + dd * dd));
            unsigned long long* slot = (unsigned long long*)xbuf + ((size_t)(u.pm * BM + row) * 4 + u.pn);
            __hip_atomic_store(slot, ((unsigned long long)__float_as_uint(m2) << 32) | __float_as_uint(mt), __ATOMIC_RELAXED, __HIP_MEMORY_SCOPE_AGENT);
        }
        asm volatile("s_waitcnt vmcnt(0)" ::: "memory");
        if (lane == 0) __hip_atomic_fetch_add(cnt + 64 * u.pm, 1u, __ATOMIC_RELAXED, __HIP_MEMORY_SCOPE_AGENT);
        if (wid == 0) {
            bool dead = false; const unsigned long long t0 = __builtin_amdgcn_s_memrealtime(); const unsigned want = 8u * (unsigned)ntn;
            for (;;) {
#if defined(BROKEN_EXCHANGE_NO_WAIT)
                break;
#endif
                if ((unsigned)__builtin_amdgcn_readfirstlane(__hip_atomic_load(cnt + 64 * u.pm, __ATOMIC_RELAXED, __HIP_MEMORY_SCOPE_AGENT)) >= want) break;
                if (__builtin_amdgcn_s_memrealtime() - t0 > 2000000ull) {
                    if (lane == 0) { unsigned expect = 0u; __hip_atomic_compare_exchange_strong(tmo + 1, &expect, code | (unsigned)(u.pm & 0xff), __ATOMIC_RELAXED, __ATOMIC_RELAXED, __HIP_MEMORY_SCOPE_AGENT);
                                     __hip_atomic_store(tmo, 1u, __ATOMIC_RELAXED, __HIP_MEMORY_SCOPE_AGENT); }
                    dead = true; break; }
                __builtin_amdgcn_s_sleep(2);
            }
            __builtin_amdgcn_fence(__ATOMIC_ACQUIRE, "agent");
            if (lane == 0) flag[0] = dead ? 1u : 0u;
        }
        asm volatile("s_waitcnt vmcnt(0) lgkmcnt(0)" ::: "memory"); __builtin_amdgcn_s_barrier(); asm volatile("" ::: "memory");
        const bool bad = flag[0] != 0u;
        if (lane < 32) {
            const unsigned long long* slot = (const unsigned long long*)xbuf + (size_t)(u.pm * BM + row) * 4; float mt[4], m2[4]; float ms = 0.f;
#pragma unroll
            for (int t = 0; t < 4; ++t) { if (t < ntn) { const unsigned long long w = __hip_atomic_load(slot + t, __ATOMIC_RELAXED, __HIP_MEMORY_SCOPE_AGENT); mt[t] = __uint_as_float((unsigned)w); m2[t] = __uint_as_float((unsigned)(w >> 32)); } else { mt[t] = 0.f; m2[t] = 0.f; } ms += mt[t]; }
            const float mean = ms / (float)ntn; float q = 0.f;
#pragma unroll
            for (int t = 0; t < 4; ++t) if (t < ntn) { const float dm = mt[t] - mean; q += m2[t] + 256.0f * dm * dm; }
            S[row] = (f32x2v){mean, 1.0f / sqrtf(q / (256.0f * (float)ntn) + eps)};
        }
        asm volatile("s_waitcnt lgkmcnt(0)" ::: "memory"); __builtin_amdgcn_s_barrier(); asm volatile("" ::: "memory");
        return bad;
    }
};
struct EpiLnRes {
    static constexpr bool PERM = false, AFTER_DRAIN = true;
    const float* base; float* out; int ldc; const float* bias; PanelStats st; unsigned poison;
    __device__ __forceinline__ void fused(f32x4 (&acc)[2][2][4][2], const Unit& u, int wr, int wc, int fr, int fq, PG8_LAS unsigned char* lds, int wid, int lane) const {
        typedef float f32x2v __attribute__((ext_vector_type(2)));
        const PG8_LAS f32x2v* S = (const PG8_LAS f32x2v*)(lds + 8192);
        const int col0 = u.pn * BM + wc * 32 + 4 * fq;
#pragma unroll
        for (int bj = 0; bj < 2; ++bj)
#pragma unroll
            for (int n = 0; n < 2; ++n) { const f32x4 bv = bias ? *(const f32x4*)(bias + col0 + bj * HALF + n * 16) : (f32x4){0.f, 0.f, 0.f, 0.f};
#pragma unroll
                for (int ai = 0; ai < 2; ++ai)
#pragma unroll
                    for (int m = 0; m < 4; ++m) acc[ai][bj][m][n] += bv; }
        f32x4 pre[4][2][2];
#pragma unroll
        for (int m = 0; m < 4; ++m) { const size_t off = (size_t)(u.pm * BM + wr * 64 + m * 16 + fr) * ldc + col0;
#pragma unroll
            for (int bj = 0; bj < 2; ++bj)
#pragma unroll
                for (int n = 0; n < 2; ++n) pre[m][bj][n] = *(const f32x4*)(base + off + bj * HALF + n * 16); }
        const bool bad = st.run(acc, u, wr, wc, fr, fq, lds, wid, lane) || poison != 0u;
        const float qnan = __builtin_nanf("");
#pragma unroll
        for (int ai = 0; ai < 2; ++ai)
#pragma unroll
            for (int m = 0; m < 4; ++m) { const int r = ai * HALF + wr * 64 + m * 16 + fr; const f32x2v sr = S[r]; const size_t off = (size_t)(u.pm * BM + r) * ldc + col0;
#pragma unroll
                for (int bj = 0; bj < 2; ++bj)
#pragma unroll
                    for (int n = 0; n < 2; ++n) { const f32x4 bs = ai == 0 ? pre[m][bj][n] : *(const f32x4*)(base + off + bj * HALF + n * 16); f32x4 o = bs + (acc[ai][bj][m][n] - sr.x) * sr.y;
                        if (bad) o = (f32x4){qnan, qnan, qnan, qnan}; *(f32x4*)(out + off + bj * HALF + n * 16) = o; }
                if (m & 1) asm volatile("" ::: "memory"); }
    }
};
struct EpiLnResLn {
    static constexpr bool PERM = false, AFTER_DRAIN = true;
    const float* base; float* out; bf16_t* xn; int ldc; const float* bias; PanelStats st1, st2; unsigned poison;
    __device__ __forceinline__ void fused(f32x4 (&acc)[2][2][4][2], const Unit& u, int wr, int wc, int fr, int fq, PG8_LAS unsigned char* lds, int wid, int lane) const {
        typedef float f32x2v __attribute__((ext_vector_type(2))); typedef unsigned u32x2v __attribute__((ext_vector_type(2)));
        const PG8_LAS f32x2v* S = (const PG8_LAS f32x2v*)(lds + 8192);
        const int col0 = u.pn * BM + wc * 32 + 4 * fq;
#pragma unroll
        for (int bj = 0; bj < 2; ++bj)
#pragma unroll
            for (int n = 0; n < 2; ++n) { const f32x4 bv = bias ? *(const f32x4*)(bias + col0 + bj * HALF + n * 16) : (f32x4){0.f, 0.f, 0.f, 0.f};
#pragma unroll
                for (int ai = 0; ai < 2; ++ai)
#pragma unroll
                    for (int m = 0; m < 4; ++m) acc[ai][bj][m][n] += bv; }
        bool bad = st1.run(acc, u, wr, wc, fr, fq, lds, wid, lane) || poison != 0u;
        const float qnan = __builtin_nanf("");
#pragma unroll
        for (int ai = 0; ai < 2; ++ai)
#pragma unroll
            for (int m = 0; m < 4; ++m) { const int r = ai * HALF + wr * 64 + m * 16 + fr; const f32x2v sr = S[r]; const size_t off = (size_t)(u.pm * BM + r) * ldc + col0;
#pragma unroll
                for (int bj = 0; bj < 2; ++bj)
#pragma unroll
                    for (int n = 0; n < 2; ++n) { const f32x4 bs = *(const f32x4*)(base + off + bj * HALF + n * 16); acc[ai][bj][m][n] = bs + (acc[ai][bj][m][n] - sr.x) * sr.y; }
                asm volatile("" : "+v"(acc[ai][0][m][0]), "+v"(acc[ai][0][m][1]), "+v"(acc[ai][1][m][0]), "+v"(acc[ai][1][m][1]));
                if (m & 1) asm volatile("" ::: "memory"); }
        const bool bad1 = bad;
        bad = st2.run(acc, u, wr, wc, fr, fq, lds, wid, lane) || bad;
#pragma unroll
        for (int ai = 0; ai < 2; ++ai)
#pragma unroll
            for (int m = 0; m < 4; ++m) { const int r = ai * HALF + wr * 64 + m * 16 + fr; const f32x2v sr = S[r]; const size_t off = (size_t)(u.pm * BM + r) * ldc + col0;
#pragma unroll
                for (int bj = 0; bj < 2; ++bj)
#pragma unroll
                    for (int n = 0; n < 2; ++n) { const f32x4 x1 = acc[ai][bj][m][n]; *(f32x4*)(out + off + bj * HALF + n * 16) = bad1 ? (f32x4){qnan, qnan, qnan, qnan} : x1;
                        const f32x4 o = (x1 - sr.x) * sr.y; u32x2v w; w.x = cvt_pk_bf16(o[0], o[1]); w.y = cvt_pk_bf16(o[2], o[3]);
                        if (bad) { w.x = 0x7fc07fc0u; w.y = 0x7fc07fc0u; } *(u32x2v*)(xn + off + bj * HALF + n * 16) = w; }
                asm volatile("" ::: "memory"); }
    }
};

template <class Epi, class Sched, bool ALIGN_EPI = false, bool SP2 = false>
__device__ __forceinline__ void gemm_phase(PG8_LAS unsigned char* lds, const Gemm g, const Sched& S, const Epi& E) {
    int tid_ = threadIdx.x; asm volatile("" : "+v"(tid_));
    const int tid = tid_, wid = __builtin_amdgcn_readfirstlane(tid >> 6), lane = tid & 63, wr = wid >> 2, wc = wid & 3, fr = lane & 15, fq = lane >> 4;
    const int K = g.K, nt = K / BK;
    unsigned voffA[2], voffB[2];
#pragma unroll
    for (int i = 0; i < 2; ++i) { int R, C; stage_rc(tid * 16 + i * 8192, R, C); const int Rb = Epi::PERM ? ((R & ~31) + perm32(R & 31)) : R;
        voffA[i] = (unsigned)(R * K + C) * 2u; voffB[i] = (unsigned)(Rb * K + C) * 2u; }
    const size_t kstep = (size_t)(BK * 2);
    const size_t hstep = (size_t)HALF * K * 2;
    const size_t tstep = 2 * hstep;
    const unsigned ldsw = (unsigned)wid * 1024u;
    const int aoff = lds_byte(wr * 64 + fr, fq * 8), boff = lds_byte(wc * 32 + fr, fq * 8);
#define PG8_SA(b, h) (((b) * 2 + (h)) * HTB)
#define PG8_SB(b, h) ((4 + (b) * 2 + (h)) * HTB)
#define PG8_STAGE(bufoff, gbase, voff) do { _Pragma("unroll") for (int _i = 0; _i < 2; ++_i) \
        __builtin_amdgcn_global_load_lds((const unsigned*)((const char*)(gbase) + (voff)[_i]), (PG8_LAS unsigned*)(lds + (bufoff) + ldsw + _i * 8192), 16, 0, 0); } while (0)
#define PG8_LDA(dst, b, h) do { _Pragma("unroll") for (int m = 0; m < 4; ++m) _Pragma("unroll") for (int k = 0; k < 2; ++k) dst[m][k] = *(const PG8_LAS bf16x8*)(lds + PG8_SA(b, h) + aoff + m * 2048 + k * 1024); } while (0)
#define PG8_LDB(dst, b, h) do { _Pragma("unroll") for (int n = 0; n < 2; ++n) _Pragma("unroll") for (int k = 0; k < 2; ++k) dst[n][k] = *(const PG8_LAS bf16x8*)(lds + PG8_SB(b, h) + boff + n * 2048 + k * 1024); } while (0)
#define PG8_MMA(ai, bj, At, Bt) do { __builtin_amdgcn_s_setprio(1); _Pragma("unroll") for (int m = 0; m < 4; ++m) _Pragma("unroll") for (int n = 0; n < 2; ++n) _Pragma("unroll") for (int k = 0; k < 2; ++k) \
        acc[ai][bj][m][n] = __builtin_amdgcn_mfma_f32_16x16x32_bf16(Bt[n][k], At[m][k], acc[ai][bj][m][n], 0, 0, 0); __builtin_amdgcn_s_setprio(0); } while (0)
#define PG8_WAIT_V(n) asm volatile("s_waitcnt vmcnt(" #n ")" ::: "memory")
#define PG8_WAIT_L(n) asm volatile("s_waitcnt lgkmcnt(" #n ")" ::: "memory")
#define PG8_BAR __builtin_amdgcn_s_barrier()
#define PG8_SCHED __builtin_amdgcn_sched_barrier(0)
    Unit cur, nxt; int ui = 0;
    if (!S.next(0, cur)) return;
    f32x4 acc[2][2][4][2];
#pragma unroll
    for (int a = 0; a < 2; ++a)
#pragma unroll
        for (int b = 0; b < 2; ++b)
#pragma unroll
            for (int m = 0; m < 4; ++m)
#pragma unroll
                for (int n = 0; n < 2; ++n) acc[a][b][m][n] = (f32x4){0.f, 0.f, 0.f, 0.f};
    bf16x8 At[4][2], B0[2][2], B1[2][2];
    const char* cA = (const char*)g.A + (size_t)cur.pm * tstep; const char* cB = (const char*)g.Bt + (size_t)cur.pn * tstep;
    S.a_ready(cur);
    if constexpr (SP2) {
        PG8_STAGE(PG8_SB(0, 0), cB, voffB); PG8_STAGE(PG8_SB(0, 1), cB + hstep, voffB); PG8_STAGE(PG8_SA(0, 0), cA, voffA); PG8_STAGE(PG8_SA(0, 1), cA + hstep, voffA);
        if (wr == 1) PG8_BAR;
        PG8_WAIT_V(2); PG8_BAR;
        PG8_STAGE(PG8_SB(1, 0), cB + kstep, voffB); PG8_STAGE(PG8_SA(1, 0), cA + kstep, voffA); PG8_STAGE(PG8_SB(1, 1), cB + hstep + kstep, voffB);
        PG8_WAIT_V(6); PG8_BAR;
    } else {
        PG8_STAGE(PG8_SB(0, 0), cB, voffB); PG8_STAGE(PG8_SA(0, 0), cA, voffA); PG8_STAGE(PG8_SB(0, 1), cB + hstep, voffB); PG8_STAGE(PG8_SA(0, 1), cA + hstep, voffA);
        if (wr == 1) PG8_BAR;
        PG8_WAIT_V(4); PG8_BAR;
        PG8_STAGE(PG8_SB(1, 0), cB + kstep, voffB); PG8_STAGE(PG8_SA(1, 0), cA + kstep, voffA); PG8_STAGE(PG8_SB(1, 1), cB + hstep + kstep, voffB);
        PG8_WAIT_V(6); PG8_BAR;
    }
    for (;;) {
        const bool has_next = S.next(ui + 1, nxt);
        const char* nA = has_next ? (const char*)g.A + (size_t)nxt.pm * tstep : cA; const char* nB = has_next ? (const char*)g.Bt + (size_t)nxt.pn * tstep : cB;
        for (int t = 0; t < nt; t += 2) {
            const bool last = (t == nt - 2);
            const char* a1 = cA + (size_t)(t + 1) * kstep;
            const char* a2 = last ? nA : cA + (size_t)(t + 2) * kstep; const char* b2 = last ? nB : cB + (size_t)(t + 2) * kstep;
            const char* a3 = a2 + kstep; const char* b3 = b2 + kstep;
            if (last && has_next) S.a_ready(nxt);
            if constexpr (SP2) {
            PG8_LDB(B0, 0, 0); PG8_LDB(B1, 0, 1); PG8_SCHED; PG8_LDA(At, 0, 0); PG8_STAGE(PG8_SA(1, 1), a1 + hstep, voffA);
            PG8_WAIT_V(8); PG8_WAIT_L(0); PG8_BAR; PG8_MMA(0, 0, At, B0); PG8_MMA(0, 1, At, B1); PG8_BAR; PG8_SCHED;
            PG8_LDA(At, 0, 1); PG8_STAGE(PG8_SB(0, 0), b2, voffB); PG8_STAGE(PG8_SB(0, 1), b2 + hstep, voffB); PG8_STAGE(PG8_SA(0, 0), a2, voffA);
            PG8_WAIT_V(8); PG8_WAIT_L(0); PG8_BAR; PG8_MMA(1, 0, At, B0); PG8_MMA(1, 1, At, B1); PG8_BAR; PG8_SCHED;
            PG8_LDB(B0, 1, 0); PG8_LDB(B1, 1, 1); PG8_SCHED; PG8_LDA(At, 1, 0); PG8_STAGE(PG8_SA(0, 1), a2 + hstep, voffA);
            PG8_WAIT_V(8); PG8_WAIT_L(0); PG8_BAR; PG8_MMA(0, 0, At, B0); PG8_MMA(0, 1, At, B1); PG8_BAR; PG8_SCHED;
            PG8_LDA(At, 1, 1); PG8_STAGE(PG8_SB(1, 0), b3, voffB); PG8_STAGE(PG8_SB(1, 1), b3 + hstep, voffB); PG8_STAGE(PG8_SA(1, 0), a3, voffA);
            PG8_WAIT_V(8); PG8_WAIT_L(0); PG8_BAR; PG8_MMA(1, 0, At, B0); PG8_MMA(1, 1, At, B1); PG8_BAR; PG8_SCHED;
            } else {
            PG8_LDB(B0, 0, 0); PG8_SCHED; PG8_LDA(At, 0, 0); PG8_STAGE(PG8_SA(1, 1), a1 + hstep, voffA);
            PG8_WAIT_L(8); PG8_BAR; PG8_WAIT_L(0); PG8_MMA(0, 0, At, B0); PG8_BAR; PG8_SCHED;
            PG8_LDB(B1, 0, 1); PG8_STAGE(PG8_SB(0, 0), b2, voffB);
            PG8_BAR; PG8_WAIT_L(0); PG8_MMA(0, 1, At, B1); PG8_BAR;
            PG8_LDA(At, 0, 1); PG8_STAGE(PG8_SA(0, 0), a2, voffA);
            PG8_BAR; PG8_WAIT_L(0); PG8_MMA(1, 0, At, B0); PG8_BAR; PG8_SCHED;
            PG8_STAGE(PG8_SB(0, 1), b2 + hstep, voffB);
            PG8_WAIT_V(6); PG8_BAR; PG8_MMA(1, 1, At, B1); PG8_BAR;
            PG8_LDB(B0, 1, 0); PG8_SCHED; PG8_LDA(At, 1, 0); PG8_STAGE(PG8_SA(0, 1), a2 + hstep, voffA);
            PG8_WAIT_L(8); PG8_BAR; PG8_WAIT_L(0); PG8_MMA(0, 0, At, B0); PG8_BAR; PG8_SCHED;
            PG8_LDB(B1, 1, 1); PG8_STAGE(PG8_SB(1, 0), b3, voffB);
            PG8_BAR; PG8_WAIT_L(0); PG8_MMA(0, 1, At, B1); PG8_BAR;
            PG8_LDA(At, 1, 1); PG8_STAGE(PG8_SA(1, 0), a3, voffA);
            PG8_BAR; PG8_WAIT_L(0); PG8_MMA(1, 0, At, B0); PG8_BAR; PG8_SCHED;
            PG8_STAGE(PG8_SB(1, 1), b3 + hstep, voffB);
            PG8_WAIT_V(6); PG8_BAR; PG8_MMA(1, 1, At, B1); PG8_BAR;
            }
        }
        if constexpr (ALIGN_EPI) { if (wr == 0) PG8_BAR; }
        if constexpr (!Epi::AFTER_DRAIN) { E(acc, cur, wr, wc, fr, fq); S.done(cur); }
        if (!has_next) break;
#pragma unroll
        for (int a = 0; a < 2; ++a)
#pragma unroll
            for (int b = 0; b < 2; ++b)
#pragma unroll
                for (int m = 0; m < 4; ++m)
#pragma unroll
                    for (int n = 0; n < 2; ++n) acc[a][b][m][n] = (f32x4){0.f, 0.f, 0.f, 0.f};
        cur = nxt; cA = nA; cB = nB; ++ui;
        if constexpr (ALIGN_EPI) { if (wr == 1) PG8_BAR; }
    }
    PG8_WAIT_V(0);
    if constexpr (!ALIGN_EPI) { if (wr == 0) PG8_BAR; }
    PG8_BAR;
    if constexpr (Epi::AFTER_DRAIN) { E.fused(acc, cur, wr, wc, fr, fq, lds, wid, lane); S.done(cur); }
#undef PG8_SA
#undef PG8_SB
#undef PG8_STAGE
#undef PG8_LDA
#undef PG8_LDB
#undef PG8_MMA
#undef PG8_WAIT_V
#undef PG8_WAIT_L
#undef PG8_BAR
#undef PG8_SCHED
}
}
#define GAS __attribute__((address_space(1)))
#define LAS __attribute__((address_space(3)))
typedef unsigned short bf16;
typedef unsigned v4u __attribute__((ext_vector_type(4)));
typedef float f32x4 __attribute__((ext_vector_type(4)));
typedef short bf16x8 __attribute__((ext_vector_type(8)));
typedef GAS unsigned gu32;
typedef GAS unsigned long long gu64;
#define RLX_AGENT __ATOMIC_RELAXED, __HIP_MEMORY_SCOPE_AGENT
#define LDS_WAIT() asm volatile("s_waitcnt lgkmcnt(0)" ::: "memory")
#define VM_WAIT() asm volatile("s_waitcnt vmcnt(0)" ::: "memory")
__device__ __forceinline__ unsigned long long rt() { return __builtin_amdgcn_s_memrealtime(); }
#define XB_TMO      128
#define XB_XCNT(j)  (256  + 64 * (j))
#define XB_XSUB(j)  (1280 + 64 * (j))
#define XB_XGEN(j)  (2304 + 64 * (j))
#define XB_TOP      3328
#define XB_TOPGEN   3392
#define XCD_BAR_WORDS 3456
#define XB_SPIN_CAP (1u << 18)

__device__ __forceinline__ unsigned xb_ld(unsigned* p)              { return __hip_atomic_load(p, __ATOMIC_RELAXED, __HIP_MEMORY_SCOPE_AGENT); }
__device__ __forceinline__ unsigned xb_add(unsigned* p, unsigned v) { return __hip_atomic_fetch_add(p, v, __ATOMIC_RELAXED, __HIP_MEMORY_SCOPE_AGENT); }
__device__ __forceinline__ unsigned xb_xcc_id() { return (unsigned)__builtin_amdgcn_s_getreg((3 << 11) | 20) & 0xFu; }
#define XB_SPIN(cond, bar) do { unsigned _sp = 0; while (cond) { __builtin_amdgcn_s_sleep(1); \
    if ((++_sp & 255u) == 0u) { if (xb_ld(&(bar)[XB_TMO])) break; if (_sp > XB_SPIN_CAP) { atomicAdd(&(bar)[XB_TMO], 1u); break; } } } } while (0)

struct XcdBarrier {
    unsigned* bar; unsigned x;
    volatile LAS unsigned* st;
};

__device__ __forceinline__ XcdBarrier xcd_barrier_post(unsigned* bar, volatile LAS unsigned* st) {
    XcdBarrier b; b.bar = bar; b.x = xb_xcc_id(); b.st = st;
    if (threadIdx.x == 0) (void)xb_add(&bar[XB_XCNT(b.x)], 1u);
    return b;
}
__device__ __forceinline__ void xcd_barrier_complete(unsigned* bar, unsigned x, unsigned& nloc, unsigned& nx) {
    const unsigned G = gridDim.x * gridDim.y * gridDim.z;
    unsigned sum, cnt, mine, sp = 0u;
    for (;;) {
        sum = 0u; cnt = 0u; mine = 0u;
#pragma unroll
        for (unsigned j = 0; j < 16; ++j) { const unsigned c = xb_ld(&bar[XB_XCNT(j)]); sum += c; cnt += (c > 0u) ? 1u : 0u; mine = (j == x) ? c : mine; }
        if (sum == G) break;
        __builtin_amdgcn_s_sleep(1);
        if ((++sp & 255u) == 0u) { if (xb_ld(&bar[XB_TMO])) break; if (sp > XB_SPIN_CAP) { atomicAdd(&bar[XB_TMO], 1u); break; } }
    }
    nloc = mine > 0u ? mine : 1u; nx = cnt > 0u ? cnt : 1u;
}

__device__ __forceinline__ void xcd_barrier(const XcdBarrier& b) {
    asm volatile("s_waitcnt vmcnt(0)" ::: "memory");
    __syncthreads();
    if (threadIdx.x == 0) {
        unsigned* bar = b.bar;
        __builtin_amdgcn_s_waitcnt(0);
        unsigned nloc = b.st[0], nx = b.st[1];
        if (nloc == 0u) { xcd_barrier_complete(bar, b.x, nloc, nx); b.st[0] = nloc; b.st[1] = nx; }
        const unsigned old = xb_add(&bar[XB_XSUB(b.x)], 1u);
        const unsigned gen = old / nloc;
        if (old + 1u == (gen + 1u) * nloc) {
            __builtin_amdgcn_fence(__ATOMIC_RELEASE, "agent");
            asm volatile("s_waitcnt vmcnt(0)" ::: "memory");
            const unsigned og = xb_add(&bar[XB_TOP], 1u);
            const unsigned tg = og / nx;
            if (og + 1u == (tg + 1u) * nx) xb_add(&bar[XB_TOPGEN], 1u);
            else XB_SPIN(xb_ld(&bar[XB_TOPGEN]) == tg, bar);
            __builtin_amdgcn_fence(__ATOMIC_ACQUIRE, "agent");
            xb_add(&bar[XB_XGEN(b.x)], 1u);
            asm volatile("s_waitcnt vmcnt(0)" ::: "memory");
        } else {
            XB_SPIN(xb_ld(&bar[XB_XGEN(b.x)]) == gen, bar);
            __builtin_amdgcn_fence(__ATOMIC_ACQUIRE, "agent");
            asm volatile("s_waitcnt vmcnt(0)" ::: "memory");
        }
    }
    __syncthreads();
}
__device__ __forceinline__ int fresh_tid() { int t = threadIdx.x; asm volatile("" : "+v"(t)); return t; }

constexpr int NB = 8, S = 8192, M = NB * S, D = 1024, FF = 4096, NMEMT = 256;
constexpr int NDIFF = 2560, NDSA_L = 1736, NDSA = 1792;
constexpr float EPS = 1e-6f;
constexpr int NWAVES = 8, NTHR = 512;
constexpr float C2 = 0.125f * 1.4426950408889634f;
constexpr int DQ = 0, DK = 768, DV = 832, DIQ = 896, DIK = 1408, DIW = 1472, DQM = 1480;

typedef unsigned short bf16_t;
typedef unsigned u32x4 __attribute__((ext_vector_type(4)));
typedef float f32x4 __attribute__((ext_vector_type(4)));

constexpr size_t MiB = 1u << 20;
constexpr size_t WS_CTL = 0;
constexpr size_t WS_WIN0 = 1 * MiB, WS_WIN1 = 6 * MiB, WS_WOUT = 10 * MiB, WS_WUP = 14 * MiB, WS_WDN = 30 * MiB, WS_WKV = 46 * MiB;
constexpr size_t WS_MEMN = 48 * MiB, WS_MEMKV = 56 * MiB, WS_ROPE = 60 * MiB, WS_TOPK = 76 * MiB;
constexpr size_t WS_H = 108 * MiB, WS_PROJ = 236 * MiB, WS_O = 556 * MiB, WS_HID = 236 * MiB, WS_Y = 748 * MiB, WS_END = 1004 * MiB;

constexpr size_t P0_Q = 0, P0_K = (size_t)M * 768, P0_V = (size_t)M * 1536, P0_QM = (size_t)M * 2304;
constexpr size_t P1_Q = 0, P1_K = (size_t)M * 768, P1_V = (size_t)M * 832, P1_IK = (size_t)M * 896, P1_IQ = (size_t)M * 960, P1_QM = (size_t)M * 1472, P1_IW = (size_t)M * 1728;
constexpr float IW_SCALE = 0.04419417382415922f;
constexpr size_t MKV_K = 0, MKV_V = 524288, MKV_LAYER = 1048576;
__device__ __forceinline__ float bf2f(bf16_t v) { return __uint_as_float((unsigned)v << 16); }
__device__ __forceinline__ unsigned f2bf(float f) { unsigned u = __float_as_uint(f); return (u + 0x7fffu + ((u >> 16) & 1u)) >> 16; }
__device__ __forceinline__ unsigned pk2(float lo, float hi) { return f2bf(lo) | (f2bf(hi) << 16); }
__device__ __forceinline__ float wave_sum(float v) {
#pragma unroll
    for (int o = 1; o < 64; o <<= 1) v += __shfl_xor(v, o);
    return v;
}

template <int ACT> struct EpiB {
    static constexpr bool PERM = true, AFTER_DRAIN = false;
    bf16_t* O; int ldc;
    __device__ __forceinline__ void operator()(const pg8::f32x4 (&acc)[2][2][4][2], const pg8::Unit& u, int wr, int wc, int fr, int fq) const {
        const int row0 = u.pm * 256 + wr * 64 + fr, col0 = u.pn * 256 + wc * 32 + 8 * fq;
#pragma unroll
        for (int ai = 0; ai < 2; ++ai)
#pragma unroll
            for (int m = 0; m < 4; ++m) { bf16_t* rowp = O + (size_t)(row0 + ai * 128 + m * 16) * ldc + col0;
#pragma unroll
                for (int bj = 0; bj < 2; ++bj) { pg8::f32x4 v0 = acc[ai][bj][m][0], v1 = acc[ai][bj][m][1];
                    if (ACT == 2) {
#pragma unroll
                        for (int e = 0; e < 4; ++e) { float a = fmaxf(v0[e], 0.f); v0[e] = a * a; float b = fmaxf(v1[e], 0.f); v1[e] = b * b; } }
                    u32x4 w; w.x = pg8::cvt_pk_bf16(v0[0], v0[1]); w.y = pg8::cvt_pk_bf16(v0[2], v0[3]); w.z = pg8::cvt_pk_bf16(v1[0], v1[1]); w.w = pg8::cvt_pk_bf16(v1[2], v1[3]);
                    *(u32x4*)(rowp + bj * 128) = w; } }
    }
};
struct EpiF {
    static constexpr bool PERM = false, AFTER_DRAIN = false;
    float* C; int ldc;
    __device__ __forceinline__ void operator()(const pg8::f32x4 (&acc)[2][2][4][2], const pg8::Unit& u, int wr, int wc, int fr, int fq) const {
        const int row0 = u.pm * 256 + wr * 64 + fr, col0 = u.pn * 256 + wc * 32 + 4 * fq;
#pragma unroll
        for (int ai = 0; ai < 2; ++ai)
#pragma unroll
            for (int m = 0; m < 4; ++m) { float* rowp = C + (size_t)(row0 + ai * 128 + m * 16) * ldc + col0;
#pragma unroll
                for (int bj = 0; bj < 2; ++bj)
#pragma unroll
                    for (int n = 0; n < 2; ++n) *(pg8::f32x4*)(rowp + bj * 128 + n * 16) = acc[ai][bj][m][n]; }
    }
};


struct EpiProj0 {
    static constexpr bool PERM = true, AFTER_DRAIN = false;
    bf16_t* P; const float2* rope;
    __device__ __forceinline__ void operator()(const pg8::f32x4 (&acc)[2][2][4][2], const pg8::Unit& u, int wr, int wc, int fr, int fq) const {
        const int pn = u.pn;
        const int b = (u.pm * 256) / S;
        const int m0 = u.pm * 256 + wr * 64 + fr;
#pragma unroll
        for (int ai = 0; ai < 2; ++ai)
#pragma unroll
            for (int mm = 0; mm < 4; ++mm) {
                const int mrow = m0 + ai * 128 + mm * 16; const int s = mrow - b * S; const int t = s >> 6, r = s & 63;
                float x1[8], x2[8];
#pragma unroll
                for (int j = 0; j < 8; ++j) { x1[j] = acc[ai][0][mm][j >> 2][j & 3]; x2[j] = acc[ai][1][mm][j >> 2][j & 3]; }
                if (pn < 6) {
                    const pg8::f32x4* cs = (const pg8::f32x4*)(rope + (size_t)mrow * 32 + 8 * fq);
                    pg8::f32x4 cv[4];
#pragma unroll
                    for (int k = 0; k < 4; ++k) cv[k] = cs[k];
#pragma unroll
                    for (int j = 0; j < 8; ++j) { const float c = cv[j >> 1][(j & 1) * 2], sn = cv[j >> 1][(j & 1) * 2 + 1];
                        const float a = x1[j] * c - x2[j] * sn, bb = x2[j] * c + x1[j] * sn; x1[j] = a; x2[j] = bb; }
                }
                if (pn < 3 || pn == 9) {
#pragma unroll
                    for (int j = 0; j < 8; ++j) { x1[j] *= C2; x2[j] *= C2; }
                }
                u32x4 w1, w2;
                w1.x = pg8::cvt_pk_bf16(x1[0], x1[1]); w1.y = pg8::cvt_pk_bf16(x1[2], x1[3]); w1.z = pg8::cvt_pk_bf16(x1[4], x1[5]); w1.w = pg8::cvt_pk_bf16(x1[6], x1[7]);
                w2.x = pg8::cvt_pk_bf16(x2[0], x2[1]); w2.y = pg8::cvt_pk_bf16(x2[2], x2[3]); w2.z = pg8::cvt_pk_bf16(x2[4], x2[5]); w2.w = pg8::cvt_pk_bf16(x2[6], x2[7]);
                bf16_t *d1, *d2;
                if (pn < 3) { bf16_t* q = P + P0_Q + ((size_t)(b * 12 + 4 * pn + wc) * S + s) * 64 + 8 * fq; d1 = q; d2 = q + 32; }
                else if (pn < 6) { bf16_t* k = P + P0_K + ((((size_t)(b * 12 + 4 * (pn - 3) + wc) * 128 + t) * 8 + fq) * 512 + r * 8); d1 = k; d2 = k + 4 * 512; }
                else if (pn < 9) { const int hsv = 4 * (pn - 6) + wc; bf16_t* v = P + P0_V + (((((size_t)(b * 6 + (hsv >> 1)) * 128 + t) * 4 + 2 * (hsv & 1)) * 64 + r) * 32 + 8 * fq); d1 = v; d2 = v + 64 * 32; }
                else { bf16_t* q = P + P0_QM + ((size_t)(b * 4 + wc) * S + s) * 64 + 8 * fq; d1 = q; d2 = q + 32; }
                *(u32x4*)d1 = w1; *(u32x4*)d2 = w2;
            }
    }
};
__device__ __forceinline__ unsigned pk_f16(float lo, float hi) { typedef float f2 __attribute__((ext_vector_type(2))); typedef _Float16 h2 __attribute__((ext_vector_type(2))); const f2 v = {lo, hi}; return __builtin_bit_cast(unsigned, __builtin_convertvector(v, h2)); }
struct EpiProj1 {
    static constexpr bool PERM = true, AFTER_DRAIN = false;
    bf16_t* P; const float2* rope;
    __device__ __forceinline__ void operator()(const pg8::f32x4 (&acc)[2][2][4][2], const pg8::Unit& u, int wr, int wc, int fr, int fq) const {
        const int pn = u.pn;
        const int b = (u.pm * 256) / S;
        const int m0 = u.pm * 256 + wr * 64 + fr;
        const bool do_rope = (pn < 3) || (pn == 3 && (wc == 0 || wc == 2)) || pn == 4 || pn == 5;
        const bool f16out = (pn == 3 && wc == 2) || pn == 4 || pn == 5;
#pragma unroll
        for (int ai = 0; ai < 2; ++ai)
#pragma unroll
            for (int mm = 0; mm < 4; ++mm) {
                const int mrow = m0 + ai * 128 + mm * 16; const int s = mrow - b * S; const int t = s >> 6, r = s & 63;
                float x1[8], x2[8];
#pragma unroll
                for (int j = 0; j < 8; ++j) { x1[j] = acc[ai][0][mm][j >> 2][j & 3]; x2[j] = acc[ai][1][mm][j >> 2][j & 3]; }
                if (pn == 3 && wc == 3) {
                    if (fq == 0) { float* w = (float*)(P + P1_IW) + (size_t)mrow * 8;
                        *(pg8::f32x4*)w = (pg8::f32x4){x1[0] * IW_SCALE, x1[1] * IW_SCALE, x1[2] * IW_SCALE, x1[3] * IW_SCALE};
                        *(pg8::f32x4*)(w + 4) = (pg8::f32x4){x1[4] * IW_SCALE, x1[5] * IW_SCALE, x1[6] * IW_SCALE, x1[7] * IW_SCALE}; }
                    continue;
                }
                if (do_rope) {
                    const pg8::f32x4* cs = (const pg8::f32x4*)(rope + (size_t)mrow * 32 + 8 * fq);
                    pg8::f32x4 cv[4];
#pragma unroll
                    for (int k = 0; k < 4; ++k) cv[k] = cs[k];
#pragma unroll
                    for (int j = 0; j < 8; ++j) { const float c = cv[j >> 1][(j & 1) * 2], sn = cv[j >> 1][(j & 1) * 2 + 1];
                        const float a = x1[j] * c - x2[j] * sn, bb = x2[j] * c + x1[j] * sn; x1[j] = a; x2[j] = bb; }
                }
                if (pn < 3 || pn == 6) {
#pragma unroll
                    for (int j = 0; j < 8; ++j) { x1[j] *= C2; x2[j] *= C2; }
                }
                u32x4 w1, w2;
                if (f16out) {
                    w1.x = pk_f16(x1[0], x1[1]); w1.y = pk_f16(x1[2], x1[3]); w1.z = pk_f16(x1[4], x1[5]); w1.w = pk_f16(x1[6], x1[7]);
                    w2.x = pk_f16(x2[0], x2[1]); w2.y = pk_f16(x2[2], x2[3]); w2.z = pk_f16(x2[4], x2[5]); w2.w = pk_f16(x2[6], x2[7]);
                } else {
                    w1.x = pg8::cvt_pk_bf16(x1[0], x1[1]); w1.y = pg8::cvt_pk_bf16(x1[2], x1[3]); w1.z = pg8::cvt_pk_bf16(x1[4], x1[5]); w1.w = pg8::cvt_pk_bf16(x1[6], x1[7]);
                    w2.x = pg8::cvt_pk_bf16(x2[0], x2[1]); w2.y = pg8::cvt_pk_bf16(x2[2], x2[3]); w2.z = pg8::cvt_pk_bf16(x2[4], x2[5]); w2.w = pg8::cvt_pk_bf16(x2[6], x2[7]);
                }
                bf16_t *d1, *d2;
                if (pn < 3) { bf16_t* q = P + P1_Q + (size_t)mrow * 768 + (4 * pn + wc) * 64 + 8 * fq; d1 = q; d2 = q + 32; }
                else if (pn == 3) {
                    if (wc == 0) { bf16_t* k = P + P1_K + (size_t)mrow * 64 + 8 * fq; d1 = k; d2 = k + 32; }
                    else if (wc == 1) { bf16_t* v = P + P1_V + (size_t)mrow * 64 + 8 * fq; d1 = v; d2 = v + 32; }
                    else { bf16_t* k = P + P1_IK + ((((size_t)b * 128 + t) * 8 + fq) * 512 + r * 8); d1 = k; d2 = k + 4 * 512; }
                }
                else if (pn < 6) { bf16_t* q = P + P1_IQ + (size_t)mrow * 512 + (4 * (pn - 4) + wc) * 64 + 8 * fq; d1 = q; d2 = q + 32; }
                else { bf16_t* q = P + P1_QM + ((size_t)(b * 4 + wc) * S + s) * 64 + 8 * fq; d1 = q; d2 = q + 32; }
                *(u32x4*)d1 = w1; *(u32x4*)d2 = w2;
            }
    }
};
struct EpiMemKV {
    static constexpr bool PERM = true, AFTER_DRAIN = false;
    bf16_t* P;
    __device__ __forceinline__ void operator()(const pg8::f32x4 (&acc)[2][2][4][2], const pg8::Unit& u, int wr, int wc, int fr, int fq) const {
        const int b = u.pm;
#pragma unroll
        for (int ai = 0; ai < 2; ++ai)
#pragma unroll
            for (int mm = 0; mm < 4; ++mm) {
                const int mt = ai * 128 + wr * 64 + mm * 16 + fr; const int t = mt >> 6, r = mt & 63;
#pragma unroll
                for (int bj = 0; bj < 2; ++bj) {
                    const pg8::f32x4 v0 = acc[ai][bj][mm][0], v1 = acc[ai][bj][mm][1];
                    u32x4 w; w.x = pg8::cvt_pk_bf16(v0[0], v0[1]); w.y = pg8::cvt_pk_bf16(v0[2], v0[3]); w.z = pg8::cvt_pk_bf16(v1[0], v1[1]); w.w = pg8::cvt_pk_bf16(v1[2], v1[3]);
                    bf16_t* dst = (u.pn == 0) ? P + MKV_K + ((((size_t)(b * 4 + wc) * 4 + t) * 8 + 4 * bj + fq) * 512 + r * 8)
                                              : P + MKV_V + (((((size_t)(b * 4 + wc) * 4 + t) * 2 + bj) * 64 + r) * 32 + 8 * fq);
                    *(u32x4*)dst = w;
                }
            }
    }
};

#ifndef FA_DEBUG_SYNC
#define FA_DEBUG_SYNC 0
#endif
namespace fa {
typedef short bf16x8 __attribute__((ext_vector_type(8)));
typedef short s16x4 __attribute__((ext_vector_type(4)));
typedef float f32x16 __attribute__((ext_vector_type(16)));
typedef __attribute__((address_space(3))) const char* lds_cptr;
typedef short v4i16_t __attribute__((ext_vector_type(4)));
__device__ __forceinline__ int crow(int r, int hi) { return (r & 3) + 8 * (r >> 2) + 4 * hi; }
__device__ __forceinline__ void glds16(const void* gsrc, unsigned lds_dst) { unsigned keep;
    asm volatile("s_mov_b32 %0, m0\n\ts_mov_b32 m0, %2\n\ts_nop 0\n\tglobal_load_lds_dwordx4 %1, off\n\ts_mov_b32 m0, %0" : "=&s"(keep) : "v"(gsrc), "s"(lds_dst) : "memory"); }
typedef float f32x2_t __attribute__((ext_vector_type(2))); typedef __bf16 bf16x2_t __attribute__((ext_vector_type(2)));
__device__ __forceinline__ unsigned cvtpk(float lo, float hi) { const f32x2_t v = {lo, hi}; return __builtin_bit_cast(unsigned, __builtin_convertvector(v, bf16x2_t)); }
__device__ __forceinline__ s16x4 vtr(lds_cptr p) { return __builtin_bit_cast(s16x4, __builtin_amdgcn_ds_read_tr16_b64_v4i16((__attribute__((address_space(3))) v4i16_t*)p)); }
__device__ __forceinline__ float swapmax(float m) { auto rr = __builtin_amdgcn_permlane32_swap(__float_as_uint(m), __float_as_uint(m), false, false); return fmaxf(__uint_as_float(rr[0]), __uint_as_float(rr[1])); }
__device__ __forceinline__ float swapsum(float m) { auto rr = __builtin_amdgcn_permlane32_swap(__float_as_uint(m), __float_as_uint(m), false, false); return __uint_as_float(rr[0]) + __uint_as_float(rr[1]); }

template <int NBR, int DV> struct Cfg {
    static constexpr int NVB = DV / 32, VBYTES = 64 * DV * 2, STG = NBR * 8192 + VBYTES, PPW = STG / 8192, ROWS = 256 / NBR;
    static constexpr int EXCH_OFF = 65536;
};
struct Unit { const bf16_t* q0; const bf16_t* q1; const bf16_t* k0; const bf16_t* k1; const bf16_t* v; int qrow0; int nt; };

template <int NBR, int DV> __device__ __forceinline__ void tile_compute(lds_cptr stage, int br, const bf16x8 (&qr)[4], f32x16 (&o)[DV / 32], float& m, float& l, int r32, int hi, int lane) {
    typedef Cfg<NBR, DV> C;
    const lds_cptr kp = stage + br * 8192 + hi * 1024 + r32 * 16;
    f32x16 p0 = {}, p1 = {};
#pragma unroll
    for (int d0 = 0; d0 < 4; ++d0) {
        const bf16x8 k0 = *(const __attribute__((address_space(3))) bf16x8*)(kp + d0 * 2048);
        const bf16x8 k1 = *(const __attribute__((address_space(3))) bf16x8*)(kp + d0 * 2048 + 512);
        p0 = __builtin_amdgcn_mfma_f32_32x32x16_bf16(k0, qr[d0], p0, 0, 0, 0);
        p1 = __builtin_amdgcn_mfma_f32_32x32x16_bf16(k1, qr[d0], p1, 0, 0, 0);
    }
    __builtin_amdgcn_sched_barrier(0);
    float mx = fmaxf(p0[0], p1[0]);
#pragma unroll
    for (int r = 1; r < 16; ++r) mx = fmaxf(mx, fmaxf(p0[r], p1[r]));
    mx = swapmax(mx);
    const float mn = fmaxf(m, mx), alpha = __builtin_amdgcn_exp2f(m - mn); m = mn;
    float ls = 0.f;
#pragma unroll
    for (int r = 0; r < 16; ++r) { p0[r] = __builtin_amdgcn_exp2f(p0[r] - mn); p1[r] = __builtin_amdgcn_exp2f(p1[r] - mn); ls += p0[r] + p1[r]; }
    l = l * alpha + ls;
#pragma unroll
    for (int db = 0; db < C::NVB; ++db)
#pragma unroll
        for (int r = 0; r < 16; ++r) o[db][r] *= alpha;
    u32x4 pw[4];
#pragma unroll
    for (int i = 0; i < 4; ++i) { pw[0][i] = cvtpk(p0[2 * i], p0[2 * i + 1]); pw[1][i] = cvtpk(p0[8 + 2 * i], p0[9 + 2 * i]); pw[2][i] = cvtpk(p1[2 * i], p1[2 * i + 1]); pw[3][i] = cvtpk(p1[8 + 2 * i], p1[9 + 2 * i]); }
    const lds_cptr vp = stage + NBR * 8192 + ((lane >> 4) & 1) * 32 + (lane & 3) * 8 + (4 * hi + ((lane & 15) >> 2)) * 64;
#pragma unroll
    for (int db = 0; db < C::NVB; ++db) {
        __builtin_amdgcn_sched_barrier(0);
#pragma unroll
        for (int ks = 0; ks < 4; ++ks) {
            const s16x4 lo = vtr(vp + db * 4096 + ks * 1024), hh = vtr(vp + db * 4096 + ks * 1024 + 512);
            const bf16x8 vf = (bf16x8){lo[0], lo[1], lo[2], lo[3], hh[0], hh[1], hh[2], hh[3]};
            o[db] = __builtin_amdgcn_mfma_f32_32x32x16_bf16(vf, __builtin_bit_cast(bf16x8, pw[ks]), o[db], 0, 0, 0);
        }
    }
    __builtin_amdgcn_sched_barrier(0);
}

template <int NBR, int DV> __device__ __forceinline__ void attn_unit(const Unit& U, bool causal, bf16_t* out, int out_row0, int ocol, float lam, const float* gsub, float oscale, LAS unsigned char* lds_) {
    typedef Cfg<NBR, DV> C;
    const int tid = fresh_tid(), lane = tid & 63, r32 = lane & 31, hi = lane >> 5; const int wid = __builtin_amdgcn_readfirstlane(tid >> 6);
    const int br = (NBR == 2) ? (wid >> 2) : 0, rw = (NBR == 2) ? (wid & 3) : wid;
    const lds_cptr lds = (lds_cptr)lds_;
    const unsigned lds0 = (unsigned)(uintptr_t)lds_;
    const int myrow0 = U.qrow0 + 32 * rw;
    const int NT = U.nt, my_nt = causal ? ((myrow0 >> 6) + 1) : NT;
    const int pc0 = wid * C::PPW;
    const char* src; int srcstep;
    if (pc0 < 8 * NBR) { src = (const char*)((pc0 >> 3) ? U.k1 : U.k0) + (pc0 & 7) * 1024; srcstep = 8192; }
    else { src = (const char*)U.v + (pc0 - 8 * NBR) * 1024; srcstep = C::VBYTES; }
    src += lane * 16;
    const unsigned dst0 = lds0 + pc0 * 1024;
#if FA_DEBUG_SYNC == 2
#define FA_DMA(t, slot) do { _Pragma("unroll") for (int i_ = 0; i_ < C::PPW; ++i_) { const u32x4 v_ = *(const u32x4*)(src + (size_t)(t) * srcstep + i_ * 1024); \
        *(LAS u32x4*)(lds_ + pc0 * 1024 + (slot) * C::STG + i_ * 1024 + lane * 16) = v_; } } while (0)
#else
#define FA_DMA(t, slot) do { _Pragma("unroll") for (int i_ = 0; i_ < C::PPW; ++i_) glds16(src + (size_t)(t) * srcstep + i_ * 1024, (unsigned)__builtin_amdgcn_readfirstlane(dst0 + (slot) * C::STG + i_ * 1024)); } while (0)
#endif
    bf16x8 qr[4];
    { const bf16_t* qp = (br ? U.q1 : U.q0) + (size_t)(myrow0 + r32) * 64 + hi * 8;
#pragma unroll
      for (int d0 = 0; d0 < 4; ++d0) qr[d0] = *(const bf16x8*)(qp + d0 * 16); }
    FA_DMA(0, 0);
    if (NT > 1) FA_DMA(1, 1);
    f32x16 o[C::NVB];
#pragma unroll
    for (int db = 0; db < C::NVB; ++db) o[db] = (f32x16){};
    float m = -INFINITY, l = 0.f;
    int slot = 0, slot2 = 2;
#pragma unroll 1
    for (int t = 0; t < NT; ++t) {
#if FA_DEBUG_SYNC >= 1
        asm volatile("s_waitcnt vmcnt(0) lgkmcnt(0)\n\ts_barrier" ::: "memory");
        if (t + 2 < NT) FA_DMA(t + 2, slot2);
        asm volatile("s_waitcnt vmcnt(0) lgkmcnt(0)\n\ts_barrier" ::: "memory");
        if (t < my_nt) tile_compute<NBR, DV>(lds + slot * C::STG, br, qr, o, m, l, r32, hi, lane);
        asm volatile("s_waitcnt vmcnt(0) lgkmcnt(0)\n\ts_barrier" ::: "memory");
#else
        if (t + 1 < NT) { if (C::PPW == 4) asm volatile("s_waitcnt vmcnt(4) lgkmcnt(0)\n\ts_barrier" ::: "memory"); else asm volatile("s_waitcnt vmcnt(2) lgkmcnt(0)\n\ts_barrier" ::: "memory"); }
        else asm volatile("s_waitcnt vmcnt(0) lgkmcnt(0)\n\ts_barrier" ::: "memory");
        if (t + 2 < NT) FA_DMA(t + 2, slot2);
        if (t < my_nt) tile_compute<NBR, DV>(lds + slot * C::STG, br, qr, o, m, l, r32, hi, lane);
#endif
        slot = (slot == 2) ? 0 : slot + 1; slot2 = (slot2 == 2) ? 0 : slot2 + 1;
    }
#undef FA_DMA
    asm volatile("s_waitcnt vmcnt(0) lgkmcnt(0)\n\ts_barrier" ::: "memory");
    l = swapsum(l);
    if (NBR == 2) {
        LAS float* ex = (LAS float*)(lds_ + C::EXCH_OFF) + rw * 4096 + lane;
        if (br == 1) {
            const float f = lam / l;
#pragma unroll
            for (int db = 0; db < C::NVB; ++db)
#pragma unroll
                for (int r = 0; r < 16; ++r) ex[(db * 16 + r) * 64] = o[db][r] * f;
        }
        asm volatile("s_waitcnt lgkmcnt(0)\n\ts_barrier" ::: "memory");
        if (br == 0) {
            const float il = 1.f / l; float ss = 0.f;
#pragma unroll
            for (int db = 0; db < C::NVB; ++db)
#pragma unroll
                for (int r = 0; r < 16; ++r) { const float v = o[db][r] * il - ex[(db * 16 + r) * 64]; o[db][r] = v; ss += v * v; }
            ss = swapsum(ss);
            const float rstd = oscale / sqrtf(ss * (1.f / (float)DV) + EPS);
            bf16_t* orow = out + (size_t)(out_row0 + myrow0 + r32) * D + ocol + 4 * hi;
#pragma unroll
            for (int db = 0; db < C::NVB; ++db)
#pragma unroll
                for (int g = 0; g < 4; ++g) { const f32x4 gg = *(const f32x4*)(gsub + db * 32 + 8 * g + 4 * hi);
                    uint2 w; w.x = cvtpk(o[db][4 * g] * rstd * gg.x, o[db][4 * g + 1] * rstd * gg.y); w.y = cvtpk(o[db][4 * g + 2] * rstd * gg.z, o[db][4 * g + 3] * rstd * gg.w);
                    *(uint2*)(orow + db * 32 + 8 * g) = w; }
        }
    } else {
        const float il = 1.f / l;
        bf16_t* orow = out + (size_t)(out_row0 + myrow0 + r32) * D + ocol + 4 * hi;
#pragma unroll
        for (int db = 0; db < C::NVB; ++db)
#pragma unroll
            for (int g = 0; g < 4; ++g) { uint2 w; w.x = cvtpk(o[db][4 * g] * il, o[db][4 * g + 1] * il); w.y = cvtpk(o[db][4 * g + 2] * il, o[db][4 * g + 3] * il);
                *(uint2*)(orow + db * 32 + 8 * g) = w; }
    }
    asm volatile("s_waitcnt lgkmcnt(0)\n\ts_barrier" ::: "memory");
}
}

namespace ix {
typedef _Float16 f16x8 __attribute__((ext_vector_type(8)));
typedef float f32x16 __attribute__((ext_vector_type(16)));
constexpr int HROW = 513 * 4;
constexpr int L_HIST = 0, L_BMAP = 0, BROW = 1024;
constexpr int L_TB = 32 * HROW;
constexpr int L_SEGC = L_TB + 256;
constexpr int SEGCAP = 12;
constexpr int L_SEGK = L_SEGC + 32 * 16 * 4;
constexpr int L_SEGI = L_SEGK + 32 * 16 * SEGCAP * 4;
constexpr int L_FLAG = L_SEGI + 32 * 16 * SEGCAP * 2;
constexpr int L_END = L_FLAG + 128;
static_assert(L_END <= 131072, "indexer LDS map");
constexpr float BIN_SCALE = 32.0f, BIN_OFF = 256.0f;

__device__ __forceinline__ unsigned bin_of(float s) { const float t = __builtin_fmaf(s, BIN_SCALE, BIN_OFF); return (unsigned)(int)__builtin_amdgcn_fmed3f(t, 0.0f, 511.0f); }
__device__ __forceinline__ unsigned skey(unsigned bits) { return (bits & 0x80000000u) ? ~bits : (bits | 0x80000000u); }

__device__ __forceinline__ void topk_row_exact(int m, const bf16_t* __restrict__ proj, unsigned short* __restrict__ topk, LAS unsigned char* lds) {
    LAS unsigned* keys = (LAS unsigned*)lds;
    LAS float* iqs = (LAS float*)(lds + 32768);
    LAS float* ws = (LAS float*)(lds + 32768 + 2048);
    LAS unsigned* cnt_s = (LAS unsigned*)(lds + 32768 + 2048 + 64);
    LAS unsigned* scan_g = (LAS unsigned*)(lds + 36864);
    LAS unsigned* scan_e = (LAS unsigned*)(lds + 36864 + 2048);
    const int tid = fresh_tid();
    const int b = m / S, t = m % S; const int n = 64 * (t / 64 + 1);
    unsigned short* out = topk + (size_t)m * 256;
    __syncthreads();
    iqs[tid] = (float)((const _Float16*)(proj + P1_IQ))[(size_t)m * 512 + tid];
    if (tid < 8) ws[tid] = ((const float*)(proj + P1_IW))[(size_t)m * 8 + tid];
    __syncthreads();
    for (int j = tid; j < n; j += NTHR) {
        const _Float16* kp = (const _Float16*)(proj + P1_IK) + (((size_t)b * 128 + (j >> 6)) * 8) * 512 + (j & 63) * 8;
        float kf[64];
#pragma unroll
        for (int d = 0; d < 64; ++d) kf[d] = (float)kp[(d >> 3) * 512 + (d & 7)];
        float sc = 0.f;
#pragma unroll 1
        for (int hh = 0; hh < 8; ++hh) { float lg = 0.f;
#pragma unroll
            for (int d = 0; d < 64; ++d) lg += iqs[hh * 64 + d] * kf[d];
            sc += fmaxf(lg, 0.f) * ws[hh]; }
        sc += 0.0f;
        keys[j] = skey(__float_as_uint(sc));
    }
    __syncthreads();
    unsigned T = 0u;
    for (int bit = 31; bit >= 0; --bit) {
        const unsigned cand = T | (1u << bit);
        if (tid == 0) cnt_s[0] = 0u;
        __syncthreads();
        unsigned c0 = 0u;
        for (int j = tid; j < n; j += NTHR) c0 += (keys[j] >= cand) ? 1u : 0u;
        c0 = (unsigned)wave_sum((float)c0);
        if ((tid & 63) == 0) atomicAdd((unsigned*)cnt_s, c0);
        __syncthreads();
        if (cnt_s[0] >= 256u) T = cand;
        __syncthreads();
    }
    const int per = (n + NTHR - 1) / NTHR; const int j0 = tid * per, j1 = (j0 + per < n) ? j0 + per : n;
    unsigned g = 0u, e = 0u;
    for (int j = j0; j < j1; ++j) { const unsigned k = keys[j]; g += (k > T) ? 1u : 0u; e += (k == T) ? 1u : 0u; }
    scan_g[tid] = g; scan_e[tid] = e;
    __syncthreads();
    unsigned pg = 0u, pe = 0u, tg = 0u, te = 0u;
    for (int i = 0; i < NTHR; ++i) { const unsigned gi = scan_g[i], ei = scan_e[i]; if (i < tid) { pg += gi; pe += ei; } tg += gi; te += ei; }
    const unsigned R = 256u - tg;
    unsigned pos = pg + (pe < R ? pe : R), oe = pe;
    for (int j = j0; j < j1; ++j) { const unsigned k = keys[j];
        if (k > T) { out[pos] = (unsigned short)j; ++pos; }
        else if (k == T) { if (oe < R) { out[pos] = (unsigned short)j; ++pos; } ++oe; } }
    __syncthreads();
}

__device__ __forceinline__ void score_block(f32x16& s, const f16x8 (&kf)[4], const f16x8 (&iqf)[8][4], const f16x8 (&cf)[4], const float (&w)[8]) {
    s = (f32x16){};
#pragma unroll
    for (int d0 = 0; d0 < 4; ++d0) s = __builtin_amdgcn_mfma_f32_32x32x16_f16(kf[d0], cf[d0], s, 0, 0, 0);
#pragma unroll
    for (int h = 0; h < 8; ++h) {
        f32x16 L = (f32x16){};
#pragma unroll
        for (int d0 = 0; d0 < 4; ++d0) L = __builtin_amdgcn_mfma_f32_32x32x16_f16(kf[d0], iqf[h][d0], L, 0, 0, 0);
#pragma unroll
        for (int r = 0; r < 16; ++r) s[r] = __builtin_fmaf(__builtin_fabsf(L[r]), w[h], s[r]);
    }
}

__device__ __forceinline__ void topk_unit(int b, int j, const bf16_t* __restrict__ proj, unsigned short* __restrict__ topk, LAS unsigned char* lds, bool force_exact) {
    const int tid = fresh_tid(), lane = tid & 63, r32 = lane & 31, hi = lane >> 5; const int wid = __builtin_amdgcn_readfirstlane(tid >> 6);
    const int row0 = 32 * j, c = row0 >> 6, n = 64 * (c + 1), NT = c + 1;
    const size_t m0 = (size_t)b * S + row0;
    if (n <= 256) {
        for (int i = tid; i < 32 * 256; i += NTHR) { const int k = i & 255; topk[(m0 + (i >> 8)) * 256 + k] = (k < n) ? (unsigned short)k : (unsigned short)0xFFFFu; }
        return;
    }
    if (force_exact) { for (int r = 0; r < 32; ++r) topk_row_exact((int)m0 + r, proj, topk, lds); return; }
    for (int i = tid; i < (32 * HROW) / 4; i += NTHR) ((LAS unsigned*)(lds + L_HIST))[i] = 0u;
    if (tid < 32) ((LAS unsigned*)(lds + L_FLAG))[tid] = 0u;
    f16x8 iqf[8][4], cf[4]; float w[8];
    {
        const _Float16* iqp = (const _Float16*)(proj + P1_IQ) + (m0 + r32) * 512 + 8 * hi;
#pragma unroll
        for (int h = 0; h < 8; ++h)
#pragma unroll
            for (int d0 = 0; d0 < 4; ++d0) iqf[h][d0] = *(const f16x8*)(iqp + h * 64 + d0 * 16);
        const float* wp = (const float*)(proj + P1_IW) + (m0 + r32) * 8;
        const f32x4 w0 = *(const f32x4*)wp, w1 = *(const f32x4*)(wp + 4);
        w[0] = 0.5f * w0.x; w[1] = 0.5f * w0.y; w[2] = 0.5f * w0.z; w[3] = 0.5f * w0.w; w[4] = 0.5f * w1.x; w[5] = 0.5f * w1.y; w[6] = 0.5f * w1.z; w[7] = 0.5f * w1.w;
#pragma unroll
        for (int d0 = 0; d0 < 4; ++d0)
#pragma unroll
            for (int e = 0; e < 8; ++e) { float a = 0.f;
#pragma unroll
                for (int h = 0; h < 8; ++h) a = __builtin_fmaf(w[h], (float)iqf[h][d0][e], a);
                cf[d0][e] = (_Float16)a; }
    }
    const char* ikb = (const char*)((const _Float16*)(proj + P1_IK) + (size_t)b * S * 64) + hi * 1024 + r32 * 16;
    asm volatile("s_waitcnt lgkmcnt(0)\n\ts_barrier" ::: "memory");
    {
        LAS unsigned char* hrow = lds + L_HIST + r32 * HROW;
#pragma unroll 1
        for (int t = wid; t < NT; t += 8)
#pragma unroll 1
            for (int half = 0; half < 2; ++half) {
                f16x8 kf[4];
#pragma unroll
                for (int d0 = 0; d0 < 4; ++d0) kf[d0] = *(const f16x8*)(ikb + (size_t)t * 8192 + half * 512 + d0 * 2048);
                f32x16 s; score_block(s, kf, iqf, cf, w);
#pragma unroll
                for (int r = 0; r < 16; ++r) { const unsigned bn = bin_of(s[r]); __hip_atomic_fetch_add((LAS unsigned*)(hrow + bn * 4), 1u, __ATOMIC_RELAXED, __HIP_MEMORY_SCOPE_WORKGROUP); }
            }
    }
    asm volatile("s_waitcnt lgkmcnt(0)\n\ts_barrier" ::: "memory");
#pragma unroll 1
    for (int rr = 0; rr < 4; ++rr) {
        const int q = 4 * wid + rr;
        const LAS unsigned* hr = (const LAS unsigned*)(lds + L_HIST + q * HROW);
        unsigned cb[8]; unsigned tot = 0u;
#pragma unroll
        for (int i = 0; i < 8; ++i) { cb[i] = hr[511 - 8 * lane - i]; tot += cb[i]; }
        unsigned incl = tot;
#pragma unroll
        for (int o = 1; o < 64; o <<= 1) { const unsigned v = __shfl_up(incl, o); if (lane >= o) incl += v; }
        const unsigned excl = incl - tot;
        const unsigned long long bal = __ballot(incl >= 256u);
        const int L = __builtin_ctzll(bal);
        unsigned run = excl; int tbi = 0; unsigned above = 0u; bool found = false;
#pragma unroll
        for (int i = 0; i < 8; ++i) { if (!found) { if (run + cb[i] >= 256u) { found = true; tbi = 511 - 8 * lane - i; above = run; } else run += cb[i]; } }
        const unsigned tb = (unsigned)__shfl(tbi, L), ab = __shfl(above, L);
        if (lane == 0) { ((LAS unsigned*)(lds + L_TB))[2 * q] = tb; ((LAS unsigned*)(lds + L_TB))[2 * q + 1] = ab; }
    }
    asm volatile("s_waitcnt lgkmcnt(0)\n\ts_barrier" ::: "memory");
    for (int i = tid; i < (32 * BROW) / 4; i += NTHR) ((LAS unsigned*)(lds + L_BMAP))[i] = 0u;
    asm volatile("s_waitcnt lgkmcnt(0)\n\ts_barrier" ::: "memory");
    {
        const unsigned tb = ((const LAS unsigned*)(lds + L_TB))[2 * r32];
        LAS unsigned char* brow = lds + L_BMAP + r32 * BROW;
        const int sg = 2 * wid + hi;
        LAS unsigned* segk = (LAS unsigned*)(lds + L_SEGK) + (r32 * 16 + sg) * SEGCAP;
        LAS unsigned short* segi = (LAS unsigned short*)(lds + L_SEGI) + (r32 * 16 + sg) * SEGCAP;
        unsigned ccnt = 0u;
#pragma unroll 1
        for (int t = wid; t < NT; t += 8)
#pragma unroll 1
            for (int half = 0; half < 2; ++half) {
                f16x8 kf[4];
#pragma unroll
                for (int d0 = 0; d0 < 4; ++d0) kf[d0] = *(const f16x8*)(ikb + (size_t)t * 8192 + half * 512 + d0 * 2048);
                f32x16 s; score_block(s, kf, iqf, cf, w);
                unsigned gm = 0u, em = 0u;
#pragma unroll
                for (int r = 0; r < 16; ++r) { const unsigned bn = bin_of(s[r]); const unsigned bit = 1u << ((r & 3) + 8 * (r >> 2)); gm |= (bn > tb) ? bit : 0u; em |= (bn == tb) ? bit : 0u; }
                if (gm) __hip_atomic_fetch_or((LAS unsigned*)(brow + (2 * t + half) * 4), gm << (4 * hi), __ATOMIC_RELAXED, __HIP_MEMORY_SCOPE_WORKGROUP);
                if (__any(em != 0u)) {
                    const int kbase = 64 * t + 32 * half + 4 * hi;
#pragma unroll
                    for (int r = 0; r < 16; ++r) { if (em & (1u << ((r & 3) + 8 * (r >> 2)))) { if (ccnt < (unsigned)SEGCAP) { segk[ccnt] = __float_as_uint(s[r]); segi[ccnt] = (unsigned short)(kbase + (r & 3) + 8 * (r >> 2)); } ++ccnt; } }
                }
            }
        ((LAS unsigned*)(lds + L_SEGC))[r32 * 16 + sg] = ccnt;
    }
    asm volatile("s_waitcnt lgkmcnt(0)\n\ts_barrier" ::: "memory");
#pragma unroll 1
    for (int rr = 0; rr < 4; ++rr) {
        const int q = 4 * wid + rr;
        const unsigned cmy = (lane < 16) ? ((const LAS unsigned*)(lds + L_SEGC))[q * 16 + lane] : 0u;
        const bool over = __any(cmy > (unsigned)SEGCAP);
        const unsigned above = ((const LAS unsigned*)(lds + L_TB))[2 * q + 1];
        const unsigned R = 256u - above;
        LAS unsigned* bm = (LAS unsigned*)(lds + L_BMAP + q * BROW);
        if (over) { if (lane == 0) ((LAS unsigned*)(lds + L_FLAG))[q] = 1u; }
        else {
            const int sgm = lane >> 2; const unsigned csg = __shfl(cmy, sgm);
            const LAS unsigned* sk = (const LAS unsigned*)(lds + L_SEGK) + (q * 16) * SEGCAP;
            const LAS unsigned short* si = (const LAS unsigned short*)(lds + L_SEGI) + (q * 16) * SEGCAP;
            unsigned ky[3], ixx[3], rk[3]; bool vd[3];
#pragma unroll
            for (int k = 0; k < 3; ++k) { const unsigned e = (lane & 3) + 4 * k; vd[k] = e < csg; const unsigned ee = vd[k] ? e : 0u;
                ky[k] = skey(sk[sgm * SEGCAP + ee]); ixx[k] = si[sgm * SEGCAP + ee]; rk[k] = 0u; }
#pragma unroll 1
            for (int s2 = 0; s2 < 16; ++s2) {
                const int cs = __builtin_amdgcn_readlane((int)cmy, s2);
#pragma unroll 1
                for (int e = 0; e < cs; ++e) { const unsigned kj = skey(sk[s2 * SEGCAP + e]), ij = si[s2 * SEGCAP + e];
#pragma unroll
                    for (int k = 0; k < 3; ++k) rk[k] += ((kj > ky[k]) || (kj == ky[k] && ij < ixx[k])) ? 1u : 0u; }
            }
#pragma unroll
            for (int k = 0; k < 3; ++k) if (vd[k] && rk[k] < R) __hip_atomic_fetch_or(bm + (ixx[k] >> 5), 1u << (ixx[k] & 31), __ATOMIC_RELAXED, __HIP_MEMORY_SCOPE_WORKGROUP);
        }
        asm volatile("s_waitcnt lgkmcnt(0)" ::: "memory");
        const u32x4 wv = *(const LAS u32x4*)(bm + 4 * lane);
        unsigned wd[4] = {wv.x, wv.y, wv.z, wv.w};
        const unsigned pc = __builtin_popcount(wd[0]) + __builtin_popcount(wd[1]) + __builtin_popcount(wd[2]) + __builtin_popcount(wd[3]);
        unsigned incl = pc;
#pragma unroll
        for (int o = 1; o < 64; o <<= 1) { const unsigned v = __shfl_up(incl, o); if (lane >= o) incl += v; }
        unsigned pos = incl - pc;
        unsigned short* out = topk + (m0 + q) * 256;
        if (!over) {
#pragma unroll
            for (int i = 0; i < 4; ++i) { unsigned x = wd[i]; while (x) { const int bpos = __builtin_ctz(x); if (pos < 256u) out[pos] = (unsigned short)(128 * lane + 32 * i + bpos); ++pos; x &= x - 1u; } }
        }
    }
    asm volatile("s_waitcnt vmcnt(0) lgkmcnt(0)\n\ts_barrier" ::: "memory");
    {
        const bool anyf = __any(((const LAS unsigned*)(lds + L_FLAG))[lane & 31] != 0u);
        if (anyf) {
            __syncthreads();
#pragma unroll 1
            for (int r = 0; r < 32; ++r) { const unsigned f = ((const LAS unsigned*)(lds + L_FLAG))[r]; if (f) topk_row_exact((int)m0 + r, proj, topk, lds); }
        }
        __syncthreads();
    }
}

__device__ __forceinline__ void ph_topk(const bf16_t* proj, unsigned short* topk, LAS unsigned char* lds, bool force_exact) {
    const int G = (int)gridDim.x, bid = (int)blockIdx.x;
    if (G == 256) {
        const int b = bid & 7, idx = bid >> 3;
#pragma unroll 1
        for (int i = 0; i < 8; ++i) { const int j = (i & 1) ? 64 * (i >> 1) + 63 - idx : 64 * (i >> 1) + idx; topk_unit(b, j, proj, topk, lds, force_exact); }
    } else {
        for (int u = bid; u < NB * 256; u += G) topk_unit(u >> 8, u & 255, proj, topk, lds, force_exact);
    }
}
}

constexpr int RING_BYTES = 131072, LDSCTL_OFF = RING_BYTES, LDS_BYTES = 147456;
constexpr size_t CTL_ZERO_BYTES = 1 * MiB;
constexpr int CW_TMO = 0, CW_BAR = 4096;

struct Args { const void* in[19]; float* out; unsigned char* ws; };

#define FRESH_IDS const int tid = fresh_tid(), lane = tid & 63, wave = __builtin_amdgcn_readfirstlane(tid >> 6); (void)lane; (void)wave
#define GSTRIDE_WAVES(gw, NGW) const int gw = (int)blockIdx.x * NWAVES + wave, NGW = (int)gridDim.x * NWAVES

__device__ __forceinline__ int src_col(int p, int N, int mode) {
    if (mode == 0) return (p < N) ? p : -1;
    const int tile = p >> 8, wc = (p >> 5) & 3, d = 32 * ((p >> 7) & 1) + (p & 31);
    if (mode == 1) return tile * 256 + 64 * wc + d;
    if (tile < 3) return DQ + 64 * (4 * tile + wc) + d;
    if (tile == 3) return wc == 0 ? DK + d : wc == 1 ? DV + d : wc == 2 ? DIK + d : (d < 8 ? DIW + d : -1);
    if (tile < 6) return DIQ + 64 * (4 * (tile - 4) + wc) + d;
    return DQM + 64 * wc + d;
}
__device__ __forceinline__ void prep_item(const float* __restrict__ W, int K, int N, bf16_t* __restrict__ Wt, int Nout, int mode, LAS float* scr, int item, int lane) {
    const int nblk = Nout / 32, kb = item / nblk, nb = item % nblk, k0 = 64 * kb, p0 = 32 * nb;
    const int p = src_col(p0 + (lane & 31), N, mode);
#pragma unroll 8
    for (int i = 0; i < 32; ++i) { const int kk = 2 * i + (lane >> 5); scr[kk * 33 + (lane & 31)] = (p >= 0) ? W[(size_t)(k0 + kk) * N + p] : 0.f; }
    LDS_WAIT(); asm volatile("" ::: "memory");
    const int c = lane & 7;
#pragma unroll
    for (int j = 0; j < 4; ++j) { const int n = (lane >> 3) + 8 * j; const LAS float* s = scr + (8 * c) * 33 + n;
        u32x4 o; o.x = pk2(s[0 * 33], s[1 * 33]); o.y = pk2(s[2 * 33], s[3 * 33]); o.z = pk2(s[4 * 33], s[5 * 33]); o.w = pk2(s[6 * 33], s[7 * 33]);
        *(u32x4*)(Wt + (size_t)(p0 + n) * K + k0 + 8 * c) = o; }
    LDS_WAIT(); asm volatile("" ::: "memory");
}
__device__ __forceinline__ void prep_matrix(const float* W, int K, int N, bf16_t* Wt, int Nout, int mode, LAS float* scr, int gw, int NGW, int lane) {
    const int nitems = (K / 64) * (Nout / 32);
    for (int it = gw; it < nitems; it += NGW) prep_item(W, K, N, Wt, Nout, mode, scr, it, lane);
}
__device__ __forceinline__ void rms_row_bf16(const float* xrow, const float* g, bf16_t* orow, int lane) {
    const f32x4* xr = (const f32x4*)xrow + lane; const f32x4* gr = (const f32x4*)g + lane;
    f32x4 v[4]; float s = 0.f;
#pragma unroll
    for (int j = 0; j < 4; ++j) { v[j] = xr[64 * j]; s += (v[j].x * v[j].x + v[j].y * v[j].y) + (v[j].z * v[j].z + v[j].w * v[j].w); }
    const float rstd = 1.f / sqrtf(wave_sum(s) * (1.f / D) + EPS);
    unsigned long long* o8 = (unsigned long long*)orow + lane;
#pragma unroll
    for (int j = 0; j < 4; ++j) { const f32x4 gg = gr[64 * j];
        o8[64 * j] = (unsigned long long)pk2(v[j].x * rstd * gg.x, v[j].y * rstd * gg.y) | ((unsigned long long)pk2(v[j].z * rstd * gg.z, v[j].w * rstd * gg.w) << 32); }
}
__device__ __forceinline__ void norm_res_row(const float* yrow, const float* xin, const float* g1, float* xout, const float* g2, bf16_t* hrow, int lane) {
    const f32x4* yr = (const f32x4*)yrow + lane; const f32x4* xr = (const f32x4*)xin + lane;
    f32x4 v[4], xv[4]; float s = 0.f;
#pragma unroll
    for (int j = 0; j < 4; ++j) { v[j] = yr[64 * j]; xv[j] = xr[64 * j]; s += (v[j].x * v[j].x + v[j].y * v[j].y) + (v[j].z * v[j].z + v[j].w * v[j].w); }
    const float rstd = 1.f / sqrtf(wave_sum(s) * (1.f / D) + EPS);
    float s2 = 0.f;
#pragma unroll
    for (int j = 0; j < 4; ++j) { const f32x4 gg = ((const f32x4*)g1 + lane)[64 * j]; xv[j] = xv[j] + v[j] * rstd * gg;
        s2 += (xv[j].x * xv[j].x + xv[j].y * xv[j].y) + (xv[j].z * xv[j].z + xv[j].w * xv[j].w);
        ((f32x4*)xout + lane)[64 * j] = xv[j]; }
    if (g2) {
        const float r2 = 1.f / sqrtf(wave_sum(s2) * (1.f / D) + EPS);
        unsigned long long* o8 = (unsigned long long*)hrow + lane;
#pragma unroll
        for (int j = 0; j < 4; ++j) { const f32x4 gg = ((const f32x4*)g2 + lane)[64 * j];
            o8[64 * j] = (unsigned long long)pk2(xv[j].x * r2 * gg.x, xv[j].y * r2 * gg.y) | ((unsigned long long)pk2(xv[j].z * r2 * gg.z, xv[j].w * r2 * gg.w) << 32); }
    }
}
__device__ __forceinline__ void ph_norm_res(const float* Y, const float* xin, const float* g1, float* xout, const float* g2, bf16_t* H, int wave, int lane) {
    GSTRIDE_WAVES(gw, NGW);
    for (int m = gw; m < M; m += NGW) norm_res_row(Y + (size_t)m * D, xin + (size_t)m * D, g1, xout + (size_t)m * D, g2, H + (size_t)m * D, lane);
}
__device__ __forceinline__ void ph_rope(bf16_t* buf, int ld, const float2* __restrict__ tab, int mode, int nheads) {
    const size_t tot = (size_t)M * nheads * 32;
    const int tid_r = fresh_tid();
    for (size_t idx = (size_t)blockIdx.x * NTHR + tid_r; idx < tot; idx += (size_t)gridDim.x * NTHR) {
        const int i = (int)(idx & 31); const size_t r = idx >> 5; const int hs = (int)(r % nheads); const size_t m = r / nheads;
        int col0;
        if (mode == 0) col0 = 64 * hs; else col0 = (hs < 12) ? 64 * hs : (hs == 12) ? DK : (hs < 21) ? DIQ + 64 * (hs - 13) : DIK;
        bf16_t* p = buf + m * ld + col0 + i; const float2 cs = tab[m * 32 + i];
        const float x1 = bf2f(p[0]), x2 = bf2f(p[32]);
        p[0] = (bf16_t)f2bf(x1 * cs.x - x2 * cs.y); p[32] = (bf16_t)f2bf(x2 * cs.x + x1 * cs.y);
    }
}

__device__ __forceinline__ void ph_attn_diff_naive(const bf16_t* __restrict__ proj, bf16_t* __restrict__ o, const float* __restrict__ lq1, const float* __restrict__ lk1,
                                                   const float* __restrict__ lq2, const float* __restrict__ lk2, const float* __restrict__ gsub) {
    float a1 = 0.f, a2 = 0.f;
    for (int i = 0; i < 64; ++i) { a1 += lq1[i] * lk1[i]; a2 += lq2[i] * lk2[i]; }
    const float lam = expf(a1) - expf(a2) + 0.2f;
    const int tidx = fresh_tid();
    const int half = __builtin_amdgcn_readfirstlane(tidx >> 8), tid = tidx & 255;
    const int NU = NB * 6 * (S / 64);
    for (int u = (int)blockIdx.x * 2 + half; u < NU; u += (int)gridDim.x * 2) {
        const int c = (S / 64 - 1) - (u / (NB * 6)), bh = u % (NB * 6), h = bh % 6, b = bh / 6;
        const int t = c * 64 + (tid >> 2), dq = tid & 3;
        const int nk = 64 * (c + 1);
        float res[32];
#pragma unroll
        for (int br = 0; br < 2; ++br) {
            float q[64];
            const int hs = 2 * h + br;
            const bf16_t* qp = proj + P0_Q + ((size_t)(b * 12 + hs) * S + t) * 64;
#pragma unroll
            for (int d = 0; d < 64; ++d) q[d] = bf2f(qp[d]);
            float acc[32];
#pragma unroll
            for (int i = 0; i < 32; ++i) acc[i] = 0.f;
            float mx = -INFINITY, l = 0.f;
            for (int j = 0; j < nk; ++j) {
                const bf16_t* kp = proj + P0_K + (((size_t)(b * 12 + hs) * 128 + (j >> 6)) * 8) * 512 + (j & 63) * 8;
                const bf16_t* vp = proj + P0_V + (((((size_t)(b * 6 + h) * 128 + (j >> 6)) * 4 + dq) * 64 + (j & 63)) * 32);
                float s = 0.f;
#pragma unroll
                for (int d = 0; d < 64; ++d) s += q[d] * bf2f(kp[(d >> 3) * 512 + (d & 7)]);
                const float mn = fmaxf(mx, s); const float f = exp2f(mx - mn), p = exp2f(s - mn);
                l = l * f + p; mx = mn;
#pragma unroll
                for (int i = 0; i < 32; ++i) acc[i] = acc[i] * f + p * bf2f(vp[i]);
            }
            const float il = 1.f / l;
            if (br == 0) {
#pragma unroll
                for (int i = 0; i < 32; ++i) res[i] = acc[i] * il;
            } else {
#pragma unroll
                for (int i = 0; i < 32; ++i) res[i] -= lam * acc[i] * il;
            }
        }
        float ss = 0.f;
#pragma unroll
        for (int i = 0; i < 32; ++i) ss += res[i] * res[i];
        ss += __shfl_xor(ss, 1); ss += __shfl_xor(ss, 2);
        const float rstd = 1.f / sqrtf(ss * (1.f / 128.f) + EPS);
        bf16_t* op = o + (size_t)(b * S + t) * D + h * 128 + dq * 32;
#pragma unroll
        for (int i = 0; i < 32; ++i) op[i] = (bf16_t)f2bf(res[i] * rstd * gsub[dq * 32 + i] * 0.8f);
    }
}
__device__ __forceinline__ void ph_attn_mem_naive(const bf16_t* __restrict__ qbuf, int qmode, int ld, int qcol0, const bf16_t* __restrict__ kv, bf16_t* __restrict__ o) {
    const int tidx = fresh_tid();
    const int half = __builtin_amdgcn_readfirstlane(tidx >> 8), tid = tidx & 255;
    const int NU = NB * 4 * (S / 64);
    for (int u = (int)blockIdx.x * 2 + half; u < NU; u += (int)gridDim.x * 2) {
        const int c = u % (S / 64), h = (u / (S / 64)) % 4, b = u / ((S / 64) * 4);
        const int t = c * 64 + (tid >> 2), dq = tid & 3;
        float q[64];
        const bf16_t* qp = qmode ? qbuf + ((size_t)(b * 4 + h) * S + t) * 64 : qbuf + (size_t)(b * S + t) * ld + qcol0 + h * 64;
        const float qs = qmode ? 1.f : C2;
#pragma unroll
        for (int d = 0; d < 64; ++d) q[d] = bf2f(qp[d]) * qs;
        float acc[16];
#pragma unroll
        for (int i = 0; i < 16; ++i) acc[i] = 0.f;
        float mx = -INFINITY, l = 0.f;
        for (int j = 0; j < NMEMT; ++j) {
            const bf16_t* kp = kv + MKV_K + (((size_t)(b * 4 + h) * 4 + (j >> 6)) * 8) * 512 + (j & 63) * 8;
            const bf16_t* vp = kv + MKV_V + (((((size_t)(b * 4 + h) * 4 + (j >> 6)) * 2 + (dq >> 1)) * 64 + (j & 63)) * 32) + (dq & 1) * 16;
            float s = 0.f;
#pragma unroll
            for (int d = 0; d < 64; ++d) s += q[d] * bf2f(kp[(d >> 3) * 512 + (d & 7)]);
            const float mn = fmaxf(mx, s); const float f = exp2f(mx - mn), p = exp2f(s - mn);
            l = l * f + p; mx = mn;
#pragma unroll
            for (int i = 0; i < 16; ++i) acc[i] = acc[i] * f + p * bf2f(vp[i]);
        }
        const float il = 1.f / l;
        bf16_t* op = o + (size_t)(b * S + t) * D + 768 + h * 64 + dq * 16;
#pragma unroll
        for (int i = 0; i < 16; ++i) op[i] = (bf16_t)f2bf(acc[i] * il);
    }
}
__device__ __forceinline__ unsigned f2key(float f) { const unsigned u = __float_as_uint(f); return (u & 0x80000000u) ? ~u : (u | 0x80000000u); }
__device__ __forceinline__ void ph_topk_naive(const bf16_t* __restrict__ proj, unsigned short* __restrict__ topk, LAS unsigned char* lds) {
    LAS unsigned* keys = (LAS unsigned*)lds;
    LAS float* iqs = (LAS float*)(lds + 32768);
    LAS float* ws = (LAS float*)(lds + 32768 + 2048);
    LAS unsigned* cnt_s = (LAS unsigned*)(lds + 32768 + 2048 + 64);
    LAS unsigned* scan_g = (LAS unsigned*)(lds + 36864);
    LAS unsigned* scan_e = (LAS unsigned*)(lds + 36864 + 2048);
    const int tid = fresh_tid();
    for (int m = blockIdx.x; m < M; m += gridDim.x) {
        const int b = m / S, t = m % S; const int c = t / 64; const int n = 64 * (c + 1);
        unsigned short* out = topk + (size_t)m * 256;
        if (n <= 256) { if (tid < 256) out[tid] = (tid < n) ? (unsigned short)tid : (unsigned short)0xFFFFu; continue; }
        __syncthreads();
        iqs[tid] = (float)((const _Float16*)(proj + P1_IQ))[(size_t)m * 512 + tid];
        if (tid < 8) ws[tid] = ((const float*)(proj + P1_IW))[(size_t)m * 8 + tid];
        __syncthreads();
        for (int j = tid; j < n; j += NTHR) {
            const _Float16* kp = (const _Float16*)(proj + P1_IK) + (((size_t)b * 128 + (j >> 6)) * 8) * 512 + (j & 63) * 8;
            float kf[64];
#pragma unroll
            for (int d = 0; d < 64; ++d) kf[d] = (float)kp[(d >> 3) * 512 + (d & 7)];
            float sc = 0.f;
#pragma unroll 1
            for (int hh = 0; hh < 8; ++hh) { float lg = 0.f;
#pragma unroll
                for (int d = 0; d < 64; ++d) lg += iqs[hh * 64 + d] * kf[d];
                sc += fmaxf(lg, 0.f) * ws[hh]; }
            sc += 0.0f;
            keys[j] = f2key(sc);
        }
        __syncthreads();
        unsigned T = 0u;
        for (int bit = 31; bit >= 0; --bit) {
            const unsigned cand = T | (1u << bit);
            if (tid == 0) cnt_s[0] = 0u;
            __syncthreads();
            unsigned c0 = 0u;
            for (int j = tid; j < n; j += NTHR) c0 += (keys[j] >= cand) ? 1u : 0u;
            c0 = (unsigned)wave_sum((float)c0);
            if ((tid & 63) == 0) atomicAdd((unsigned*)cnt_s, c0);
            __syncthreads();
            if (cnt_s[0] >= 256u) T = cand;
            __syncthreads();
        }
        const int per = (n + NTHR - 1) / NTHR; const int j0 = tid * per, j1 = (j0 + per < n) ? j0 + per : n;
        unsigned g = 0u, e = 0u;
        for (int j = j0; j < j1; ++j) { const unsigned k = keys[j]; g += (k > T) ? 1u : 0u; e += (k == T) ? 1u : 0u; }
        scan_g[tid] = g; scan_e[tid] = e;
        __syncthreads();
        unsigned pg = 0u, pe = 0u, tg = 0u;
        for (int i = 0; i < NTHR; ++i) { const unsigned gi = scan_g[i], ei = scan_e[i]; if (i < tid) { pg += gi; pe += ei; } tg += gi; }
        const unsigned R = 256u - tg;
        unsigned og = pg, oe = pe;
        for (int j = j0; j < j1; ++j) { const unsigned k = keys[j];
            if (k > T) { out[og] = (unsigned short)j; ++og; }
            else if (k == T) { if (oe < R) out[tg + oe] = (unsigned short)j; ++oe; } }
    }
}
__device__ __forceinline__ void ph_dsa_attn_naive(const bf16_t* __restrict__ proj, const unsigned short* __restrict__ topk, bf16_t* __restrict__ o, int wave, int lane) {
    GSTRIDE_WAVES(gw, NGW);
    const int hd = (lane < 48) ? (lane >> 2) : 0, dq = lane & 3;
    for (int m = gw; m < M; m += NGW) {
        const int b = m / S;
        const bf16_t* row = proj + P1_Q + (size_t)m * 768;
        float q[64];
#pragma unroll
        for (int d = 0; d < 64; ++d) q[d] = bf2f(row[hd * 64 + d]);
        float acc[16];
#pragma unroll
        for (int i = 0; i < 16; ++i) acc[i] = 0.f;
        float mx = -INFINITY, l = 0.f;
        const unsigned short* ix = topk + (size_t)m * 256;
        for (int jj = 0; jj < 256; ++jj) {
            const unsigned j = ix[jj]; if (j == 0xFFFFu) continue;
            const bf16_t* kp = proj + P1_K + (size_t)(b * S + j) * 64;
            const bf16_t* vp = proj + P1_V + (size_t)(b * S + j) * 64 + dq * 16;
            float s = 0.f;
#pragma unroll
            for (int d = 0; d < 64; ++d) s += q[d] * bf2f(kp[d]);
            const float mn = fmaxf(mx, s); const float f = exp2f(mx - mn), p = exp2f(s - mn);
            l = l * f + p; mx = mn;
#pragma unroll
            for (int i = 0; i < 16; ++i) acc[i] = acc[i] * f + p * bf2f(vp[i]);
        }
        if (lane < 48) {
            const float il = 1.f / l;
            bf16_t* op = o + (size_t)m * D + hd * 64 + dq * 16;
#pragma unroll
            for (int i = 0; i < 16; ++i) op[i] = (bf16_t)f2bf(acc[i] * il);
        }
    }
}

__device__ __forceinline__ void ph_attn_diff(const bf16_t* P, bf16_t* O, const float* lq1, const float* lk1, const float* lq2, const float* lk2, const float* gsub, LAS unsigned char* lds) {
    float a1 = 0.f, a2 = 0.f;
    for (int i = 0; i < 64; ++i) { a1 += lq1[i] * lk1[i]; a2 += lq2[i] * lk2[i]; }
    const float lam = expf(a1) - expf(a2) + 0.2f;
    const int G = (int)gridDim.x, bid = (int)blockIdx.x; const int vcu = (G % 8 == 0) ? (bid % 8) * (G / 8) + bid / 8 : bid;
    for (int i = 0; ; ++i) {
        const int pu = vcu + (i >> 1) * G; if (pu >= NB * 6 * 32) break;
        const int bh = pu >> 5, pair = pu & 31, b = bh / 6, h = bh % 6; const int qblk = (i & 1) ? pair : 63 - pair;
        fa::Unit U;
        U.q0 = P + P0_Q + (size_t)(b * 12 + 2 * h) * S * 64; U.q1 = U.q0 + (size_t)S * 64;
        U.k0 = P + P0_K + (size_t)(b * 12 + 2 * h) * S * 64; U.k1 = U.k0 + (size_t)S * 64;
        U.v = P + P0_V + (size_t)(b * 6 + h) * S * 128; U.qrow0 = qblk * 128; U.nt = 2 * qblk + 2;
        fa::attn_unit<2, 128>(U, true, O, b * S, h * 128, lam, gsub, 0.8f, lds);
    }
}
__device__ __forceinline__ void ph_attn_mem(const bf16_t* QM, const bf16_t* kv, bf16_t* O, LAS unsigned char* lds) {
    for (int u = (int)blockIdx.x; u < NB * 4 * (S / 256); u += (int)gridDim.x) {
        const int b = u >> 7, mh = (u >> 5) & 3, qb = u & 31;
        fa::Unit U;
        U.q0 = QM + (size_t)(b * 4 + mh) * S * 64; U.q1 = U.q0;
        U.k0 = kv + MKV_K + (size_t)(b * 4 + mh) * NMEMT * 64; U.k1 = U.k0;
        U.v = kv + MKV_V + (size_t)(b * 4 + mh) * NMEMT * 64; U.qrow0 = qb * 256; U.nt = 4;
        fa::attn_unit<1, 64>(U, false, O, b * S, 768 + mh * 64, 0.f, nullptr, 1.f, lds);
    }
}

#ifndef IX_FORCE_EXACT
#define IX_FORCE_EXACT 0
#endif
#define GEMM_PHASE(EPI, Aptr, Bptr, Mr, Nn, Kk, ...) do { pg8::Gemm g_{(Aptr), (Bptr), (Mr), (Nn), (Kk)}; pg8::StaticOrder S_; S_.init((Mr), (Nn), (int)gridDim.x, (int)blockIdx.x); \
    EPI E_{__VA_ARGS__}; pg8::gemm_phase<EPI, pg8::StaticOrder, true, true>(lds, g_, S_, E_); } while (0)

__global__ void __launch_bounds__(NTHR, 2) mk_fwd(Args args) {
    extern __shared__ __attribute__((aligned(16))) unsigned char lds_raw[];
    LAS unsigned char* lds = (LAS unsigned char*)lds_raw;
    unsigned char* ws = args.ws; float* out = args.out;
    const float* x = (const float*)args.in[0]; const float* mem = (const float*)args.in[1]; const int* pos = (const int*)args.in[2];
    const float* g_pre_mix = (const float*)args.in[3]; const float* g_post_mix = (const float*)args.in[4]; const float* g_mem = (const float*)args.in[5];
    const float* w_mem_kv = (const float*)args.in[6]; const float* w_out = (const float*)args.in[7]; const float* g_pre_mlp = (const float*)args.in[8];
    const float* g_post_mlp = (const float*)args.in[9]; const float* w_up = (const float*)args.in[10]; const float* w_dn = (const float*)args.in[11];
    const float* w_in_diff = (const float*)args.in[12]; const float* lq1 = (const float*)args.in[13]; const float* lk1 = (const float*)args.in[14];
    const float* lq2 = (const float*)args.in[15]; const float* lk2 = (const float*)args.in[16]; const float* gsub = (const float*)args.in[17]; const float* w_in_dsa = (const float*)args.in[18];
    bf16_t* Win0 = (bf16_t*)(ws + WS_WIN0); bf16_t* Win1 = (bf16_t*)(ws + WS_WIN1); bf16_t* Wout = (bf16_t*)(ws + WS_WOUT);
    bf16_t* Wup = (bf16_t*)(ws + WS_WUP); bf16_t* Wdn = (bf16_t*)(ws + WS_WDN); bf16_t* Wkv = (bf16_t*)(ws + WS_WKV);
    bf16_t* memn = (bf16_t*)(ws + WS_MEMN); bf16_t* memkv = (bf16_t*)(ws + WS_MEMKV); float2* rope = (float2*)(ws + WS_ROPE);
    unsigned short* topk = (unsigned short*)(ws + WS_TOPK); bf16_t* H = (bf16_t*)(ws + WS_H); bf16_t* proj = (bf16_t*)(ws + WS_PROJ);
    bf16_t* O = (bf16_t*)(ws + WS_O); bf16_t* hid = (bf16_t*)(ws + WS_HID); float* Y = (float*)(ws + WS_Y);
    gu32* ctl = (gu32*)(ws + WS_CTL);

    for (int u = threadIdx.x; u < (LDS_BYTES - LDSCTL_OFF) / 4; u += NTHR) ((LAS unsigned*)(lds + LDSCTL_OFF))[u] = 0u;
    __syncthreads();
    XcdBarrier bar = xcd_barrier_post((unsigned*)(ctl + CW_BAR), (volatile LAS unsigned*)(lds + LDSCTL_OFF + 64));
#define GRID_BAR() xcd_barrier(bar)

    {
        FRESH_IDS;
        LAS float* scr = (LAS float*)(lds + wave * 16384);
        GSTRIDE_WAVES(gw, NGW);
        prep_matrix(w_in_diff, D, NDIFF, Win0, NDIFF, 1, scr, gw, NGW, lane);
        prep_matrix(w_in_dsa, D, NDSA_L, Win1, NDSA, 2, scr, gw, NGW, lane);
#pragma unroll 1
        for (int l = 0; l < 2; ++l) {
            prep_matrix(w_out + (size_t)l * D * D, D, D, Wout + (size_t)l * D * D, D, 0, scr, gw, NGW, lane);
            prep_matrix(w_up + (size_t)l * D * FF, D, FF, Wup + (size_t)l * D * FF, FF, 0, scr, gw, NGW, lane);
            prep_matrix(w_dn + (size_t)l * D * FF, FF, D, Wdn + (size_t)l * D * FF, D, 0, scr, gw, NGW, lane);
            prep_matrix(w_mem_kv + (size_t)l * D * 512, D, 512, Wkv + (size_t)l * D * 512, 512, 1, scr, gw, NGW, lane);
            for (int m = gw; m < NB * NMEMT; m += NGW) rms_row_bf16(mem + (size_t)m * D, g_mem + l * D, memn + ((size_t)l * NB * NMEMT + m) * D, lane);
        }
        for (int idx = (int)blockIdx.x * NTHR + tid; idx < M * 32; idx += (int)gridDim.x * NTHR) {
            const int m = idx >> 5, i = idx & 31;
            const double inv = pow(10000.0, -(double)i / 32.0); const double ang = (double)pos[m] * inv;
            rope[idx] = make_float2((float)cos(ang), (float)sin(ang));
        }
        for (int m = gw; m < M; m += NGW) rms_row_bf16(x + (size_t)m * D, g_pre_mix, H + (size_t)m * D, lane);
    }
    GRID_BAR();
    GEMM_PHASE(EpiMemKV, memn, Wkv, NB * NMEMT, 512, D, memkv);
    GEMM_PHASE(EpiMemKV, memn + (size_t)NB * NMEMT * D, Wkv + (size_t)D * 512, NB * NMEMT, 512, D, memkv + MKV_LAYER);
    GEMM_PHASE(EpiProj0, H, Win0, M, NDIFF, D, proj, rope);
    GRID_BAR();
    ph_attn_diff(proj, O, lq1, lk1, lq2, lk2, gsub, lds);
    ph_attn_mem(proj + P0_QM, memkv, O, lds);
    GRID_BAR();
    GEMM_PHASE(EpiF, O, Wout, M, D, D, Y, D);
    GRID_BAR();
    { FRESH_IDS; ph_norm_res(Y, x, g_post_mix, out, g_pre_mlp, H, wave, lane); }
    GRID_BAR();
    GEMM_PHASE(EpiB<2>, H, Wup, M, FF, D, hid, FF);
    GRID_BAR();
    GEMM_PHASE(EpiF, hid, Wdn, M, D, FF, Y, D);
    GRID_BAR();
    { FRESH_IDS; ph_norm_res(Y, out, g_post_mlp, out, g_pre_mix + D, H, wave, lane); }
    GRID_BAR();
    GEMM_PHASE(EpiProj1, H, Win1, M, NDSA, D, proj, rope);
    GRID_BAR();
    ix::ph_topk(proj, topk, lds, IX_FORCE_EXACT != 0);
    GRID_BAR();
    { FRESH_IDS; ph_dsa_attn_naive(proj, topk, O, wave, lane); }
    ph_attn_mem(proj + P1_QM, memkv + MKV_LAYER, O, lds);
    GRID_BAR();
    GEMM_PHASE(EpiF, O, Wout + (size_t)D * D, M, D, D, Y, D);
    GRID_BAR();
    { FRESH_IDS; ph_norm_res(Y, out, g_post_mix + D, out, g_pre_mlp + D, H, wave, lane); }
    GRID_BAR();
    GEMM_PHASE(EpiB<2>, H, Wup + (size_t)D * FF, M, FF, D, hid, FF);
    GRID_BAR();
    GEMM_PHASE(EpiF, hid, Wdn + (size_t)D * FF, M, D, FF, Y, D);
    GRID_BAR();
    { FRESH_IDS; ph_norm_res(Y, out, g_post_mlp + D, out, (const float*)nullptr, H, wave, lane); }
}

extern "C" void kernel_launch(void* const* d_in, const int* in_sizes, int n_in, void* d_out, int out_size, void* d_ws, size_t ws_size, hipStream_t stream) {
    static int grid = 0;
    if (grid == 0) {
        if (n_in != 19 || out_size != M * D || ws_size < WS_END) { fprintf(stderr, "kernel_launch: unexpected shapes n_in %d out %d ws %zu\n", n_in, out_size, ws_size); grid = -1; return; }
        int dev = 0, cus = 0, per_cu = 0;
        if (hipGetDevice(&dev) != hipSuccess || hipDeviceGetAttribute(&cus, hipDeviceAttributeMultiprocessorCount, dev) != hipSuccess) { grid = -1; return; }
        if (hipFuncSetAttribute((const void*)mk_fwd, hipFuncAttributeMaxDynamicSharedMemorySize, LDS_BYTES) != hipSuccess) { fprintf(stderr, "kernel_launch: hipFuncSetAttribute failed\n"); grid = -1; return; }
        if (hipOccupancyMaxActiveBlocksPerMultiprocessor(&per_cu, (const void*)mk_fwd, NTHR, LDS_BYTES) != hipSuccess || per_cu < 1) { fprintf(stderr, "kernel_launch: occupancy query says %d blocks per CU\n", per_cu); grid = -1; (void)hipGetLastError(); return; }
        grid = cus;
    }
    if (grid < 0) return;
    (void)hipMemsetAsync((char*)d_ws + WS_CTL, 0, CTL_ZERO_BYTES, stream);
    Args a; memset(&a, 0, sizeof(a));
    for (int i = 0; i < 19; ++i) a.in[i] = d_in[i];
    a.out = (float*)d_out; a.ws = (unsigned char*)d_ws;
    hipLaunchKernelGGL(mk_fwd, dim3(grid), dim3(NTHR), LDS_BYTES, stream, a);
}
```

```cpp
#include <hip/hip_runtime.h>
#include <cstdio>
#include <cstdint>
#include <cstring>
namespace pg8 {
#define PG8_LAS __attribute__((address_space(3)))
typedef unsigned short bf16_t;
typedef short bf16x8 __attribute__((ext_vector_type(8)));
typedef float f32x4 __attribute__((ext_vector_type(4)));
typedef unsigned u32x4 __attribute__((ext_vector_type(4)));
constexpr int BM = 256, BK = 64, HALF = 128, HTB = HALF * BK * 2  , STAGE_BYTES = 8 * HTB, NXCD = 8, WGM = 8;

__host__ __device__ __forceinline__ int lds_byte(int r, int c) { const int st = (r >> 4) * 2 + (c >> 5), rr = r & 15, cc = c & 31, ob = rr * 64 + cc * 2; return st * 1024 + (ob ^ (((ob >> 9) & 1) << 5)); }
__host__ __device__ __forceinline__ void stage_rc(int b, int& R, int& C) { const int st = b / 1024, sb = b % 1024, swz = sb ^ (((sb >> 9) & 1) << 5); R = (st >> 1) * 16 + swz / 64; C = (st & 1) * 32 + (swz % 64) / 2; }
__host__ __device__ __forceinline__ int perm32(int rho) { const int n = rho >> 4, i = rho & 15; return 8 * (i >> 2) + 4 * n + (i & 3); }

struct Unit { int pm, pn; };
struct Gemm { const bf16_t* A; const bf16_t* Bt; int M, N, K; };

struct StaticOrder {
    int nM, nN, nwg, G, c;
    __host__ __device__ void init(int M, int N, int G_, int c_) { nM = M / BM; nN = N / BM; nwg = nM * nN; G = G_; c = c_; }
    __host__ __device__ bool next(int i, Unit& u) const {
        const long L = (long)i * G + c; if (L >= nwg) return false;
        int wgid = (int)L; { const int q = nwg / NXCD, r = nwg % NXCD, xcd = wgid % NXCD, off = wgid / NXCD; wgid = (xcd < r ? xcd * (q + 1) : r * (q + 1) + (xcd - r) * q) + off; }
        const int nig = WGM * nN, gid = wgid / nig, fm = gid * WGM, gsz = (nM - fm) < WGM ? (nM - fm) : WGM;
        u.pm = fm + ((wgid % nig) % gsz); u.pn = (wgid % nig) / gsz; return true;
    }
    __device__ __forceinline__ void a_ready(const Unit&) const {}
    __device__ __forceinline__ void done(const Unit&) const {}
};

__device__ __forceinline__ unsigned cvt_pk_bf16(float lo, float hi) { unsigned r; asm volatile("v_cvt_pk_bf16_f32 %0, %1, %2" : "=v"(r) : "v"(lo), "v"(hi)); return r; }
typedef float f32x2 __attribute__((ext_vector_type(2)));
__device__ __forceinline__ f32x2 gelu_pk(f32x2 v) {
    const f32x2 av = __builtin_elementwise_abs(v), d = av * 0.2316418882f + 1.0f;
    f32x2 t; t.x = __builtin_amdgcn_rcpf(d.x); t.y = __builtin_amdgcn_rcpf(d.y);
    f32x2 q = t * 0.5307027145f + (-0.7265760135f); q = q * t + 0.7107068705f; q = q * t + (-0.142248368f); q = q * t + 0.127414796f; q = q * t;
    const f32x2 s = (v * v) * (-0.72134752044f);
    f32x2 e; e.x = __builtin_amdgcn_exp2f(s.x); e.y = __builtin_amdgcn_exp2f(s.y);
    const f32x2 m = v * (q * e), r = v - m;
    f32x2 o; o.x = v.x < 0.f ? m.x : r.x; o.y = v.y < 0.f ? m.y : r.y; return o;
}

template <int ACT  > struct EpiBf16 {
    static constexpr bool PERM = true, AFTER_DRAIN = false; static_assert(ACT == 0 || ACT == 1, "EpiBf16: ACT is 0 (none) or 1 (gelu_pk)");
    bf16_t* O; int ldc; const float* bias; int split_cols; size_t split_stride; float scale0;
    __device__ __forceinline__ void operator()(const f32x4 (&acc)[2][2][4][2], const Unit& u, int wr, int wc, int fr, int fq) const {
        const int row0 = u.pm * BM + wr * 64 + fr; int colt = u.pn * BM; bf16_t* base = O;
        float sc = 1.f; if (split_cols) { const int t = colt / split_cols; base += (size_t)t * split_stride; colt -= t * split_cols; if (t == 0) sc = scale0; }
        const int col0 = colt + wc * 32 + 8 * fq, bcol0 = u.pn * BM + wc * 32 + 8 * fq;
        f32x4 bv[2][2];
#pragma unroll
        for (int bj = 0; bj < 2; ++bj)
#pragma unroll
            for (int n = 0; n < 2; ++n) bv[bj][n] = bias ? *(const f32x4*)(bias + bcol0 + bj * HALF + 4 * n) : (f32x4){0.f, 0.f, 0.f, 0.f};
#pragma unroll
        for (int ai = 0; ai < 2; ++ai)
#pragma unroll
            for (int m = 0; m < 4; ++m) { bf16_t* rowp = base + (size_t)(row0 + ai * HALF + m * 16) * ldc + col0;
#pragma unroll
                for (int bj = 0; bj < 2; ++bj) { f32x4 v0 = acc[ai][bj][m][0] + bv[bj][0], v1 = acc[ai][bj][m][1] + bv[bj][1];
                    if (ACT == 1) { f32x2 a = gelu_pk((f32x2){v0[0], v0[1]}), b = gelu_pk((f32x2){v0[2], v0[3]}), c = gelu_pk((f32x2){v1[0], v1[1]}), d = gelu_pk((f32x2){v1[2], v1[3]});
                        v0 = (f32x4){a.x, a.y, b.x, b.y}; v1 = (f32x4){c.x, c.y, d.x, d.y}; }
                    v0 = v0 * sc; v1 = v1 * sc; u32x4 w; w.x = cvt_pk_bf16(v0[0], v0[1]); w.y = cvt_pk_bf16(v0[2], v0[3]); w.z = cvt_pk_bf16(v1[0], v1[1]); w.w = cvt_pk_bf16(v1[2], v1[3]);
                    *(u32x4*)(rowp + bj * HALF) = w; } }
    }
};

struct PanelStats {
    unsigned* xbuf;
    unsigned* cnt;
    unsigned* tmo;
    int ntn; float eps;
    unsigned code;
    __device__ __forceinline__ bool run(const f32x4 (&v)[2][2][4][2], const Unit& u, int wr, int wc, int fr, int fq, PG8_LAS unsigned char* lds, int wid, int lane) const {
        typedef float f32x2v __attribute__((ext_vector_type(2)));
        PG8_LAS f32x2v* P = (PG8_LAS f32x2v*)lds;
        PG8_LAS f32x2v* S = (PG8_LAS f32x2v*)(lds + 8192);
        PG8_LAS unsigned* flag = (PG8_LAS unsigned*)(lds + 8192 + 2048);
#pragma unroll
        for (int ai = 0; ai < 2; ++ai)
#pragma unroll
            for (int m = 0; m < 4; ++m) {
                float s = 0.f;
#pragma unroll
                for (int bj = 0; bj < 2; ++bj)
#pragma unroll
                    for (int n = 0; n < 2; ++n) { const f32x4 x = v[ai][bj][m][n]; s += (x[0] + x[1]) + (x[2] + x[3]); }
                s += __shfl_xor(s, 16); s += __shfl_xor(s, 32);
                const float mw = s * (1.0f / 64.0f); float q = 0.f;
#pragma unroll
                for (int bj = 0; bj < 2; ++bj)
#pragma unroll
                    for (int n = 0; n < 2; ++n) { const f32x4 d = v[ai][bj][m][n] - mw; q += (d[0] * d[0] + d[1] * d[1]) + (d[2] * d[2] + d[3] * d[3]); }
                q += __shfl_xor(q, 16); q += __shfl_xor(q, 32);
                if (fq == 0) P[(ai * HALF + wr * 64 + m * 16 + fr) * 4 + wc] = (f32x2v){mw, q};
            }
        asm volatile("s_waitcnt lgkmcnt(0)" ::: "memory"); __builtin_amdgcn_s_barrier(); asm volatile("" ::: "memory");
#if defined(BROKEN_EXCHANGE_NO_WAIT)
#warning BROKEN CONTROL BUILD: the row-statistics exchange does not wait; results are wrong by design
        if (blockIdx.x >= 64) { const long long t0_ = clock64(); while (clock64() - t0_ < 60000) __builtin_amdgcn_s_sleep(8); }
#endif
        const int row = wid * 32 + (lane & 31);
        if (lane < 32) {
            const f32x2v a = P[row * 4 + 0], b = P[row * 4 + 1], c = P[row * 4 + 2], d = P[row * 4 + 3];
            const float mt = (a.x + b.x + c.x + d.x) * 0.25f;
            const float da = a.x - mt, db = b.x - mt, dc = c.x - mt, dd = d.x - mt;
            const float m2 = (a.y + b.y) + (c.y + d.y) + 64.0f * ((da * da + db * db) + (dc * dc + dd * dd));
            unsigned long long* slot = (unsigned long long*)xbuf + ((size_t)(u.pm * BM + row) * 4 + u.pn);
            __hip_atomic_store(slot, ((unsigned long long)__float_as_uint(m2) << 32) | __float_as_uint(mt), __ATOMIC_RELAXED, __HIP_MEMORY_SCOPE_AGENT);
        }
        asm volatile("s_waitcnt vmcnt(0)" ::: "memory");
        if (lane == 0) __hip_atomic_fetch_add(cnt + 64 * u.pm, 1u, __ATOMIC_RELAXED, __HIP_MEMORY_SCOPE_AGENT);
        if (wid == 0) {
            bool dead = false; const unsigned long long t0 = __builtin_amdgcn_s_memrealtime(); const unsigned want = 8u * (unsigned)ntn;
            for (;;) {
#if defined(BROKEN_EXCHANGE_NO_WAIT)
                break;
#endif
                if ((unsigned)__builtin_amdgcn_readfirstlane(__hip_atomic_load(cnt + 64 * u.pm, __ATOMIC_RELAXED, __HIP_MEMORY_SCOPE_AGENT)) >= want) break;
                if (__builtin_amdgcn_s_memrealtime() - t0 > 2000000ull) {
                    if (lane == 0) { unsigned expect = 0u; __hip_atomic_compare_exchange_strong(tmo + 1, &expect, code | (unsigned)(u.pm & 0xff), __ATOMIC_RELAXED, __ATOMIC_RELAXED, __HIP_MEMORY_SCOPE_AGENT);
                                     __hip_atomic_store(tmo, 1u, __ATOMIC_RELAXED, __HIP_MEMORY_SCOPE_AGENT); }
                    dead = true; break; }
                __builtin_amdgcn_s_sleep(2);
            }
            __builtin_amdgcn_fence(__ATOMIC_ACQUIRE, "agent");
            if (lane == 0) flag[0] = dead ? 1u : 0u;
        }
        asm volatile("s_waitcnt vmcnt(0) lgkmcnt(0)" ::: "memory"); __builtin_amdgcn_s_barrier(); asm volatile("" ::: "memory");
        const bool bad = flag[0] != 0u;
        if (lane < 32) {
            const unsigned long long* slot = (const unsigned long long*)xbuf + (size_t)(u.pm * BM + row) * 4; float mt[4], m2[4]; float ms = 0.f;
#pragma unroll
            for (int t = 0; t < 4; ++t) { if (t < ntn) { const unsigned long long w = __hip_atomic_load(slot + t, __ATOMIC_RELAXED, __HIP_MEMORY_SCOPE_AGENT); mt[t] = __uint_as_float((unsigned)w); m2[t] = __uint_as_float((unsigned)(w >> 32)); } else { mt[t] = 0.f; m2[t] = 0.f; } ms += mt[t]; }
            const float mean = ms / (float)ntn; float q = 0.f;
#pragma unroll
            for (int t = 0; t < 4; ++t) if (t < ntn) { const float dm = mt[t] - mean; q += m2[t] + 256.0f * dm * dm; }
            S[row] = (f32x2v){mean, 1.0f / sqrtf(q / (256.0f * (float)ntn) + eps)};
        }
        asm volatile("s_waitcnt lgkmcnt(0)" ::: "memory"); __builtin_amdgcn_s_barrier(); asm volatile("" ::: "memory");
        return bad;
    }
};
struct EpiLnRes {
    static constexpr bool PERM = false, AFTER_DRAIN = true;
    const float* base; float* out; int ldc; const float* bias; PanelStats st; unsigned poison;
    __device__ __forceinline__ void fused(f32x4 (&acc)[2][2][4][2], const Unit& u, int wr, int wc, int fr, int fq, PG8_LAS unsigned char* lds, int wid, int lane) const {
        typedef float f32x2v __attribute__((ext_vector_type(2)));
        const PG8_LAS f32x2v* S = (const PG8_LAS f32x2v*)(lds + 8192);
        const int col0 = u.pn * BM + wc * 32 + 4 * fq;
#pragma unroll
        for (int bj = 0; bj < 2; ++bj)
#pragma unroll
            for (int n = 0; n < 2; ++n) { const f32x4 bv = bias ? *(const f32x4*)(bias + col0 + bj * HALF + n * 16) : (f32x4){0.f, 0.f, 0.f, 0.f};
#pragma unroll
                for (int ai = 0; ai < 2; ++ai)
#pragma unroll
                    for (int m = 0; m < 4; ++m) acc[ai][bj][m][n] += bv; }
        f32x4 pre[4][2][2];
#pragma unroll
        for (int m = 0; m < 4; ++m) { const size_t off = (size_t)(u.pm * BM + wr * 64 + m * 16 + fr) * ldc + col0;
#pragma unroll
            for (int bj = 0; bj < 2; ++bj)
#pragma unroll
                for (int n = 0; n < 2; ++n) pre[m][bj][n] = *(const f32x4*)(base + off + bj * HALF + n * 16); }
        const bool bad = st.run(acc, u, wr, wc, fr, fq, lds, wid, lane) || poison != 0u;
        const float qnan = __builtin_nanf("");
#pragma unroll
        for (int ai = 0; ai < 2; ++ai)
#pragma unroll
            for (int m = 0; m < 4; ++m) { const int r = ai * HALF + wr * 64 + m * 16 + fr; const f32x2v sr = S[r]; const size_t off = (size_t)(u.pm * BM + r) * ldc + col0;
#pragma unroll
                for (int bj = 0; bj < 2; ++bj)
#pragma unroll
                    for (int n = 0; n < 2; ++n) { const f32x4 bs = ai == 0 ? pre[m][bj][n] : *(const f32x4*)(base + off + bj * HALF + n * 16); f32x4 o = bs + (acc[ai][bj][m][n] - sr.x) * sr.y;
                        if (bad) o = (f32x4){qnan, qnan, qnan, qnan}; *(f32x4*)(out + off + bj * HALF + n * 16) = o; }
                if (m & 1) asm volatile("" ::: "memory"); }
    }
};
struct EpiLnResLn {
    static constexpr bool PERM = false, AFTER_DRAIN = true;
    const float* base; float* out; bf16_t* xn; int ldc; const float* bias; PanelStats st1, st2; unsigned poison;
    __device__ __forceinline__ void fused(f32x4 (&acc)[2][2][4][2], const Unit& u, int wr, int wc, int fr, int fq, PG8_LAS unsigned char* lds, int wid, int lane) const {
        typedef float f32x2v __attribute__((ext_vector_type(2))); typedef unsigned u32x2v __attribute__((ext_vector_type(2)));
        const PG8_LAS f32x2v* S = (const PG8_LAS f32x2v*)(lds + 8192);
        const int col0 = u.pn * BM + wc * 32 + 4 * fq;
#pragma unroll
        for (int bj = 0; bj < 2; ++bj)
#pragma unroll
            for (int n = 0; n < 2; ++n) { const f32x4 bv = bias ? *(const f32x4*)(bias + col0 + bj * HALF + n * 16) : (f32x4){0.f, 0.f, 0.f, 0.f};
#pragma unroll
                for (int ai = 0; ai < 2; ++ai)
#pragma unroll
                    for (int m = 0; m < 4; ++m) acc[ai][bj][m][n] += bv; }
        bool bad = st1.run(acc, u, wr, wc, fr, fq, lds, wid, lane) || poison != 0u;
        const float qnan = __builtin_nanf("");
#pragma unroll
        for (int ai = 0; ai < 2; ++ai)
#pragma unroll
            for (int m = 0; m < 4; ++m) { const int r = ai * HALF + wr * 64 + m * 16 + fr; const f32x2v sr = S[r]; const size_t off = (size_t)(u.pm * BM + r) * ldc + col0;
#pragma unroll
                for (int bj = 0; bj < 2; ++bj)
#pragma unroll
                    for (int n = 0; n < 2; ++n) { const f32x4 bs = *(const f32x4*)(base + off + bj * HALF + n * 16); acc[ai][bj][m][n] = bs + (acc[ai][bj][m][n] - sr.x) * sr.y; }
                asm volatile("" : "+v"(acc[ai][0][m][0]), "+v"(acc[ai][0][m][1]), "+v"(acc[ai][1][m][0]), "+v"(acc[ai][1][m][1]));
                if (m & 1) asm volatile("" ::: "memory"); }
        const bool bad1 = bad;
        bad = st2.run(acc, u, wr, wc, fr, fq, lds, wid, lane) || bad;
#pragma unroll
        for (int ai = 0; ai < 2; ++ai)
#pragma unroll
            for (int m = 0; m < 4; ++m) { const int r = ai * HALF + wr * 64 + m * 16 + fr; const f32x2v sr = S[r]; const size_t off = (size_t)(u.pm * BM + r) * ldc + col0;
#pragma unroll
                for (int bj = 0; bj < 2; ++bj)
#pragma unroll
                    for (int n = 0; n < 2; ++n) { const f32x4 x1 = acc[ai][bj][m][n]; *(f32x4*)(out + off + bj * HALF + n * 16) = bad1 ? (f32x4){qnan, qnan, qnan, qnan} : x1;
                        const f32x4 o = (x1 - sr.x) * sr.y; u32x2v w; w.x = cvt_pk_bf16(o[0], o[1]); w.y = cvt_pk_bf16(o[2], o[3]);
                        if (bad) { w.x = 0x7fc07fc0u; w.y = 0x7fc07fc0u; } *(u32x2v*)(xn + off + bj * HALF + n * 16) = w; }
                asm volatile("" ::: "memory"); }
    }
};

template <class Epi, class Sched, bool ALIGN_EPI = false, bool SP2 = false>
__device__ __forceinline__ void gemm_phase(PG8_LAS unsigned char* lds, const Gemm g, const Sched& S, const Epi& E) {
    int tid_ = threadIdx.x; asm volatile("" : "+v"(tid_));
    const int tid = tid_, wid = __builtin_amdgcn_readfirstlane(tid >> 6), lane = tid & 63, wr = wid >> 2, wc = wid & 3, fr = lane & 15, fq = lane >> 4;
    const int K = g.K, nt = K / BK;
    unsigned voffA[2], voffB[2];
#pragma unroll
    for (int i = 0; i < 2; ++i) { int R, C; stage_rc(tid * 16 + i * 8192, R, C); const int Rb = Epi::PERM ? ((R & ~31) + perm32(R & 31)) : R;
        voffA[i] = (unsigned)(R * K + C) * 2u; voffB[i] = (unsigned)(Rb * K + C) * 2u; }
    const size_t kstep = (size_t)(BK * 2);
    const size_t hstep = (size_t)HALF * K * 2;
    const size_t tstep = 2 * hstep;
    const unsigned ldsw = (unsigned)wid * 1024u;
    const int aoff = lds_byte(wr * 64 + fr, fq * 8), boff = lds_byte(wc * 32 + fr, fq * 8);
#define PG8_SA(b, h) (((b) * 2 + (h)) * HTB)
#define PG8_SB(b, h) ((4 + (b) * 2 + (h)) * HTB)
#define PG8_STAGE(bufoff, gbase, voff) do { _Pragma("unroll") for (int _i = 0; _i < 2; ++_i) \
        __builtin_amdgcn_global_load_lds((const unsigned*)((const char*)(gbase) + (voff)[_i]), (PG8_LAS unsigned*)(lds + (bufoff) + ldsw + _i * 8192), 16, 0, 0); } while (0)
#define PG8_LDA(dst, b, h) do { _Pragma("unroll") for (int m = 0; m < 4; ++m) _Pragma("unroll") for (int k = 0; k < 2; ++k) dst[m][k] = *(const PG8_LAS bf16x8*)(lds + PG8_SA(b, h) + aoff + m * 2048 + k * 1024); } while (0)
#define PG8_LDB(dst, b, h) do { _Pragma("unroll") for (int n = 0; n < 2; ++n) _Pragma("unroll") for (int k = 0; k < 2; ++k) dst[n][k] = *(const PG8_LAS bf16x8*)(lds + PG8_SB(b, h) + boff + n * 2048 + k * 1024); } while (0)
#define PG8_MMA(ai, bj, At, Bt) do { __builtin_amdgcn_s_setprio(1); _Pragma("unroll") for (int m = 0; m < 4; ++m) _Pragma("unroll") for (int n = 0; n < 2; ++n) _Pragma("unroll") for (int k = 0; k < 2; ++k) \
        acc[ai][bj][m][n] = __builtin_amdgcn_mfma_f32_16x16x32_bf16(Bt[n][k], At[m][k], acc[ai][bj][m][n], 0, 0, 0); __builtin_amdgcn_s_setprio(0); } while (0)
#define PG8_WAIT_V(n) asm volatile("s_waitcnt vmcnt(" #n ")" ::: "memory")
#define PG8_WAIT_L(n) asm volatile("s_waitcnt lgkmcnt(" #n ")" ::: "memory")
#define PG8_BAR __builtin_amdgcn_s_barrier()
#define PG8_SCHED __builtin_amdgcn_sched_barrier(0)
    Unit cur, nxt; int ui = 0;
    if (!S.next(0, cur)) return;
    f32x4 acc[2][2][4][2];
#pragma unroll
    for (int a = 0; a < 2; ++a)
#pragma unroll
        for (int b = 0; b < 2; ++b)
#pragma unroll
            for (int m = 0; m < 4; ++m)
#pragma unroll
                for (int n = 0; n < 2; ++n) acc[a][b][m][n] = (f32x4){0.f, 0.f, 0.f, 0.f};
    bf16x8 At[4][2], B0[2][2], B1[2][2];
    const char* cA = (const char*)g.A + (size_t)cur.pm * tstep; const char* cB = (const char*)g.Bt + (size_t)cur.pn * tstep;
    S.a_ready(cur);
    if constexpr (SP2) {
        PG8_STAGE(PG8_SB(0, 0), cB, voffB); PG8_STAGE(PG8_SB(0, 1), cB + hstep, voffB); PG8_STAGE(PG8_SA(0, 0), cA, voffA); PG8_STAGE(PG8_SA(0, 1), cA + hstep, voffA);
        if (wr == 1) PG8_BAR;
        PG8_WAIT_V(2); PG8_BAR;
        PG8_STAGE(PG8_SB(1, 0), cB + kstep, voffB); PG8_STAGE(PG8_SA(1, 0), cA + kstep, voffA); PG8_STAGE(PG8_SB(1, 1), cB + hstep + kstep, voffB);
        PG8_WAIT_V(6); PG8_BAR;
    } else {
        PG8_STAGE(PG8_SB(0, 0), cB, voffB); PG8_STAGE(PG8_SA(0, 0), cA, voffA); PG8_STAGE(PG8_SB(0, 1), cB + hstep, voffB); PG8_STAGE(PG8_SA(0, 1), cA + hstep, voffA);
        if (wr == 1) PG8_BAR;
        PG8_WAIT_V(4); PG8_BAR;
        PG8_STAGE(PG8_SB(1, 0), cB + kstep, voffB); PG8_STAGE(PG8_SA(1, 0), cA + kstep, voffA); PG8_STAGE(PG8_SB(1, 1), cB + hstep + kstep, voffB);
        PG8_WAIT_V(6); PG8_BAR;
    }
    for (;;) {
        const bool has_next = S.next(ui + 1, nxt);
        const char* nA = has_next ? (const char*)g.A + (size_t)nxt.pm * tstep : cA; const char* nB = has_next ? (const char*)g.Bt + (size_t)nxt.pn * tstep : cB;
        for (int t = 0; t < nt; t += 2) {
            const bool last = (t == nt - 2);
            const char* a1 = cA + (size_t)(t + 1) * kstep;
            const char* a2 = last ? nA : cA + (size_t)(t + 2) * kstep; const char* b2 = last ? nB : cB + (size_t)(t + 2) * kstep;
            const char* a3 = a2 + kstep; const char* b3 = b2 + kstep;
            if (last && has_next) S.a_ready(nxt);
            if constexpr (SP2) {
            PG8_LDB(B0, 0, 0); PG8_LDB(B1, 0, 1); PG8_SCHED; PG8_LDA(At, 0, 0); PG8_STAGE(PG8_SA(1, 1), a1 + hstep, voffA);
            PG8_WAIT_V(8); PG8_WAIT_L(0); PG8_BAR; PG8_MMA(0, 0, At, B0); PG8_MMA(0, 1, At, B1); PG8_BAR; PG8_SCHED;
            PG8_LDA(At, 0, 1); PG8_STAGE(PG8_SB(0, 0), b2, voffB); PG8_STAGE(PG8_SB(0, 1), b2 + hstep, voffB); PG8_STAGE(PG8_SA(0, 0), a2, voffA);
            PG8_WAIT_V(8); PG8_WAIT_L(0); PG8_BAR; PG8_MMA(1, 0, At, B0); PG8_MMA(1, 1, At, B1); PG8_BAR; PG8_SCHED;
            PG8_LDB(B0, 1, 0); PG8_LDB(B1, 1, 1); PG8_SCHED; PG8_LDA(At, 1, 0); PG8_STAGE(PG8_SA(0, 1), a2 + hstep, voffA);
            PG8_WAIT_V(8); PG8_WAIT_L(0); PG8_BAR; PG8_MMA(0, 0, At, B0); PG8_MMA(0, 1, At, B1); PG8_BAR; PG8_SCHED;
            PG8_LDA(At, 1, 1); PG8_STAGE(PG8_SB(1, 0), b3, voffB); PG8_STAGE(PG8_SB(1, 1), b3 + hstep, voffB); PG8_STAGE(PG8_SA(1, 0), a3, voffA);
            PG8_WAIT_V(8); PG8_WAIT_L(0); PG8_BAR; PG8_MMA(1, 0, At, B0); PG8_MMA(1, 1, At, B1); PG8_BAR; PG8_SCHED;
            } else {
            PG8_LDB(B0, 0, 0); PG8_SCHED; PG8_LDA(At, 0, 0); PG8_STAGE(PG8_SA(1, 1), a1 + hstep, voffA);
            PG8_WAIT_L(8); PG8_BAR; PG8_WAIT_L(0); PG8_MMA(0, 0, At, B0); PG8_BAR; PG8_SCHED;
            PG8_LDB(B1, 0, 1); PG8_STAGE(PG8_SB(0, 0), b2, voffB);
            PG8_BAR; PG8_WAIT_L(0); PG8_MMA(0, 1, At, B1); PG8_BAR;
            PG8_LDA(At, 0, 1); PG8_STAGE(PG8_SA(0, 0), a2, voffA);
            PG8_BAR; PG8_WAIT_L(0); PG8_MMA(1, 0, At, B0); PG8_BAR; PG8_SCHED;
            PG8_STAGE(PG8_SB(0, 1), b2 + hstep, voffB);
            PG8_WAIT_V(6); PG8_BAR; PG8_MMA(1, 1, At, B1); PG8_BAR;
            PG8_LDB(B0, 1, 0); PG8_SCHED; PG8_LDA(At, 1, 0); PG8_STAGE(PG8_SA(0, 1), a2 + hstep, voffA);
            PG8_WAIT_L(8); PG8_BAR; PG8_WAIT_L(0); PG8_MMA(0, 0, At, B0); PG8_BAR; PG8_SCHED;
            PG8_LDB(B1, 1, 1); PG8_STAGE(PG8_SB(1, 0), b3, voffB);
            PG8_BAR; PG8_WAIT_L(0); PG8_MMA(0, 1, At, B1); PG8_BAR;
            PG8_LDA(At, 1, 1); PG8_STAGE(PG8_SA(1, 0), a3, voffA);
            PG8_BAR; PG8_WAIT_L(0); PG8_MMA(1, 0, At, B0); PG8_BAR; PG8_SCHED;
            PG8_STAGE(PG8_SB(1, 1), b3 + hstep, voffB);
            PG8_WAIT_V(6); PG8_BAR; PG8_MMA(1, 1, At, B1); PG8_BAR;
            }
        }
        if constexpr (ALIGN_EPI) { if (wr == 0) PG8_BAR; }
        if constexpr (!Epi::AFTER_DRAIN) { E(acc, cur, wr, wc, fr, fq); S.done(cur); }
        if (!has_next) break;
#pragma unroll
        for (int a = 0; a < 2; ++a)
#pragma unroll
            for (int b = 0; b < 2; ++b)
#pragma unroll
                for (int m = 0; m < 4; ++m)
#pragma unroll
                    for (int n = 0; n < 2; ++n) acc[a][b][m][n] = (f32x4){0.f, 0.f, 0.f, 0.f};
        cur = nxt; cA = nA; cB = nB; ++ui;
        if constexpr (ALIGN_EPI) { if (wr == 1) PG8_BAR; }
    }
    PG8_WAIT_V(0);
    if constexpr (!ALIGN_EPI) { if (wr == 0) PG8_BAR; }
    PG8_BAR;
    if constexpr (Epi::AFTER_DRAIN) { E.fused(acc, cur, wr, wc, fr, fq, lds, wid, lane); S.done(cur); }
#undef PG8_SA
#undef PG8_SB
#undef PG8_STAGE
#undef PG8_LDA
#undef PG8_LDB
#undef PG8_MMA
#undef PG8_WAIT_V
#undef PG8_WAIT_L
#undef PG8_BAR
#undef PG8_SCHED
}
}
#define GAS __attribute__((address_space(1)))
#define LAS __attribute__((address_space(3)))
typedef unsigned short bf16;
typedef unsigned v4u __attribute__((ext_vector_type(4)));
typedef float f32x4 __attribute__((ext_vector_type(4)));
typedef short bf16x8 __attribute__((ext_vector_type(8)));
typedef GAS unsigned gu32;
typedef GAS unsigned long long gu64;
#define RLX_AGENT __ATOMIC_RELAXED, __HIP_MEMORY_SCOPE_AGENT
#define LDS_WAIT() asm volatile("s_waitcnt lgkmcnt(0)" ::: "memory")
#define VM_WAIT() asm volatile("s_waitcnt vmcnt(0)" ::: "memory")
__device__ __forceinline__ unsigned long long rt() { return __builtin_amdgcn_s_memrealtime(); }
#define XB_TMO      128
#define XB_XCNT(j)  (256  + 64 * (j))
#define XB_XSUB(j)  (1280 + 64 * (j))
#define XB_XGEN(j)  (2304 + 64 * (j))
#define XB_TOP      3328
#define XB_TOPGEN   3392
#define XCD_BAR_WORDS 3456
#define XB_SPIN_CAP (1u << 18)

__device__ __forceinline__ unsigned xb_ld(unsigned* p)              { return __hip_atomic_load(p, __ATOMIC_RELAXED, __HIP_MEMORY_SCOPE_AGENT); }
__device__ __forceinline__ unsigned xb_add(unsigned* p, unsigned v) { return __hip_atomic_fetch_add(p, v, __ATOMIC_RELAXED, __HIP_MEMORY_SCOPE_AGENT); }
__device__ __forceinline__ unsigned xb_xcc_id() { return (unsigned)__builtin_amdgcn_s_getreg((3 << 11) | 20) & 0xFu; }
#define XB_SPIN(cond, bar) do { unsigned _sp = 0; while (cond) { __builtin_amdgcn_s_sleep(1); \
    if ((++_sp & 255u) == 0u) { if (xb_ld(&(bar)[XB_TMO])) break; if (_sp > XB_SPIN_CAP) { atomicAdd(&(bar)[XB_TMO], 1u); break; } } } } while (0)

struct XcdBarrier {
    unsigned* bar; unsigned x;
    volatile LAS unsigned* st;
};

__device__ __forceinline__ XcdBarrier xcd_barrier_post(unsigned* bar, volatile LAS unsigned* st) {
    XcdBarrier b; b.bar = bar; b.x = xb_xcc_id(); b.st = st;
    if (threadIdx.x == 0) (void)xb_add(&bar[XB_XCNT(b.x)], 1u);
    return b;
}
__device__ __forceinline__ void xcd_barrier_complete(unsigned* bar, unsigned x, unsigned& nloc, unsigned& nx) {
    const unsigned G = gridDim.x * gridDim.y * gridDim.z;
    unsigned sum, cnt, mine, sp = 0u;
    for (;;) {
        sum = 0u; cnt = 0u; mine = 0u;
#pragma unroll
        for (unsigned j = 0; j < 16; ++j) { const unsigned c = xb_ld(&bar[XB_XCNT(j)]); sum += c; cnt += (c > 0u) ? 1u : 0u; mine = (j == x) ? c : mine; }
        if (sum == G) break;
        __builtin_amdgcn_s_sleep(1);
        if ((++sp & 255u) == 0u) { if (xb_ld(&bar[XB_TMO])) break; if (sp > XB_SPIN_CAP) { atomicAdd(&bar[XB_TMO], 1u); break; } }
    }
    nloc = mine > 0u ? mine : 1u; nx = cnt > 0u ? cnt : 1u;
}

__device__ __forceinline__ void xcd_barrier(const XcdBarrier& b) {
    asm volatile("s_waitcnt vmcnt(0)" ::: "memory");
    __syncthreads();
    if (threadIdx.x == 0) {
        unsigned* bar = b.bar;
        __builtin_amdgcn_s_waitcnt(0);
        unsigned nloc = b.st[0], nx = b.st[1];
        if (nloc == 0u) { xcd_barrier_complete(bar, b.x, nloc, nx); b.st[0] = nloc; b.st[1] = nx; }
        const unsigned old = xb_add(&bar[XB_XSUB(b.x)], 1u);
        const unsigned gen = old / nloc;
        if (old + 1u == (gen + 1u) * nloc) {
            __builtin_amdgcn_fence(__ATOMIC_RELEASE, "agent");
            asm volatile("s_waitcnt vmcnt(0)" ::: "memory");
            const unsigned og = xb_add(&bar[XB_TOP], 1u);
            const unsigned tg = og / nx;
            if (og + 1u == (tg + 1u) * nx) xb_add(&bar[XB_TOPGEN], 1u);
            else XB_SPIN(xb_ld(&bar[XB_TOPGEN]) == tg, bar);
            __builtin_amdgcn_fence(__ATOMIC_ACQUIRE, "agent");
            xb_add(&bar[XB_XGEN(b.x)], 1u);
            asm volatile("s_waitcnt vmcnt(0)" ::: "memory");
        } else {
            XB_SPIN(xb_ld(&bar[XB_XGEN(b.x)]) == gen, bar);
            __builtin_amdgcn_fence(__ATOMIC_ACQUIRE, "agent");
            asm volatile("s_waitcnt vmcnt(0)" ::: "memory");
        }
    }
    __syncthreads();
}
__device__ __forceinline__ int fresh_tid() { int t = threadIdx.x; asm volatile("" : "+v"(t)); return t; }

constexpr int NB = 8, S = 8192, M = NB * S, D = 1024, FF = 4096, NMEMT = 256;
constexpr int NDIFF = 2560, NDSA_L = 1736, NDSA = 1792;
constexpr float EPS = 1e-6f;
constexpr int NWAVES = 8, NTHR = 512;
constexpr float C2 = 0.125f * 1.4426950408889634f;
constexpr int DQ = 0, DK = 768, DV = 832, DIQ = 896, DIK = 1408, DIW = 1472, DQM = 1480;

typedef unsigned short bf16_t;
typedef unsigned u32x4 __attribute__((ext_vector_type(4)));
typedef float f32x4 __attribute__((ext_vector_type(4)));

constexpr size_t MiB = 1u << 20;
constexpr size_t WS_CTL = 0;
constexpr size_t WS_WIN0 = 1 * MiB, WS_WIN1 = 6 * MiB, WS_WOUT = 10 * MiB, WS_WUP = 14 * MiB, WS_WDN = 30 * MiB, WS_WKV = 46 * MiB;
constexpr size_t WS_MEMN = 48 * MiB, WS_MEMKV = 56 * MiB, WS_ROPE = 60 * MiB, WS_TOPK = 76 * MiB;
constexpr size_t WS_H = 108 * MiB, WS_PROJ = 236 * MiB, WS_O = 556 * MiB, WS_HID = 236 * MiB, WS_Y = 748 * MiB, WS_END = 1004 * MiB;

constexpr size_t P0_Q = 0, P0_K = (size_t)M * 768, P0_V = (size_t)M * 1536, P0_QM = (size_t)M * 2304;
constexpr size_t P1_Q = 0, P1_K = (size_t)M * 768, P1_V = (size_t)M * 832, P1_IK = (size_t)M * 896, P1_IQ = (size_t)M * 960, P1_QM = (size_t)M * 1472, P1_IW = (size_t)M * 1728;
constexpr float IW_SCALE = 0.04419417382415922f;
constexpr size_t MKV_K = 0, MKV_V = 524288, MKV_LAYER = 1048576;
__device__ __forceinline__ float bf2f(bf16_t v) { return __uint_as_float((unsigned)v << 16); }
__device__ __forceinline__ unsigned f2bf(float f) { unsigned u = __float_as_uint(f); return (u + 0x7fffu + ((u >> 16) & 1u)) >> 16; }
__device__ __forceinline__ unsigned pk2(float lo, float hi) { return f2bf(lo) | (f2bf(hi) << 16); }
__device__ __forceinline__ float wave_sum(float v) {
#pragma unroll
    for (int o = 1; o < 64; o <<= 1) v += __shfl_xor(v, o);
    return v;
}

template <int ACT> struct EpiB {
    static constexpr bool PERM = true, AFTER_DRAIN = false;
    bf16_t* O; int ldc;
    __device__ __forceinline__ void operator()(const pg8::f32x4 (&acc)[2][2][4][2], const pg8::Unit& u, int wr, int wc, int fr, int fq) const {
        const int row0 = u.pm * 256 + wr * 64 + fr, col0 = u.pn * 256 + wc * 32 + 8 * fq;
#pragma unroll
        for (int ai = 0; ai < 2; ++ai)
#pragma unroll
            for (int m = 0; m < 4; ++m) { bf16_t* rowp = O + (size_t)(row0 + ai * 128 + m * 16) * ldc + col0;
#pragma unroll
                for (int bj = 0; bj < 2; ++bj) { pg8::f32x4 v0 = acc[ai][bj][m][0], v1 = acc[ai][bj][m][1];
                    if (ACT == 2) {
#pragma unroll
                        for (int e = 0; e < 4; ++e) { float a = fmaxf(v0[e], 0.f); v0[e] = a * a; float b = fmaxf(v1[e], 0.f); v1[e] = b * b; } }
                    u32x4 w; w.x = pg8::cvt_pk_bf16(v0[0], v0[1]); w.y = pg8::cvt_pk_bf16(v0[2], v0[3]); w.z = pg8::cvt_pk_bf16(v1[0], v1[1]); w.w = pg8::cvt_pk_bf16(v1[2], v1[3]);
                    *(u32x4*)(rowp + bj * 128) = w; } }
    }
};
struct EpiF {
    static constexpr bool PERM = false, AFTER_DRAIN = false;
    float* C; int ldc;
    __device__ __forceinline__ void operator()(const pg8::f32x4 (&acc)[2][2][4][2], const pg8::Unit& u, int wr, int wc, int fr, int fq) const {
        const int row0 = u.pm * 256 + wr * 64 + fr, col0 = u.pn * 256 + wc * 32 + 4 * fq;
#pragma unroll
        for (int ai = 0; ai < 2; ++ai)
#pragma unroll
            for (int m = 0; m < 4; ++m) { float* rowp = C + (size_t)(row0 + ai * 128 + m * 16) * ldc + col0;
#pragma unroll
                for (int bj = 0; bj < 2; ++bj)
#pragma unroll
                    for (int n = 0; n < 2; ++n) *(pg8::f32x4*)(rowp + bj * 128 + n * 16) = acc[ai][bj][m][n]; }
    }
};


struct EpiProj0 {
    static constexpr bool PERM = true, AFTER_DRAIN = false;
    bf16_t* P; const float2* rope;
    __device__ __forceinline__ void operator()(const pg8::f32x4 (&acc)[2][2][4][2], const pg8::Unit& u, int wr, int wc, int fr, int fq) const {
        const int pn = u.pn;
        const int b = (u.pm * 256) / S;
        const int m0 = u.pm * 256 + wr * 64 + fr;
#pragma unroll
        for (int ai = 0; ai < 2; ++ai)
#pragma unroll
            for (int mm = 0; mm < 4; ++mm) {
                const int mrow = m0 + ai * 128 + mm * 16; const int s = mrow - b * S; const int t = s >> 6, r = s & 63;
                float x1[8], x2[8];
#pragma unroll
                for (int j = 0; j < 8; ++j) { x1[j] = acc[ai][0][mm][j >> 2][j & 3]; x2[j] = acc[ai][1][mm][j >> 2][j & 3]; }
                if (pn < 6) {
                    const pg8::f32x4* cs = (const pg8::f32x4*)(rope + (size_t)mrow * 32 + 8 * fq);
                    pg8::f32x4 cv[4];
#pragma unroll
                    for (int k = 0; k < 4; ++k) cv[k] = cs[k];
#pragma unroll
                    for (int j = 0; j < 8; ++j) { const float c = cv[j >> 1][(j & 1) * 2], sn = cv[j >> 1][(j & 1) * 2 + 1];
                        const float a = x1[j] * c - x2[j] * sn, bb = x2[j] * c + x1[j] * sn; x1[j] = a; x2[j] = bb; }
                }
                if (pn < 3 || pn == 9) {
#pragma unroll
                    for (int j = 0; j < 8; ++j) { x1[j] *= C2; x2[j] *= C2; }
                }
                u32x4 w1, w2;
                w1.x = pg8::cvt_pk_bf16(x1[0], x1[1]); w1.y = pg8::cvt_pk_bf16(x1[2], x1[3]); w1.z = pg8::cvt_pk_bf16(x1[4], x1[5]); w1.w = pg8::cvt_pk_bf16(x1[6], x1[7]);
                w2.x = pg8::cvt_pk_bf16(x2[0], x2[1]); w2.y = pg8::cvt_pk_bf16(x2[2], x2[3]); w2.z = pg8::cvt_pk_bf16(x2[4], x2[5]); w2.w = pg8::cvt_pk_bf16(x2[6], x2[7]);
                bf16_t *d1, *d2;
                if (pn < 3) { bf16_t* q = P + P0_Q + ((size_t)(b * 12 + 4 * pn + wc) * S + s) * 64 + 8 * fq; d1 = q; d2 = q + 32; }
                else if (pn < 6) { bf16_t* k = P + P0_K + ((((size_t)(b * 12 + 4 * (pn - 3) + wc) * 128 + t) * 8 + fq) * 512 + r * 8); d1 = k; d2 = k + 4 * 512; }
                else if (pn < 9) { const int hsv = 4 * (pn - 6) + wc; bf16_t* v = P + P0_V + (((((size_t)(b * 6 + (hsv >> 1)) * 128 + t) * 4 + 2 * (hsv & 1)) * 64 + r) * 32 + 8 * fq); d1 = v; d2 = v + 64 * 32; }
                else { bf16_t* q = P + P0_QM + ((size_t)(b * 4 + wc) * S + s) * 64 + 8 * fq; d1 = q; d2 = q + 32; }
                *(u32x4*)d1 = w1; *(u32x4*)d2 = w2;
            }
    }
};
__device__ __forceinline__ unsigned pk_f16(float lo, float hi) { typedef float f2 __attribute__((ext_vector_type(2))); typedef _Float16 h2 __attribute__((ext_vector_type(2))); const f2 v = {lo, hi}; return __builtin_bit_cast(unsigned, __builtin_convertvector(v, h2)); }
struct EpiProj1 {
    static constexpr bool PERM = true, AFTER_DRAIN = false;
    bf16_t* P; const float2* rope;
    __device__ __forceinline__ void operator()(const pg8::f32x4 (&acc)[2][2][4][2], const pg8::Unit& u, int wr, int wc, int fr, int fq) const {
        const int pn = u.pn;
        const int b = (u.pm * 256) / S;
        const int m0 = u.pm * 256 + wr * 64 + fr;
        const bool do_rope = (pn < 3) || (pn == 3 && (wc == 0 || wc == 2)) || pn == 4 || pn == 5;
        const bool f16out = (pn == 3 && wc == 2) || pn == 4 || pn == 5;
#pragma unroll
        for (int ai = 0; ai < 2; ++ai)
#pragma unroll
            for (int mm = 0; mm < 4; ++mm) {
                const int mrow = m0 + ai * 128 + mm * 16; const int s = mrow - b * S; const int t = s >> 6, r = s & 63;
                float x1[8], x2[8];
#pragma unroll
                for (int j = 0; j < 8; ++j) { x1[j] = acc[ai][0][mm][j >> 2][j & 3]; x2[j] = acc[ai][1][mm][j >> 2][j & 3]; }
                if (pn == 3 && wc == 3) {
                    if (fq == 0) { float* w = (float*)(P + P1_IW) + (size_t)mrow * 8;
                        *(pg8::f32x4*)w = (pg8::f32x4){x1[0] * IW_SCALE, x1[1] * IW_SCALE, x1[2] * IW_SCALE, x1[3] * IW_SCALE};
                        *(pg8::f32x4*)(w + 4) = (pg8::f32x4){x1[4] * IW_SCALE, x1[5] * IW_SCALE, x1[6] * IW_SCALE, x1[7] * IW_SCALE}; }
                    continue;
                }
                if (do_rope) {
                    const pg8::f32x4* cs = (const pg8::f32x4*)(rope + (size_t)mrow * 32 + 8 * fq);
                    pg8::f32x4 cv[4];
#pragma unroll
                    for (int k = 0; k < 4; ++k) cv[k] = cs[k];
#pragma unroll
                    for (int j = 0; j < 8; ++j) { const float c = cv[j >> 1][(j & 1) * 2], sn = cv[j >> 1][(j & 1) * 2 + 1];
                        const float a = x1[j] * c - x2[j] * sn, bb = x2[j] * c + x1[j] * sn; x1[j] = a; x2[j] = bb; }
                }
                if (pn < 3 || pn == 6) {
#pragma unroll
                    for (int j = 0; j < 8; ++j) { x1[j] *= C2; x2[j] *= C2; }
                }
                u32x4 w1, w2;
                if (f16out) {
                    w1.x = pk_f16(x1[0], x1[1]); w1.y = pk_f16(x1[2], x1[3]); w1.z = pk_f16(x1[4], x1[5]); w1.w = pk_f16(x1[6], x1[7]);
                    w2.x = pk_f16(x2[0], x2[1]); w2.y = pk_f16(x2[2], x2[3]); w2.z = pk_f16(x2[4], x2[5]); w2.w = pk_f16(x2[6], x2[7]);
                } else {
                    w1.x = pg8::cvt_pk_bf16(x1[0], x1[1]); w1.y = pg8::cvt_pk_bf16(x1[2], x1[3]); w1.z = pg8::cvt_pk_bf16(x1[4], x1[5]); w1.w = pg8::cvt_pk_bf16(x1[6], x1[7]);
                    w2.x = pg8::cvt_pk_bf16(x2[0], x2[1]); w2.y = pg8::cvt_pk_bf16(x2[2], x2[3]); w2.z = pg8::cvt_pk_bf16(x2[4], x2[5]); w2.w = pg8::cvt_pk_bf16(x2[6], x2[7]);
                }
                bf16_t *d1, *d2;
                if (pn < 3) { bf16_t* q = P + P1_Q + (size_t)mrow * 768 + (4 * pn + wc) * 64 + 8 * fq; d1 = q; d2 = q + 32; }
                else if (pn == 3) {
                    if (wc == 0) { bf16_t* k = P + P1_K + (size_t)mrow * 64 + 8 * fq; d1 = k; d2 = k + 32; }
                    else if (wc == 1) { bf16_t* v = P + P1_V + (size_t)mrow * 64 + 8 * fq; d1 = v; d2 = v + 32; }
                    else { bf16_t* k = P + P1_IK + ((((size_t)b * 128 + t) * 8 + fq) * 512 + r * 8); d1 = k; d2 = k + 4 * 512; }
                }
                else if (pn < 6) { bf16_t* q = P + P1_IQ + (size_t)mrow * 512 + (4 * (pn - 4) + wc) * 64 + 8 * fq; d1 = q; d2 = q + 32; }
                else { bf16_t* q = P + P1_QM + ((size_t)(b * 4 + wc) * S + s) * 64 + 8 * fq; d1 = q; d2 = q + 32; }
                *(u32x4*)d1 = w1; *(u32x4*)d2 = w2;
            }
    }
};
struct EpiMemKV {
    static constexpr bool PERM = true, AFTER_DRAIN = false;
    bf16_t* P;
    __device__ __forceinline__ void operator()(const pg8::f32x4 (&acc)[2][2][4][2], const pg8::Unit& u, int wr, int wc, int fr, int fq) const {
        const int b = u.pm;
#pragma unroll
        for (int ai = 0; ai < 2; ++ai)
#pragma unroll
            for (int mm = 0; mm < 4; ++mm) {
                const int mt = ai * 128 + wr * 64 + mm * 16 + fr; const int t = mt >> 6, r = mt & 63;
#pragma unroll
                for (int bj = 0; bj < 2; ++bj) {
                    const pg8::f32x4 v0 = acc[ai][bj][mm][0], v1 = acc[ai][bj][mm][1];
                    u32x4 w; w.x = pg8::cvt_pk_bf16(v0[0], v0[1]); w.y = pg8::cvt_pk_bf16(v0[2], v0[3]); w.z = pg8::cvt_pk_bf16(v1[0], v1[1]); w.w = pg8::cvt_pk_bf16(v1[2], v1[3]);
                    bf16_t* dst = (u.pn == 0) ? P + MKV_K + ((((size_t)(b * 4 + wc) * 4 + t) * 8 + 4 * bj + fq) * 512 + r * 8)
                                              : P + MKV_V + (((((size_t)(b * 4 + wc) * 4 + t) * 2 + bj) * 64 + r) * 32 + 8 * fq);
                    *(u32x4*)dst = w;
                }
            }
    }
};

#ifndef FA_DEBUG_SYNC
#define FA_DEBUG_SYNC 0
#endif
namespace fa {
typedef short bf16x8 __attribute__((ext_vector_type(8)));
typedef short s16x4 __attribute__((ext_vector_type(4)));
typedef float f32x16 __attribute__((ext_vector_type(16)));
typedef __attribute__((address_space(3))) const char* lds_cptr;
typedef short v4i16_t __attribute__((ext_vector_type(4)));
__device__ __forceinline__ int crow(int r, int hi) { return (r & 3) + 8 * (r >> 2) + 4 * hi; }
__device__ __forceinline__ void glds16(const void* gsrc, unsigned lds_dst) { unsigned keep;
    asm volatile("s_mov_b32 %0, m0\n\ts_mov_b32 m0, %2\n\ts_nop 0\n\tglobal_load_lds_dwordx4 %1, off\n\ts_mov_b32 m0, %0" : "=&s"(keep) : "v"(gsrc), "s"(lds_dst) : "memory"); }
typedef float f32x2_t __attribute__((ext_vector_type(2))); typedef __bf16 bf16x2_t __attribute__((ext_vector_type(2)));
__device__ __forceinline__ unsigned cvtpk(float lo, float hi) { const f32x2_t v = {lo, hi}; return __builtin_bit_cast(unsigned, __builtin_convertvector(v, bf16x2_t)); }
__device__ __forceinline__ s16x4 vtr(lds_cptr p) { return __builtin_bit_cast(s16x4, __builtin_amdgcn_ds_read_tr16_b64_v4i16((__attribute__((address_space(3))) v4i16_t*)p)); }
__device__ __forceinline__ float swapmax(float m) { auto rr = __builtin_amdgcn_permlane32_swap(__float_as_uint(m), __float_as_uint(m), false, false); return fmaxf(__uint_as_float(rr[0]), __uint_as_float(rr[1])); }
__device__ __forceinline__ float swapsum(float m) { auto rr = __builtin_amdgcn_permlane32_swap(__float_as_uint(m), __float_as_uint(m), false, false); return __uint_as_float(rr[0]) + __uint_as_float(rr[1]); }

template <int NBR, int DV> struct Cfg {
    static constexpr int NVB = DV / 32, VBYTES = 64 * DV * 2, STG = NBR * 8192 + VBYTES, PPW = STG / 8192, ROWS = 256 / NBR;
    static constexpr int EXCH_OFF = 65536;
};
struct Unit { const bf16_t* q0; const bf16_t* q1; const bf16_t* k0; const bf16_t* k1; const bf16_t* v; int qrow0; int nt; };

template <int NBR, int DV> __device__ __forceinline__ void tile_compute(lds_cptr stage, int br, const bf16x8 (&qr)[4], f32x16 (&o)[DV / 32], float& m, float& l, int r32, int hi, int lane) {
    typedef Cfg<NBR, DV> C;
    const lds_cptr kp = stage + br * 8192 + hi * 1024 + r32 * 16;
    f32x16 p0 = {}, p1 = {};
#pragma unroll
    for (int d0 = 0; d0 < 4; ++d0) {
        const bf16x8 k0 = *(const __attribute__((address_space(3))) bf16x8*)(kp + d0 * 2048);
        const bf16x8 k1 = *(const __attribute__((address_space(3))) bf16x8*)(kp + d0 * 2048 + 512);
        p0 = __builtin_amdgcn_mfma_f32_32x32x16_bf16(k0, qr[d0], p0, 0, 0, 0);
        p1 = __builtin_amdgcn_mfma_f32_32x32x16_bf16(k1, qr[d0], p1, 0, 0, 0);
    }
    __builtin_amdgcn_sched_barrier(0);
    float mx = fmaxf(p0[0], p1[0]);
#pragma unroll
    for (int r = 1; r < 16; ++r) mx = fmaxf(mx, fmaxf(p0[r], p1[r]));
    mx = swapmax(mx);
    const float mn = fmaxf(m, mx), alpha = __builtin_amdgcn_exp2f(m - mn); m = mn;
    float ls = 0.f;
#pragma unroll
    for (int r = 0; r < 16; ++r) { p0[r] = __builtin_amdgcn_exp2f(p0[r] - mn); p1[r] = __builtin_amdgcn_exp2f(p1[r] - mn); ls += p0[r] + p1[r]; }
    l = l * alpha + ls;
#pragma unroll
    for (int db = 0; db < C::NVB; ++db)
#pragma unroll
        for (int r = 0; r < 16; ++r) o[db][r] *= alpha;
    u32x4 pw[4];
#pragma unroll
    for (int i = 0; i < 4; ++i) { pw[0][i] = cvtpk(p0[2 * i], p0[2 * i + 1]); pw[1][i] = cvtpk(p0[8 + 2 * i], p0[9 + 2 * i]); pw[2][i] = cvtpk(p1[2 * i], p1[2 * i + 1]); pw[3][i] = cvtpk(p1[8 + 2 * i], p1[9 + 2 * i]); }
    const lds_cptr vp = stage + NBR * 8192 + ((lane >> 4) & 1) * 32 + (lane & 3) * 8 + (4 * hi + ((lane & 15) >> 2)) * 64;
#pragma unroll
    for (int db = 0; db < C::NVB; ++db) {
        __builtin_amdgcn_sched_barrier(0);
#pragma unroll
        for (int ks = 0; ks < 4; ++ks) {
            const s16x4 lo = vtr(vp + db * 4096 + ks * 1024), hh = vtr(vp + db * 4096 + ks * 1024 + 512);
            const bf16x8 vf = (bf16x8){lo[0], lo[1], lo[2], lo[3], hh[0], hh[1], hh[2], hh[3]};
            o[db] = __builtin_amdgcn_mfma_f32_32x32x16_bf16(vf, __builtin_bit_cast(bf16x8, pw[ks]), o[db], 0, 0, 0);
        }
    }
    __builtin_amdgcn_sched_barrier(0);
}

template <int NBR, int DV> __device__ __forceinline__ void attn_unit(const Unit& U, bool causal, bf16_t* out, int out_row0, int ocol, float lam, const float* gsub, float oscale, LAS unsigned char* lds_) {
    typedef Cfg<NBR, DV> C;
    const int tid = fresh_tid(), lane = tid & 63, r32 = lane & 31, hi = lane >> 5; const int wid = __builtin_amdgcn_readfirstlane(tid >> 6);
    const int br = (NBR == 2) ? (wid >> 2) : 0, rw = (NBR == 2) ? (wid & 3) : wid;
    const lds_cptr lds = (lds_cptr)lds_;
    const unsigned lds0 = (unsigned)(uintptr_t)lds_;
    const int myrow0 = U.qrow0 + 32 * rw;
    const int NT = U.nt, my_nt = causal ? ((myrow0 >> 6) + 1) : NT;
    const int pc0 = wid * C::PPW;
    const char* src; int srcstep;
    if (pc0 < 8 * NBR) { src = (const char*)((pc0 >> 3) ? U.k1 : U.k0) + (pc0 & 7) * 1024; srcstep = 8192; }
    else { src = (const char*)U.v + (pc0 - 8 * NBR) * 1024; srcstep = C::VBYTES; }
    src += lane * 16;
    const unsigned dst0 = lds0 + pc0 * 1024;
#if FA_DEBUG_SYNC == 2
#define FA_DMA(t, slot) do { _Pragma("unroll") for (int i_ = 0; i_ < C::PPW; ++i_) { const u32x4 v_ = *(const u32x4*)(src + (size_t)(t) * srcstep + i_ * 1024); \
        *(LAS u32x4*)(lds_ + pc0 * 1024 + (slot) * C::STG + i_ * 1024 + lane * 16) = v_; } } while (0)
#else
#define FA_DMA(t, slot) do { _Pragma("unroll") for (int i_ = 0; i_ < C::PPW; ++i_) glds16(src + (size_t)(t) * srcstep + i_ * 1024, (unsigned)__builtin_amdgcn_readfirstlane(dst0 + (slot) * C::STG + i_ * 1024)); } while (0)
#endif
    bf16x8 qr[4];
    { const bf16_t* qp = (br ? U.q1 : U.q0) + (size_t)(myrow0 + r32) * 64 + hi * 8;
#pragma unroll
      for (int d0 = 0; d0 < 4; ++d0) qr[d0] = *(const bf16x8*)(qp + d0 * 16); }
    FA_DMA(0, 0);
    if (NT > 1) FA_DMA(1, 1);
    f32x16 o[C::NVB];
#pragma unroll
    for (int db = 0; db < C::NVB; ++db) o[db] = (f32x16){};
    float m = -INFINITY, l = 0.f;
    int slot = 0, slot2 = 2;
#pragma unroll 1
    for (int t = 0; t < NT; ++t) {
#if FA_DEBUG_SYNC >= 1
        asm volatile("s_waitcnt vmcnt(0) lgkmcnt(0)\n\ts_barrier" ::: "memory");
        if (t + 2 < NT) FA_DMA(t + 2, slot2);
        asm volatile("s_waitcnt vmcnt(0) lgkmcnt(0)\n\ts_barrier" ::: "memory");
        if (t < my_nt) tile_compute<NBR, DV>(lds + slot * C::STG, br, qr, o, m, l, r32, hi, lane);
        asm volatile("s_waitcnt vmcnt(0) lgkmcnt(0)\n\ts_barrier" ::: "memory");
#else
        if (t + 1 < NT) { if (C::PPW == 4) asm volatile("s_waitcnt vmcnt(4) lgkmcnt(0)\n\ts_barrier" ::: "memory"); else asm volatile("s_waitcnt vmcnt(2) lgkmcnt(0)\n\ts_barrier" ::: "memory"); }
        else asm volatile("s_waitcnt vmcnt(0) lgkmcnt(0)\n\ts_barrier" ::: "memory");
        if (t + 2 < NT) FA_DMA(t + 2, slot2);
        if (t < my_nt) tile_compute<NBR, DV>(lds + slot * C::STG, br, qr, o, m, l, r32, hi, lane);
#endif
        slot = (slot == 2) ? 0 : slot + 1; slot2 = (slot2 == 2) ? 0 : slot2 + 1;
    }
#undef FA_DMA
    asm volatile("s_waitcnt vmcnt(0) lgkmcnt(0)\n\ts_barrier" ::: "memory");
    l = swapsum(l);
    if (NBR == 2) {
        LAS float* ex = (LAS float*)(lds_ + C::EXCH_OFF) + rw * 4096 + lane;
        if (br == 1) {
            const float f = lam / l;
#pragma unroll
            for (int db = 0; db < C::NVB; ++db)
#pragma unroll
                for (int r = 0; r < 16; ++r) ex[(db * 16 + r) * 64] = o[db][r] * f;
        }
        asm volatile("s_waitcnt lgkmcnt(0)\n\ts_barrier" ::: "memory");
        if (br == 0) {
            const float il = 1.f / l; float ss = 0.f;
#pragma unroll
            for (int db = 0; db < C::NVB; ++db)
#pragma unroll
                for (int r = 0; r < 16; ++r) { const float v = o[db][r] * il - ex[(db * 16 + r) * 64]; o[db][r] = v; ss += v * v; }
            ss = swapsum(ss);
            const float rstd = oscale / sqrtf(ss * (1.f / (float)DV) + EPS);
            bf16_t* orow = out + (size_t)(out_row0 + myrow0 + r32) * D + ocol + 4 * hi;
#pragma unroll
            for (int db = 0; db < C::NVB; ++db)
#pragma unroll
                for (int g = 0; g < 4; ++g) { const f32x4 gg = *(const f32x4*)(gsub + db * 32 + 8 * g + 4 * hi);
                    uint2 w; w.x = cvtpk(o[db][4 * g] * rstd * gg.x, o[db][4 * g + 1] * rstd * gg.y); w.y = cvtpk(o[db][4 * g + 2] * rstd * gg.z, o[db][4 * g + 3] * rstd * gg.w);
                    *(uint2*)(orow + db * 32 + 8 * g) = w; }
        }
    } else {
        const float il = 1.f / l;
        bf16_t* orow = out + (size_t)(out_row0 + myrow0 + r32) * D + ocol + 4 * hi;
#pragma unroll
        for (int db = 0; db < C::NVB; ++db)
#pragma unroll
            for (int g = 0; g < 4; ++g) { uint2 w; w.x = cvtpk(o[db][4 * g] * il, o[db][4 * g + 1] * il); w.y = cvtpk(o[db][4 * g + 2] * il, o[db][4 * g + 3] * il);
                *(uint2*)(orow + db * 32 + 8 * g) = w; }
    }
    asm volatile("s_waitcnt lgkmcnt(0)\n\ts_barrier" ::: "memory");
}
}

namespace ix {
typedef _Float16 f16x8 __attribute__((ext_vector_type(8)));
typedef float f32x16 __attribute__((ext_vector_type(16)));
constexpr int HROW = 513 * 4;
constexpr int L_HIST = 0, L_BMAP = 0, BROW = 1024;
constexpr int L_TB = 32 * HROW;
constexpr int L_SEGC = L_TB + 256;
constexpr int SEGCAP = 12;
constexpr int L_SEGK = L_SEGC + 32 * 16 * 4;
constexpr int L_SEGI = L_SEGK + 32 * 16 * SEGCAP * 4;
constexpr int L_FLAG = L_SEGI + 32 * 16 * SEGCAP * 2;
constexpr int L_END = L_FLAG + 128;
static_assert(L_END <= 131072, "indexer LDS map");
constexpr float BIN_SCALE = 32.0f, BIN_OFF = 256.0f;

__device__ __forceinline__ unsigned bin_of(float s) { const float t = __builtin_fmaf(s, BIN_SCALE, BIN_OFF); return (unsigned)(int)__builtin_amdgcn_fmed3f(t, 0.0f, 511.0f); }
__device__ __forceinline__ unsigned skey(unsigned bits) { return (bits & 0x80000000u) ? ~bits : (bits | 0x80000000u); }

__device__ __forceinline__ void topk_row_exact(int m, const bf16_t* __restrict__ proj, unsigned short* __restrict__ topk, LAS unsigned char* lds) {
    LAS unsigned* keys = (LAS unsigned*)lds;
    LAS float* iqs = (LAS float*)(lds + 32768);
    LAS float* ws = (LAS float*)(lds + 32768 + 2048);
    LAS unsigned* cnt_s = (LAS unsigned*)(lds + 32768 + 2048 + 64);
    LAS unsigned* scan_g = (LAS unsigned*)(lds + 36864);
    LAS unsigned* scan_e = (LAS unsigned*)(lds + 36864 + 2048);
    const int tid = fresh_tid();
    const int b = m / S, t = m % S; const int n = 64 * (t / 64 + 1);
    unsigned short* out = topk + (size_t)m * 256;
    __syncthreads();
    iqs[tid] = (float)((const _Float16*)(proj + P1_IQ))[(size_t)m * 512 + tid];
    if (tid < 8) ws[tid] = ((const float*)(proj + P1_IW))[(size_t)m * 8 + tid];
    __syncthreads();
    for (int j = tid; j < n; j += NTHR) {
        const _Float16* kp = (const _Float16*)(proj + P1_IK) + (((size_t)b * 128 + (j >> 6)) * 8) * 512 + (j & 63) * 8;
        float kf[64];
#pragma unroll
        for (int d = 0; d < 64; ++d) kf[d] = (float)kp[(d >> 3) * 512 + (d & 7)];
        float sc = 0.f;
#pragma unroll 1
        for (int hh = 0; hh < 8; ++hh) { float lg = 0.f;
#pragma unroll
            for (int d = 0; d < 64; ++d) lg += iqs[hh * 64 + d] * kf[d];
            sc += fmaxf(lg, 0.f) * ws[hh]; }
        sc += 0.0f;
        keys[j] = skey(__float_as_uint(sc));
    }
    __syncthreads();
    unsigned T = 0u;
    for (int bit = 31; bit >= 0; --bit) {
        const unsigned cand = T | (1u << bit);
        if (tid == 0) cnt_s[0] = 0u;
        __syncthreads();
        unsigned c0 = 0u;
        for (int j = tid; j < n; j += NTHR) c0 += (keys[j] >= cand) ? 1u : 0u;
        c0 = (unsigned)wave_sum((float)c0);
        if ((tid & 63) == 0) atomicAdd((unsigned*)cnt_s, c0);
        __syncthreads();
        if (cnt_s[0] >= 256u) T = cand;
        __syncthreads();
    }
    const int per = (n + NTHR - 1) / NTHR; const int j0 = tid * per, j1 = (j0 + per < n) ? j0 + per : n;
    unsigned g = 0u, e = 0u;
    for (int j = j0; j < j1; ++j) { const unsigned k = keys[j]; g += (k > T) ? 1u : 0u; e += (k == T) ? 1u : 0u; }
    scan_g[tid] = g; scan_e[tid] = e;
    __syncthreads();
    unsigned pg = 0u, pe = 0u, tg = 0u, te = 0u;
    for (int i = 0; i < NTHR; ++i) { const unsigned gi = scan_g[i], ei = scan_e[i]; if (i < tid) { pg += gi; pe += ei; } tg += gi; te += ei; }
    const unsigned R = 256u - tg;
    unsigned pos = pg + (pe < R ? pe : R), oe = pe;
    for (int j = j0; j < j1; ++j) { const unsigned k = keys[j];
        if (k > T) { out[pos] = (unsigned short)j; ++pos; }
        else if (k == T) { if (oe < R) { out[pos] = (unsigned short)j; ++pos; } ++oe; } }
    __syncthreads();
}

__device__ __forceinline__ void score_block(f32x16& s, const f16x8 (&kf)[4], const f16x8 (&iqf)[8][4], const f16x8 (&cf)[4], const float (&w)[8]) {
    s = (f32x16){};
#pragma unroll
    for (int d0 = 0; d0 < 4; ++d0) s = __builtin_amdgcn_mfma_f32_32x32x16_f16(kf[d0], cf[d0], s, 0, 0, 0);
#pragma unroll
    for (int h = 0; h < 8; ++h) {
        f32x16 L = (f32x16){};
#pragma unroll
        for (int d0 = 0; d0 < 4; ++d0) L = __builtin_amdgcn_mfma_f32_32x32x16_f16(kf[d0], iqf[h][d0], L, 0, 0, 0);
#pragma unroll
        for (int r = 0; r < 16; ++r) s[r] = __builtin_fmaf(__builtin_fabsf(L[r]), w[h], s[r]);
    }
}

__device__ __forceinline__ void topk_unit(int b, int j, const bf16_t* __restrict__ proj, unsigned short* __restrict__ topk, LAS unsigned char* lds, bool force_exact) {
    const int tid = fresh_tid(), lane = tid & 63, r32 = lane & 31, hi = lane >> 5; const int wid = __builtin_amdgcn_readfirstlane(tid >> 6);
    const int row0 = 32 * j, c = row0 >> 6, n = 64 * (c + 1), NT = c + 1;
    const size_t m0 = (size_t)b * S + row0;
    if (n <= 256) {
        for (int i = tid; i < 32 * 256; i += NTHR) { const int k = i & 255; topk[(m0 + (i >> 8)) * 256 + k] = (k < n) ? (unsigned short)k : (unsigned short)0xFFFFu; }
        return;
    }
    if (force_exact) { for (int r = 0; r < 32; ++r) topk_row_exact((int)m0 + r, proj, topk, lds); return; }
    for (int i = tid; i < (32 * HROW) / 4; i += NTHR) ((LAS unsigned*)(lds + L_HIST))[i] = 0u;
    if (tid < 32) ((LAS unsigned*)(lds + L_FLAG))[tid] = 0u;
    f16x8 iqf[8][4], cf[4]; float w[8];
    {
        const _Float16* iqp = (const _Float16*)(proj + P1_IQ) + (m0 + r32) * 512 + 8 * hi;
#pragma unroll
        for (int h = 0; h < 8; ++h)
#pragma unroll
            for (int d0 = 0; d0 < 4; ++d0) iqf[h][d0] = *(const f16x8*)(iqp + h * 64 + d0 * 16);
        const float* wp = (const float*)(proj + P1_IW) + (m0 + r32) * 8;
        const f32x4 w0 = *(const f32x4*)wp, w1 = *(const f32x4*)(wp + 4);
        w[0] = 0.5f * w0.x; w[1] = 0.5f * w0.y; w[2] = 0.5f * w0.z; w[3] = 0.5f * w0.w; w[4] = 0.5f * w1.x; w[5] = 0.5f * w1.y; w[6] = 0.5f * w1.z; w[7] = 0.5f * w1.w;
#pragma unroll
        for (int d0 = 0; d0 < 4; ++d0)
#pragma unroll
            for (int e = 0; e < 8; ++e) { float a = 0.f;
#pragma unroll
                for (int h = 0; h < 8; ++h) a = __builtin_fmaf(w[h], (float)iqf[h][d0][e], a);
                cf[d0][e] = (_Float16)a; }
    }
    const char* ikb = (const char*)((const _Float16*)(proj + P1_IK) + (size_t)b * S * 64) + hi * 1024 + r32 * 16;
    asm volatile("s_waitcnt lgkmcnt(0)\n\ts_barrier" ::: "memory");
    {
        LAS unsigned char* hrow = lds + L_HIST + r32 * HROW;
#pragma unroll 1
        for (int t = wid; t < NT; t += 8)
#pragma unroll 1
            for (int half = 0; half < 2; ++half) {
                f16x8 kf[4];
#pragma unroll
                for (int d0 = 0; d0 < 4; ++d0) kf[d0] = *(const f16x8*)(ikb + (size_t)t * 8192 + half * 512 + d0 * 2048);
                f32x16 s; score_block(s, kf, iqf, cf, w);
#pragma unroll
                for (int r = 0; r < 16; ++r) { const unsigned bn = bin_of(s[r]); __hip_atomic_fetch_add((LAS unsigned*)(hrow + bn * 4), 1u, __ATOMIC_RELAXED, __HIP_MEMORY_SCOPE_WORKGROUP); }
            }
    }
    asm volatile("s_waitcnt lgkmcnt(0)\n\ts_barrier" ::: "memory");
#pragma unroll 1
    for (int rr = 0; rr < 4; ++rr) {
        const int q = 4 * wid + rr;
        const LAS unsigned* hr = (const LAS unsigned*)(lds + L_HIST + q * HROW);
        unsigned cb[8]; unsigned tot = 0u;
#pragma unroll
        for (int i = 0; i < 8; ++i) { cb[i] = hr[511 - 8 * lane - i]; tot += cb[i]; }
        unsigned incl = tot;
#pragma unroll
        for (int o = 1; o < 64; o <<= 1) { const unsigned v = __shfl_up(incl, o); if (lane >= o) incl += v; }
        const unsigned excl = incl - tot;
        const unsigned long long bal = __ballot(incl >= 256u);
        const int L = __builtin_ctzll(bal);
        unsigned run = excl; int tbi = 0; unsigned above = 0u; bool found = false;
#pragma unroll
        for (int i = 0; i < 8; ++i) { if (!found) { if (run + cb[i] >= 256u) { found = true; tbi = 511 - 8 * lane - i; above = run; } else run += cb[i]; } }
        const unsigned tb = (unsigned)__shfl(tbi, L), ab = __shfl(above, L);
        if (lane == 0) { ((LAS unsigned*)(lds + L_TB))[2 * q] = tb; ((LAS unsigned*)(lds + L_TB))[2 * q + 1] = ab; }
    }
    asm volatile("s_waitcnt lgkmcnt(0)\n\ts_barrier" ::: "memory");
    for (int i = tid; i < (32 * BROW) / 4; i += NTHR) ((LAS unsigned*)(lds + L_BMAP))[i] = 0u;
    asm volatile("s_waitcnt lgkmcnt(0)\n\ts_barrier" ::: "memory");
    {
        const unsigned tb = ((const LAS unsigned*)(lds + L_TB))[2 * r32];
        LAS unsigned char* brow = lds + L_BMAP + r32 * BROW;
        const int sg = 2 * wid + hi;
        LAS unsigned* segk = (LAS unsigned*)(lds + L_SEGK) + (r32 * 16 + sg) * SEGCAP;
        LAS unsigned short* segi = (LAS unsigned short*)(lds + L_SEGI) + (r32 * 16 + sg) * SEGCAP;
        unsigned ccnt = 0u;
#pragma unroll 1
        for (int t = wid; t < NT; t += 8)
#pragma unroll 1
            for (int half = 0; half < 2; ++half) {
                f16x8 kf[4];
#pragma unroll
                for (int d0 = 0; d0 < 4; ++d0) kf[d0] = *(const f16x8*)(ikb + (size_t)t * 8192 + half * 512 + d0 * 2048);
                f32x16 s; score_block(s, kf, iqf, cf, w);
                unsigned gm = 0u, em = 0u;
#pragma unroll
                for (int r = 0; r < 16; ++r) { const unsigned bn = bin_of(s[r]); const unsigned bit = 1u << ((r & 3) + 8 * (r >> 2)); gm |= (bn > tb) ? bit : 0u; em |= (bn == tb) ? bit : 0u; }
                if (gm) __hip_atomic_fetch_or((LAS unsigned*)(brow + (2 * t + half) * 4), gm << (4 * hi), __ATOMIC_RELAXED, __HIP_MEMORY_SCOPE_WORKGROUP);
                if (__any(em != 0u)) {
                    const int kbase = 64 * t + 32 * half + 4 * hi;
#pragma unroll
                    for (int r = 0; r < 16; ++r) { if (em & (1u << ((r & 3) + 8 * (r >> 2)))) { if (ccnt < (unsigned)SEGCAP) { segk[ccnt] = __float_as_uint(s[r]); segi[ccnt] = (unsigned short)(kbase + (r & 3) + 8 * (r >> 2)); } ++ccnt; } }
                }
            }
        ((LAS unsigned*)(lds + L_SEGC))[r32 * 16 + sg] = ccnt;
    }
    asm volatile("s_waitcnt lgkmcnt(0)\n\ts_barrier" ::: "memory");
#pragma unroll 1
    for (int rr = 0; rr < 4; ++rr) {
        const int q = 4 * wid + rr;
        const unsigned cmy = (lane < 16) ? ((const LAS unsigned*)(lds + L_SEGC))[q * 16 + lane] : 0u;
        const bool over = __any(cmy > (unsigned)SEGCAP);
        const unsigned above = ((const LAS unsigned*)(lds + L_TB))[2 * q + 1];
        const unsigned R = 256u - above;
        LAS unsigned* bm = (LAS unsigned*)(lds + L_BMAP + q * BROW);
        if (over) { if (lane == 0) ((LAS unsigned*)(lds + L_FLAG))[q] = 1u; }
        else {
            const int sgm = lane >> 2; const unsigned csg = __shfl(cmy, sgm);
            const LAS unsigned* sk = (const LAS unsigned*)(lds + L_SEGK) + (q * 16) * SEGCAP;
            const LAS unsigned short* si = (const LAS unsigned short*)(lds + L_SEGI) + (q * 16) * SEGCAP;
            unsigned ky[3], ixx[3], rk[3]; bool vd[3];
#pragma unroll
            for (int k = 0; k < 3; ++k) { const unsigned e = (lane & 3) + 4 * k; vd[k] = e < csg; const unsigned ee = vd[k] ? e : 0u;
                ky[k] = skey(sk[sgm * SEGCAP + ee]); ixx[k] = si[sgm * SEGCAP + ee]; rk[k] = 0u; }
#pragma unroll 1
            for (int s2 = 0; s2 < 16; ++s2) {
                const int cs = __builtin_amdgcn_readlane((int)cmy, s2);
#pragma unroll 1
                for (int e = 0; e < cs; ++e) { const unsigned kj = skey(sk[s2 * SEGCAP + e]), ij = si[s2 * SEGCAP + e];
#pragma unroll
                    for (int k = 0; k < 3; ++k) rk[k] += ((kj > ky[k]) || (kj == ky[k] && ij < ixx[k])) ? 1u : 0u; }
            }
#pragma unroll
            for (int k = 0; k < 3; ++k) if (vd[k] && rk[k] < R) __hip_atomic_fetch_or(bm + (ixx[k] >> 5), 1u << (ixx[k] & 31), __ATOMIC_RELAXED, __HIP_MEMORY_SCOPE_WORKGROUP);
        }
        asm volatile("s_waitcnt lgkmcnt(0)" ::: "memory");
        const u32x4 wv = *(const LAS u32x4*)(bm + 4 * lane);
        unsigned wd[4] = {wv.x, wv.y, wv.z, wv.w};
        const unsigned pc = __builtin_popcount(wd[0]) + __builtin_popcount(wd[1]) + __builtin_popcount(wd[2]) + __builtin_popcount(wd[3]);
        unsigned incl = pc;
#pragma unroll
        for (int o = 1; o < 64; o <<= 1) { const unsigned v = __shfl_up(incl, o); if (lane >= o) incl += v; }
        unsigned pos = incl - pc;
        unsigned short* out = topk + (m0 + q) * 256;
        if (!over) {
#pragma unroll
            for (int i = 0; i < 4; ++i) { unsigned x = wd[i]; while (x) { const int bpos = __builtin_ctz(x); if (pos < 256u) out[pos] = (unsigned short)(128 * lane + 32 * i + bpos); ++pos; x &= x - 1u; } }
        }
    }
    asm volatile("s_waitcnt vmcnt(0) lgkmcnt(0)\n\ts_barrier" ::: "memory");
    {
        const bool anyf = __any(((const LAS unsigned*)(lds + L_FLAG))[lane & 31] != 0u);
        if (anyf) {
            __syncthreads();
#pragma unroll 1
            for (int r = 0; r < 32; ++r) { const unsigned f = ((const LAS unsigned*)(lds + L_FLAG))[r]; if (f) topk_row_exact((int)m0 + r, proj, topk, lds); }
        }
        __syncthreads();
    }
}

__device__ __forceinline__ void ph_topk(const bf16_t* proj, unsigned short* topk, LAS unsigned char* lds, bool force_exact) {
    const int G = (int)gridDim.x, bid = (int)blockIdx.x;
    if (G == 256) {
        const int b = bid & 7, idx = bid >> 3;
#pragma unroll 1
        for (int i = 0; i < 8; ++i) { const int j = (i & 1) ? 64 * (i >> 1) + 63 - idx : 64 * (i >> 1) + idx; topk_unit(b, j, proj, topk, lds, force_exact); }
    } else {
        for (int u = bid; u < NB * 256; u += G) topk_unit(u >> 8, u & 255, proj, topk, lds, force_exact);
    }
}
}

namespace sa {
typedef short bf16x8 __attribute__((ext_vector_type(8)));
typedef short s16x4 __attribute__((ext_vector_type(4)));
typedef short v4i16_t __attribute__((ext_vector_type(4)));
typedef unsigned u32x2 __attribute__((ext_vector_type(2)));
typedef __attribute__((address_space(3))) const char* lds_cptr;
constexpr int VROW = 144, WLDS = 512 + 64 * VROW;
static_assert(8 * WLDS <= 131072, "sparse attention LDS");
__device__ __forceinline__ s16x4 vtr(lds_cptr p) { return __builtin_bit_cast(s16x4, __builtin_amdgcn_ds_read_tr16_b64_v4i16((__attribute__((address_space(3))) v4i16_t*)p)); }
__device__ __forceinline__ unsigned pk(float lo, float hi) { typedef float f2 __attribute__((ext_vector_type(2))); typedef __bf16 b2 __attribute__((ext_vector_type(2))); const f2 v = {lo, hi}; return __builtin_bit_cast(unsigned, __builtin_convertvector(v, b2)); }
__device__ __forceinline__ float xmax(float v) { v = fmaxf(v, __shfl_xor(v, 16)); return fmaxf(v, __shfl_xor(v, 32)); }
__device__ __forceinline__ float xsum(float v) { v += __shfl_xor(v, 16); return v + __shfl_xor(v, 32); }

__device__ __forceinline__ void query(int m, int b, int nvalid, const bf16_t* __restrict__ P, const unsigned short* __restrict__ topk, bf16_t* __restrict__ O, LAS unsigned char* wl, int lane) {
    const int ks = lane & 15, kq = lane >> 4;
    LAS unsigned short* idxs = (LAS unsigned short*)wl; LAS unsigned char* vst = wl + 512;
    { u32x2 iv = *(const u32x2*)(topk + (size_t)m * 256 + 4 * lane);
      if ((iv.x & 0xFFFFu) == 0xFFFFu) iv.x &= 0xFFFF0000u; if ((iv.x >> 16) == 0xFFFFu) iv.x &= 0x0000FFFFu;
      if ((iv.y & 0xFFFFu) == 0xFFFFu) iv.y &= 0xFFFF0000u; if ((iv.y >> 16) == 0xFFFFu) iv.y &= 0x0000FFFFu;
      *(LAS u32x2*)(idxs + 4 * lane) = iv; }
    const bf16_t* qp = P + P1_Q + (size_t)m * 768 + (ks < 12 ? ks : 11) * 64 + 8 * kq;
    const bf16x8 q0 = *(const bf16x8*)qp, q1 = *(const bf16x8*)(qp + 32);
    const u32x4 ia = *(const LAS u32x4*)(idxs + 16 * ks), ib = *(const LAS u32x4*)(idxs + 16 * ks + 8);
    const unsigned iw[8] = {ia.x, ia.y, ia.z, ia.w, ib.x, ib.y, ib.z, ib.w};
    const bf16_t* Kb = P + P1_K + (size_t)b * S * 64 + 8 * kq;
    const bf16_t* Vb = P + P1_V + (size_t)b * S * 64 + 8 * (lane & 7);
    f32x4 Sx[16];
#pragma unroll
    for (int gb = 0; gb < 4; ++gb) {
        bf16x8 ka[4], kb[4];
#pragma unroll
        for (int gg = 0; gg < 4; ++gg) { const int g = 4 * gb + gg; const unsigned id = (g & 1) ? (iw[g >> 1] >> 16) : (iw[g >> 1] & 0xFFFFu);
            const bf16_t* kp = Kb + (size_t)id * 64; ka[gg] = *(const bf16x8*)kp; kb[gg] = *(const bf16x8*)(kp + 32); }
#pragma unroll
        for (int gg = 0; gg < 4; ++gg) { const int g = 4 * gb + gg;
            Sx[g] = __builtin_amdgcn_mfma_f32_16x16x32_bf16(ka[gg], q0, (f32x4){0.f, 0.f, 0.f, 0.f}, 0, 0, 0);
            Sx[g] = __builtin_amdgcn_mfma_f32_16x16x32_bf16(kb[gg], q1, Sx[g], 0, 0, 0); }
    }
    float mx = -INFINITY;
#pragma unroll
    for (int g = 0; g < 16; ++g)
#pragma unroll
        for (int r = 0; r < 4; ++r) { if (64 * kq + 16 * r + g >= nvalid) Sx[g][r] = -INFINITY; mx = fmaxf(mx, Sx[g][r]); }
    mx = xmax(mx);
    float sum = 0.f;
#pragma unroll
    for (int g = 0; g < 16; ++g)
#pragma unroll
        for (int r = 0; r < 4; ++r) { Sx[g][r] = __builtin_amdgcn_exp2f(Sx[g][r] - mx); sum += Sx[g][r]; }
    sum = xsum(sum);
    f32x4 o[4];
#pragma unroll
    for (int n = 0; n < 4; ++n) o[n] = (f32x4){0.f, 0.f, 0.f, 0.f};
    const lds_cptr vrd = (lds_cptr)vst + (4 * kq + ((lane & 15) >> 2)) * VROW + (lane & 3) * 8;
#pragma unroll
    for (int vb = 0; vb < 4; ++vb) {
        u32x4 vv[8];
#pragma unroll
        for (int i = 0; i < 8; ++i) { const int g = 4 * vb + (i >> 1); const unsigned id = idxs[16 * (8 * (i & 1) + (lane >> 3)) + g]; vv[i] = *(const u32x4*)(Vb + (size_t)id * 64); }
#pragma unroll
        for (int i = 0; i < 8; ++i) *(LAS u32x4*)(vst + (8 * i + (lane >> 3)) * VROW + (lane & 7) * 16) = vv[i];
#pragma unroll
        for (int Gl = 0; Gl < 2; ++Gl) {
            const int G2 = 2 * vb + Gl;
            u32x4 pw; pw.x = pk(Sx[2 * G2][0], Sx[2 * G2][1]); pw.y = pk(Sx[2 * G2][2], Sx[2 * G2][3]); pw.z = pk(Sx[2 * G2 + 1][0], Sx[2 * G2 + 1][1]); pw.w = pk(Sx[2 * G2 + 1][2], Sx[2 * G2 + 1][3]);
#pragma unroll
            for (int n = 0; n < 4; ++n) {
                const s16x4 lo = vtr(vrd + (32 * Gl) * VROW + n * 32), hh = vtr(vrd + (32 * Gl + 16) * VROW + n * 32);
                const bf16x8 vf = (bf16x8){lo[0], lo[1], lo[2], lo[3], hh[0], hh[1], hh[2], hh[3]};
                o[n] = __builtin_amdgcn_mfma_f32_16x16x32_bf16(vf, __builtin_bit_cast(bf16x8, pw), o[n], 0, 0, 0);
            }
        }
    }
    if (ks < 12) {
        const float il = 1.f / sum;
        bf16_t* op = O + (size_t)m * D + ks * 64 + 4 * kq;
#pragma unroll
        for (int n = 0; n < 4; ++n) { u32x2 w; w.x = pk(o[n][0] * il, o[n][1] * il); w.y = pk(o[n][2] * il, o[n][3] * il); *(u32x2*)(op + 16 * n) = w; }
    }
}

__device__ __forceinline__ void ph_dsa_attn(const bf16_t* P, const unsigned short* topk, bf16_t* O, LAS unsigned char* lds) {
    const int tid = fresh_tid(), lane = tid & 63; const int wid = __builtin_amdgcn_readfirstlane(tid >> 6);
    LAS unsigned char* wl = lds + wid * WLDS;
    const int G = (int)gridDim.x, bid = (int)blockIdx.x;
    if (G == 256) {
        const int b = bid & 7, w0 = (bid >> 3) * 8 + wid;
#pragma unroll 1
        for (int i = 0; i < 32; ++i) { const int t = w0 + 256 * i; const int nv = 64 * (t / 64 + 1); query(b * S + t, b, nv < 256 ? nv : 256, P, topk, O, wl, lane); }
    } else {
        for (int m = bid * NWAVES + wid; m < M; m += G * NWAVES) { const int t = m % S; const int nv = 64 * (t / 64 + 1); query(m, m / S, nv < 256 ? nv : 256, P, topk, O, wl, lane); }
    }
}
}

constexpr int RING_BYTES = 131072, LDSCTL_OFF = RING_BYTES, LDS_BYTES = 147456;
constexpr size_t CTL_ZERO_BYTES = 1 * MiB;
constexpr int CW_TMO = 0, CW_BAR = 4096;

struct Args { const void* in[19]; float* out; unsigned char* ws; };

#define FRESH_IDS const int tid = fresh_tid(), lane = tid & 63, wave = __builtin_amdgcn_readfirstlane(tid >> 6); (void)lane; (void)wave
#define GSTRIDE_WAVES(gw, NGW) const int gw = (int)blockIdx.x * NWAVES + wave, NGW = (int)gridDim.x * NWAVES

__device__ __forceinline__ int src_col(int p, int N, int mode) {
    if (mode == 0) return (p < N) ? p : -1;
    const int tile = p >> 8, wc = (p >> 5) & 3, d = 32 * ((p >> 7) & 1) + (p & 31);
    if (mode == 1) return tile * 256 + 64 * wc + d;
    if (tile < 3) return DQ + 64 * (4 * tile + wc) + d;
    if (tile == 3) return wc == 0 ? DK + d : wc == 1 ? DV + d : wc == 2 ? DIK + d : (d < 8 ? DIW + d : -1);
    if (tile < 6) return DIQ + 64 * (4 * (tile - 4) + wc) + d;
    return DQM + 64 * wc + d;
}
__device__ __forceinline__ void prep_item(const float* __restrict__ W, int K, int N, bf16_t* __restrict__ Wt, int Nout, int mode, LAS float* scr, int item, int lane) {
    const int nblk = Nout / 32, kb = item / nblk, nb = item % nblk, k0 = 64 * kb, p0 = 32 * nb;
    const int p = src_col(p0 + (lane & 31), N, mode);
#pragma unroll 8
    for (int i = 0; i < 32; ++i) { const int kk = 2 * i + (lane >> 5); scr[kk * 33 + (lane & 31)] = (p >= 0) ? W[(size_t)(k0 + kk) * N + p] : 0.f; }
    LDS_WAIT(); asm volatile("" ::: "memory");
    const int c = lane & 7;
#pragma unroll
    for (int j = 0; j < 4; ++j) { const int n = (lane >> 3) + 8 * j; const LAS float* s = scr + (8 * c) * 33 + n;
        u32x4 o; o.x = pk2(s[0 * 33], s[1 * 33]); o.y = pk2(s[2 * 33], s[3 * 33]); o.z = pk2(s[4 * 33], s[5 * 33]); o.w = pk2(s[6 * 33], s[7 * 33]);
        *(u32x4*)(Wt + (size_t)(p0 + n) * K + k0 + 8 * c) = o; }
    LDS_WAIT(); asm volatile("" ::: "memory");
}
__device__ __forceinline__ void prep_matrix(const float* W, int K, int N, bf16_t* Wt, int Nout, int mode, LAS float* scr, int gw, int NGW, int lane) {
    const int nitems = (K / 64) * (Nout / 32);
    for (int it = gw; it < nitems; it += NGW) prep_item(W, K, N, Wt, Nout, mode, scr, it, lane);
}
__device__ __forceinline__ void rms_row_bf16(const float* xrow, const float* g, bf16_t* orow, int lane) {
    const f32x4* xr = (const f32x4*)xrow + lane; const f32x4* gr = (const f32x4*)g + lane;
    f32x4 v[4]; float s = 0.f;
#pragma unroll
    for (int j = 0; j < 4; ++j) { v[j] = xr[64 * j]; s += (v[j].x * v[j].x + v[j].y * v[j].y) + (v[j].z * v[j].z + v[j].w * v[j].w); }
    const float rstd = 1.f / sqrtf(wave_sum(s) * (1.f / D) + EPS);
    unsigned long long* o8 = (unsigned long long*)orow + lane;
#pragma unroll
    for (int j = 0; j < 4; ++j) { const f32x4 gg = gr[64 * j];
        o8[64 * j] = (unsigned long long)pk2(v[j].x * rstd * gg.x, v[j].y * rstd * gg.y) | ((unsigned long long)pk2(v[j].z * rstd * gg.z, v[j].w * rstd * gg.w) << 32); }
}
__device__ __forceinline__ void norm_res_row(const float* yrow, const float* xin, const float* g1, float* xout, const float* g2, bf16_t* hrow, int lane) {
    const f32x4* yr = (const f32x4*)yrow + lane; const f32x4* xr = (const f32x4*)xin + lane;
    f32x4 v[4], xv[4]; float s = 0.f;
#pragma unroll
    for (int j = 0; j < 4; ++j) { v[j] = yr[64 * j]; xv[j] = xr[64 * j]; s += (v[j].x * v[j].x + v[j].y * v[j].y) + (v[j].z * v[j].z + v[j].w * v[j].w); }
    const float rstd = 1.f / sqrtf(wave_sum(s) * (1.f / D) + EPS);
    float s2 = 0.f;
#pragma unroll
    for (int j = 0; j < 4; ++j) { const f32x4 gg = ((const f32x4*)g1 + lane)[64 * j]; xv[j] = xv[j] + v[j] * rstd * gg;
        s2 += (xv[j].x * xv[j].x + xv[j].y * xv[j].y) + (xv[j].z * xv[j].z + xv[j].w * xv[j].w);
        ((f32x4*)xout + lane)[64 * j] = xv[j]; }
    if (g2) {
        const float r2 = 1.f / sqrtf(wave_sum(s2) * (1.f / D) + EPS);
        unsigned long long* o8 = (unsigned long long*)hrow + lane;
#pragma unroll
        for (int j = 0; j < 4; ++j) { const f32x4 gg = ((const f32x4*)g2 + lane)[64 * j];
            o8[64 * j] = (unsigned long long)pk2(xv[j].x * r2 * gg.x, xv[j].y * r2 * gg.y) | ((unsigned long long)pk2(xv[j].z * r2 * gg.z, xv[j].w * r2 * gg.w) << 32); }
    }
}
__device__ __forceinline__ void ph_norm_res(const float* Y, const float* xin, const float* g1, float* xout, const float* g2, bf16_t* H, int wave, int lane) {
    GSTRIDE_WAVES(gw, NGW);
    for (int m = gw; m < M; m += NGW) norm_res_row(Y + (size_t)m * D, xin + (size_t)m * D, g1, xout + (size_t)m * D, g2, H + (size_t)m * D, lane);
}
__device__ __forceinline__ void ph_rope(bf16_t* buf, int ld, const float2* __restrict__ tab, int mode, int nheads) {
    const size_t tot = (size_t)M * nheads * 32;
    const int tid_r = fresh_tid();
    for (size_t idx = (size_t)blockIdx.x * NTHR + tid_r; idx < tot; idx += (size_t)gridDim.x * NTHR) {
        const int i = (int)(idx & 31); const size_t r = idx >> 5; const int hs = (int)(r % nheads); const size_t m = r / nheads;
        int col0;
        if (mode == 0) col0 = 64 * hs; else col0 = (hs < 12) ? 64 * hs : (hs == 12) ? DK : (hs < 21) ? DIQ + 64 * (hs - 13) : DIK;
        bf16_t* p = buf + m * ld + col0 + i; const float2 cs = tab[m * 32 + i];
        const float x1 = bf2f(p[0]), x2 = bf2f(p[32]);
        p[0] = (bf16_t)f2bf(x1 * cs.x - x2 * cs.y); p[32] = (bf16_t)f2bf(x2 * cs.x + x1 * cs.y);
    }
}

__device__ __forceinline__ void ph_attn_diff_naive(const bf16_t* __restrict__ proj, bf16_t* __restrict__ o, const float* __restrict__ lq1, const float* __restrict__ lk1,
                                                   const float* __restrict__ lq2, const float* __restrict__ lk2, const float* __restrict__ gsub) {
    float a1 = 0.f, a2 = 0.f;
    for (int i = 0; i < 64; ++i) { a1 += lq1[i] * lk1[i]; a2 += lq2[i] * lk2[i]; }
    const float lam = expf(a1) - expf(a2) + 0.2f;
    const int tidx = fresh_tid();
    const int half = __builtin_amdgcn_readfirstlane(tidx >> 8), tid = tidx & 255;
    const int NU = NB * 6 * (S / 64);
    for (int u = (int)blockIdx.x * 2 + half; u < NU; u += (int)gridDim.x * 2) {
        const int c = (S / 64 - 1) - (u / (NB * 6)), bh = u % (NB * 6), h = bh % 6, b = bh / 6;
        const int t = c * 64 + (tid >> 2), dq = tid & 3;
        const int nk = 64 * (c + 1);
        float res[32];
#pragma unroll
        for (int br = 0; br < 2; ++br) {
            float q[64];
            const int hs = 2 * h + br;
            const bf16_t* qp = proj + P0_Q + ((size_t)(b * 12 + hs) * S + t) * 64;
#pragma unroll
            for (int d = 0; d < 64; ++d) q[d] = bf2f(qp[d]);
            float acc[32];
#pragma unroll
            for (int i = 0; i < 32; ++i) acc[i] = 0.f;
            float mx = -INFINITY, l = 0.f;
            for (int j = 0; j < nk; ++j) {
                const bf16_t* kp = proj + P0_K + (((size_t)(b * 12 + hs) * 128 + (j >> 6)) * 8) * 512 + (j & 63) * 8;
                const bf16_t* vp = proj + P0_V + (((((size_t)(b * 6 + h) * 128 + (j >> 6)) * 4 + dq) * 64 + (j & 63)) * 32);
                float s = 0.f;
#pragma unroll
                for (int d = 0; d < 64; ++d) s += q[d] * bf2f(kp[(d >> 3) * 512 + (d & 7)]);
                const float mn = fmaxf(mx, s); const float f = exp2f(mx - mn), p = exp2f(s - mn);
                l = l * f + p; mx = mn;
#pragma unroll
                for (int i = 0; i < 32; ++i) acc[i] = acc[i] * f + p * bf2f(vp[i]);
            }
            const float il = 1.f / l;
            if (br == 0) {
#pragma unroll
                for (int i = 0; i < 32; ++i) res[i] = acc[i] * il;
            } else {
#pragma unroll
                for (int i = 0; i < 32; ++i) res[i] -= lam * acc[i] * il;
            }
        }
        float ss = 0.f;
#pragma unroll
        for (int i = 0; i < 32; ++i) ss += res[i] * res[i];
        ss += __shfl_xor(ss, 1); ss += __shfl_xor(ss, 2);
        const float rstd = 1.f / sqrtf(ss * (1.f / 128.f) + EPS);
        bf16_t* op = o + (size_t)(b * S + t) * D + h * 128 + dq * 32;
#pragma unroll
        for (int i = 0; i < 32; ++i) op[i] = (bf16_t)f2bf(res[i] * rstd * gsub[dq * 32 + i] * 0.8f);
    }
}
__device__ __forceinline__ void ph_attn_mem_naive(const bf16_t* __restrict__ qbuf, int qmode, int ld, int qcol0, const bf16_t* __restrict__ kv, bf16_t* __restrict__ o) {
    const int tidx = fresh_tid();
    const int half = __builtin_amdgcn_readfirstlane(tidx >> 8), tid = tidx & 255;
    const int NU = NB * 4 * (S / 64);
    for (int u = (int)blockIdx.x * 2 + half; u < NU; u += (int)gridDim.x * 2) {
        const int c = u % (S / 64), h = (u / (S / 64)) % 4, b = u / ((S / 64) * 4);
        const int t = c * 64 + (tid >> 2), dq = tid & 3;
        float q[64];
        const bf16_t* qp = qmode ? qbuf + ((size_t)(b * 4 + h) * S + t) * 64 : qbuf + (size_t)(b * S + t) * ld + qcol0 + h * 64;
        const float qs = qmode ? 1.f : C2;
#pragma unroll
        for (int d = 0; d < 64; ++d) q[d] = bf2f(qp[d]) * qs;
        float acc[16];
#pragma unroll
        for (int i = 0; i < 16; ++i) acc[i] = 0.f;
        float mx = -INFINITY, l = 0.f;
        for (int j = 0; j < NMEMT; ++j) {
            const bf16_t* kp = kv + MKV_K + (((size_t)(b * 4 + h) * 4 + (j >> 6)) * 8) * 512 + (j & 63) * 8;
            const bf16_t* vp = kv + MKV_V + (((((size_t)(b * 4 + h) * 4 + (j >> 6)) * 2 + (dq >> 1)) * 64 + (j & 63)) * 32) + (dq & 1) * 16;
            float s = 0.f;
#pragma unroll
            for (int d = 0; d < 64; ++d) s += q[d] * bf2f(kp[(d >> 3) * 512 + (d & 7)]);
            const float mn = fmaxf(mx, s); const float f = exp2f(mx - mn), p = exp2f(s - mn);
            l = l * f + p; mx = mn;
#pragma unroll
            for (int i = 0; i < 16; ++i) acc[i] = acc[i] * f + p * bf2f(vp[i]);
        }
        const float il = 1.f / l;
        bf16_t* op = o + (size_t)(b * S + t) * D + 768 + h * 64 + dq * 16;
#pragma unroll
        for (int i = 0; i < 16; ++i) op[i] = (bf16_t)f2bf(acc[i] * il);
    }
}
__device__ __forceinline__ unsigned f2key(float f) { const unsigned u = __float_as_uint(f); return (u & 0x80000000u) ? ~u : (u | 0x80000000u); }
__device__ __forceinline__ void ph_topk_naive(const bf16_t* __restrict__ proj, unsigned short* __restrict__ topk, LAS unsigned char* lds) {
    LAS unsigned* keys = (LAS unsigned*)lds;
    LAS float* iqs = (LAS float*)(lds + 32768);
    LAS float* ws = (LAS float*)(lds + 32768 + 2048);
    LAS unsigned* cnt_s = (LAS unsigned*)(lds + 32768 + 2048 + 64);
    LAS unsigned* scan_g = (LAS unsigned*)(lds + 36864);
    LAS unsigned* scan_e = (LAS unsigned*)(lds + 36864 + 2048);
    const int tid = fresh_tid();
    for (int m = blockIdx.x; m < M; m += gridDim.x) {
        const int b = m / S, t = m % S; const int c = t / 64; const int n = 64 * (c + 1);
        unsigned short* out = topk + (size_t)m * 256;
        if (n <= 256) { if (tid < 256) out[tid] = (tid < n) ? (unsigned short)tid : (unsigned short)0xFFFFu; continue; }
        __syncthreads();
        iqs[tid] = (float)((const _Float16*)(proj + P1_IQ))[(size_t)m * 512 + tid];
        if (tid < 8) ws[tid] = ((const float*)(proj + P1_IW))[(size_t)m * 8 + tid];
        __syncthreads();
        for (int j = tid; j < n; j += NTHR) {
            const _Float16* kp = (const _Float16*)(proj + P1_IK) + (((size_t)b * 128 + (j >> 6)) * 8) * 512 + (j & 63) * 8;
            float kf[64];
#pragma unroll
            for (int d = 0; d < 64; ++d) kf[d] = (float)kp[(d >> 3) * 512 + (d & 7)];
            float sc = 0.f;
#pragma unroll 1
            for (int hh = 0; hh < 8; ++hh) { float lg = 0.f;
#pragma unroll
                for (int d = 0; d < 64; ++d) lg += iqs[hh * 64 + d] * kf[d];
                sc += fmaxf(lg, 0.f) * ws[hh]; }
            sc += 0.0f;
            keys[j] = f2key(sc);
        }
        __syncthreads();
        unsigned T = 0u;
        for (int bit = 31; bit >= 0; --bit) {
            const unsigned cand = T | (1u << bit);
            if (tid == 0) cnt_s[0] = 0u;
            __syncthreads();
            unsigned c0 = 0u;
            for (int j = tid; j < n; j += NTHR) c0 += (keys[j] >= cand) ? 1u : 0u;
            c0 = (unsigned)wave_sum((float)c0);
            if ((tid & 63) == 0) atomicAdd((unsigned*)cnt_s, c0);
            __syncthreads();
            if (cnt_s[0] >= 256u) T = cand;
            __syncthreads();
        }
        const int per = (n + NTHR - 1) / NTHR; const int j0 = tid * per, j1 = (j0 + per < n) ? j0 + per : n;
        unsigned g = 0u, e = 0u;
        for (int j = j0; j < j1; ++j) { const unsigned k = keys[j]; g += (k > T) ? 1u : 0u; e += (k == T) ? 1u : 0u; }
        scan_g[tid] = g; scan_e[tid] = e;
        __syncthreads();
        unsigned pg = 0u, pe = 0u, tg = 0u;
        for (int i = 0; i < NTHR; ++i) { const unsigned gi = scan_g[i], ei = scan_e[i]; if (i < tid) { pg += gi; pe += ei; } tg += gi; }
        const unsigned R = 256u - tg;
        unsigned og = pg, oe = pe;
        for (int j = j0; j < j1; ++j) { const unsigned k = keys[j];
            if (k > T) { out[og] = (unsigned short)j; ++og; }
            else if (k == T) { if (oe < R) out[tg + oe] = (unsigned short)j; ++oe; } }
    }
}
__device__ __forceinline__ void ph_dsa_attn_naive(const bf16_t* __restrict__ proj, const unsigned short* __restrict__ topk, bf16_t* __restrict__ o, int wave, int lane) {
    GSTRIDE_WAVES(gw, NGW);
    const int hd = (lane < 48) ? (lane >> 2) : 0, dq = lane & 3;
    for (int m = gw; m < M; m += NGW) {
        const int b = m / S;
        const bf16_t* row = proj + P1_Q + (size_t)m * 768;
        float q[64];
#pragma unroll
        for (int d = 0; d < 64; ++d) q[d] = bf2f(row[hd * 64 + d]);
        float acc[16];
#pragma unroll
        for (int i = 0; i < 16; ++i) acc[i] = 0.f;
        float mx = -INFINITY, l = 0.f;
        const unsigned short* ix = topk + (size_t)m * 256;
        for (int jj = 0; jj < 256; ++jj) {
            const unsigned j = ix[jj]; if (j == 0xFFFFu) continue;
            const bf16_t* kp = proj + P1_K + (size_t)(b * S + j) * 64;
            const bf16_t* vp = proj + P1_V + (size_t)(b * S + j) * 64 + dq * 16;
            float s = 0.f;
#pragma unroll
            for (int d = 0; d < 64; ++d) s += q[d] * bf2f(kp[d]);
            const float mn = fmaxf(mx, s); const float f = exp2f(mx - mn), p = exp2f(s - mn);
            l = l * f + p; mx = mn;
#pragma unroll
            for (int i = 0; i < 16; ++i) acc[i] = acc[i] * f + p * bf2f(vp[i]);
        }
        if (lane < 48) {
            const float il = 1.f / l;
            bf16_t* op = o + (size_t)m * D + hd * 64 + dq * 16;
#pragma unroll
            for (int i = 0; i < 16; ++i) op[i] = (bf16_t)f2bf(acc[i] * il);
        }
    }
}

__device__ __forceinline__ void ph_attn_diff(const bf16_t* P, bf16_t* O, const float* lq1, const float* lk1, const float* lq2, const float* lk2, const float* gsub, LAS unsigned char* lds) {
    float a1 = 0.f, a2 = 0.f;
    for (int i = 0; i < 64; ++i) { a1 += lq1[i] * lk1[i]; a2 += lq2[i] * lk2[i]; }
    const float lam = expf(a1) - expf(a2) + 0.2f;
    const int G = (int)gridDim.x, bid = (int)blockIdx.x; const int vcu = (G % 8 == 0) ? (bid % 8) * (G / 8) + bid / 8 : bid;
    for (int i = 0; ; ++i) {
        const int pu = vcu + (i >> 1) * G; if (pu >= NB * 6 * 32) break;
        const int bh = pu >> 5, pair = pu & 31, b = bh / 6, h = bh % 6; const int qblk = (i & 1) ? pair : 63 - pair;
        fa::Unit U;
        U.q0 = P + P0_Q + (size_t)(b * 12 + 2 * h) * S * 64; U.q1 = U.q0 + (size_t)S * 64;
        U.k0 = P + P0_K + (size_t)(b * 12 + 2 * h) * S * 64; U.k1 = U.k0 + (size_t)S * 64;
        U.v = P + P0_V + (size_t)(b * 6 + h) * S * 128; U.qrow0 = qblk * 128; U.nt = 2 * qblk + 2;
        fa::attn_unit<2, 128>(U, true, O, b * S, h * 128, lam, gsub, 0.8f, lds);
    }
}
__device__ __forceinline__ void ph_attn_mem(const bf16_t* QM, const bf16_t* kv, bf16_t* O, LAS unsigned char* lds) {
    for (int u = (int)blockIdx.x; u < NB * 4 * (S / 256); u += (int)gridDim.x) {
        const int b = u >> 7, mh = (u >> 5) & 3, qb = u & 31;
        fa::Unit U;
        U.q0 = QM + (size_t)(b * 4 + mh) * S * 64; U.q1 = U.q0;
        U.k0 = kv + MKV_K + (size_t)(b * 4 + mh) * NMEMT * 64; U.k1 = U.k0;
        U.v = kv + MKV_V + (size_t)(b * 4 + mh) * NMEMT * 64; U.qrow0 = qb * 256; U.nt = 4;
        fa::attn_unit<1, 64>(U, false, O, b * S, 768 + mh * 64, 0.f, nullptr, 1.f, lds);
    }
}

#ifndef IX_FORCE_EXACT
#define IX_FORCE_EXACT 0
#endif
#define GEMM_PHASE(EPI, Aptr, Bptr, Mr, Nn, Kk, ...) do { pg8::Gemm g_{(Aptr), (Bptr), (Mr), (Nn), (Kk)}; pg8::StaticOrder S_; S_.init((Mr), (Nn), (int)gridDim.x, (int)blockIdx.x); \
    EPI E_{__VA_ARGS__}; pg8::gemm_phase<EPI, pg8::StaticOrder, true, true>(lds, g_, S_, E_); } while (0)

__global__ void __launch_bounds__(NTHR, 2) mk_fwd(Args args) {
    extern __shared__ __attribute__((aligned(16))) unsigned char lds_raw[];
    LAS unsigned char* lds = (LAS unsigned char*)lds_raw;
    unsigned char* ws = args.ws; float* out = args.out;
    const float* x = (const float*)args.in[0]; const float* mem = (const float*)args.in[1]; const int* pos = (const int*)args.in[2];
    const float* g_pre_mix = (const float*)args.in[3]; const float* g_post_mix = (const float*)args.in[4]; const float* g_mem = (const float*)args.in[5];
    const float* w_mem_kv = (const float*)args.in[6]; const float* w_out = (const float*)args.in[7]; const float* g_pre_mlp = (const float*)args.in[8];
    const float* g_post_mlp = (const float*)args.in[9]; const float* w_up = (const float*)args.in[10]; const float* w_dn = (const float*)args.in[11];
    const float* w_in_diff = (const float*)args.in[12]; const float* lq1 = (const float*)args.in[13]; const float* lk1 = (const float*)args.in[14];
    const float* lq2 = (const float*)args.in[15]; const float* lk2 = (const float*)args.in[16]; const float* gsub = (const float*)args.in[17]; const float* w_in_dsa = (const float*)args.in[18];
    bf16_t* Win0 = (bf16_t*)(ws + WS_WIN0); bf16_t* Win1 = (bf16_t*)(ws + WS_WIN1); bf16_t* Wout = (bf16_t*)(ws + WS_WOUT);
    bf16_t* Wup = (bf16_t*)(ws + WS_WUP); bf16_t* Wdn = (bf16_t*)(ws + WS_WDN); bf16_t* Wkv = (bf16_t*)(ws + WS_WKV);
    bf16_t* memn = (bf16_t*)(ws + WS_MEMN); bf16_t* memkv = (bf16_t*)(ws + WS_MEMKV); float2* rope = (float2*)(ws + WS_ROPE);
    unsigned short* topk = (unsigned short*)(ws + WS_TOPK); bf16_t* H = (bf16_t*)(ws + WS_H); bf16_t* proj = (bf16_t*)(ws + WS_PROJ);
    bf16_t* O = (bf16_t*)(ws + WS_O); bf16_t* hid = (bf16_t*)(ws + WS_HID); float* Y = (float*)(ws + WS_Y);
    gu32* ctl = (gu32*)(ws + WS_CTL);

    for (int u = threadIdx.x; u < (LDS_BYTES - LDSCTL_OFF) / 4; u += NTHR) ((LAS unsigned*)(lds + LDSCTL_OFF))[u] = 0u;
    __syncthreads();
    XcdBarrier bar = xcd_barrier_post((unsigned*)(ctl + CW_BAR), (volatile LAS unsigned*)(lds + LDSCTL_OFF + 64));
#define GRID_BAR() xcd_barrier(bar)

    {
        FRESH_IDS;
        LAS float* scr = (LAS float*)(lds + wave * 16384);
        GSTRIDE_WAVES(gw, NGW);
        prep_matrix(w_in_diff, D, NDIFF, Win0, NDIFF, 1, scr, gw, NGW, lane);
        prep_matrix(w_in_dsa, D, NDSA_L, Win1, NDSA, 2, scr, gw, NGW, lane);
#pragma unroll 1
        for (int l = 0; l < 2; ++l) {
            prep_matrix(w_out + (size_t)l * D * D, D, D, Wout + (size_t)l * D * D, D, 0, scr, gw, NGW, lane);
            prep_matrix(w_up + (size_t)l * D * FF, D, FF, Wup + (size_t)l * D * FF, FF, 0, scr, gw, NGW, lane);
            prep_matrix(w_dn + (size_t)l * D * FF, FF, D, Wdn + (size_t)l * D * FF, D, 0, scr, gw, NGW, lane);
            prep_matrix(w_mem_kv + (size_t)l * D * 512, D, 512, Wkv + (size_t)l * D * 512, 512, 1, scr, gw, NGW, lane);
            for (int m = gw; m < NB * NMEMT; m += NGW) rms_row_bf16(mem + (size_t)m * D, g_mem + l * D, memn + ((size_t)l * NB * NMEMT + m) * D, lane);
        }
        for (int idx = (int)blockIdx.x * NTHR + tid; idx < M * 32; idx += (int)gridDim.x * NTHR) {
            const int m = idx >> 5, i = idx & 31;
            const double inv = pow(10000.0, -(double)i / 32.0); const double ang = (double)pos[m] * inv;
            rope[idx] = make_float2((float)cos(ang), (float)sin(ang));
        }
        for (int m = gw; m < M; m += NGW) rms_row_bf16(x + (size_t)m * D, g_pre_mix, H + (size_t)m * D, lane);
    }
    GRID_BAR();
    GEMM_PHASE(EpiMemKV, memn, Wkv, NB * NMEMT, 512, D, memkv);
    GEMM_PHASE(EpiMemKV, memn + (size_t)NB * NMEMT * D, Wkv + (size_t)D * 512, NB * NMEMT, 512, D, memkv + MKV_LAYER);
    GEMM_PHASE(EpiProj0, H, Win0, M, NDIFF, D, proj, rope);
    GRID_BAR();
    ph_attn_diff(proj, O, lq1, lk1, lq2, lk2, gsub, lds);
    ph_attn_mem(proj + P0_QM, memkv, O, lds);
    GRID_BAR();
    GEMM_PHASE(EpiF, O, Wout, M, D, D, Y, D);
    GRID_BAR();
    { FRESH_IDS; ph_norm_res(Y, x, g_post_mix, out, g_pre_mlp, H, wave, lane); }
    GRID_BAR();
    GEMM_PHASE(EpiB<2>, H, Wup, M, FF, D, hid, FF);
    GRID_BAR();
    GEMM_PHASE(EpiF, hid, Wdn, M, D, FF, Y, D);
    GRID_BAR();
    { FRESH_IDS; ph_norm_res(Y, out, g_post_mlp, out, g_pre_mix + D, H, wave, lane); }
    GRID_BAR();
    GEMM_PHASE(EpiProj1, H, Win1, M, NDSA, D, proj, rope);
    GRID_BAR();
    ix::ph_topk(proj, topk, lds, IX_FORCE_EXACT != 0);
    GRID_BAR();
    sa::ph_dsa_attn(proj, topk, O, lds);
    __syncthreads();
    ph_attn_mem(proj + P1_QM, memkv + MKV_LAYER, O, lds);
    GRID_BAR();
    GEMM_PHASE(EpiF, O, Wout + (size_t)D * D, M, D, D, Y, D);
    GRID_BAR();
    { FRESH_IDS; ph_norm_res(Y, out, g_post_mix + D, out, g_pre_mlp + D, H, wave, lane); }
    GRID_BAR();
    GEMM_PHASE(EpiB<2>, H, Wup + (size_t)D * FF, M, FF, D, hid, FF);
    GRID_BAR();
    GEMM_PHASE(EpiF, hid, Wdn + (size_t)D * FF, M, D, FF, Y, D);
    GRID_BAR();
    { FRESH_IDS; ph_norm_res(Y, out, g_post_mlp + D, out, (const float*)nullptr, H, wave, lane); }
}

extern "C" void kernel_launch(void* const* d_in, const int* in_sizes, int n_in, void* d_out, int out_size, void* d_ws, size_t ws_size, hipStream_t stream) {
    static int grid = 0;
    if (grid == 0) {
        if (n_in != 19 || out_size != M * D || ws_size < WS_END) { fprintf(stderr, "kernel_launch: unexpected shapes n_in %d out %d ws %zu\n", n_in, out_size, ws_size); grid = -1; return; }
        int dev = 0, cus = 0, per_cu = 0;
        if (hipGetDevice(&dev) != hipSuccess || hipDeviceGetAttribute(&cus, hipDeviceAttributeMultiprocessorCount, dev) != hipSuccess) { grid = -1; return; }
        if (hipFuncSetAttribute((const void*)mk_fwd, hipFuncAttributeMaxDynamicSharedMemorySize, LDS_BYTES) != hipSuccess) { fprintf(stderr, "kernel_launch: hipFuncSetAttribute failed\n"); grid = -1; return; }
        if (hipOccupancyMaxActiveBlocksPerMultiprocessor(&per_cu, (const void*)mk_fwd, NTHR, LDS_BYTES) != hipSuccess || per_cu < 1) { fprintf(stderr, "kernel_launch: occupancy query says %d blocks per CU\n", per_cu); grid = -1; (void)hipGetLastError(); return; }
        grid = cus;
    }
    if (grid < 0) return;
    (void)hipMemsetAsync((char*)d_ws + WS_CTL, 0, CTL_ZERO_BYTES, stream);
    Args a; memset(&a, 0, sizeof(a));
    for (int i = 0; i < 19; ++i) a.in[i] = d_in[i];
    a.out = (float*)d_out; a.ws = (unsigned char*)d_ws;
    hipLaunchKernelGGL(mk_fwd, dim3(grid), dim3(NTHR), LDS_BYTES, stream, a);
}
```

```cpp
#include <hip/hip_runtime.h>
#include <cstdio>
#include <cstdint>
#include <cstring>

namespace pg8 {
#define PG8_LAS __attribute__((address_space(3)))
typedef unsigned short bf16_t;
typedef short bf16x8 __attribute__((ext_vector_type(8)));
typedef float f32x4 __attribute__((ext_vector_type(4)));
typedef unsigned u32x4 __attribute__((ext_vector_type(4)));
constexpr int BM = 256, BK = 64, HALF = 128, HTB = HALF * BK * 2  , STAGE_BYTES = 8 * HTB, NXCD = 8, WGM = 8;

__host__ __device__ __forceinline__ int lds_byte(int r, int c) { const int st = (r >> 4) * 2 + (c >> 5), rr = r & 15, cc = c & 31, ob = rr * 64 + cc * 2; return st * 1024 + (ob ^ (((ob >> 9) & 1) << 5)); }
__host__ __device__ __forceinline__ void stage_rc(int b, int& R, int& C) { const int st = b / 1024, sb = b % 1024, swz = sb ^ (((sb >> 9) & 1) << 5); R = (st >> 1) * 16 + swz / 64; C = (st & 1) * 32 + (swz % 64) / 2; }
__host__ __device__ __forceinline__ int perm32(int rho) { const int n = rho >> 4, i = rho & 15; return 8 * (i >> 2) + 4 * n + (i & 3); }

struct Unit { int pm, pn; };
struct Gemm { const bf16_t* A; const bf16_t* Bt; int M, N, K; };

struct StaticOrder {
    int nM, nN, nwg, G, c;
    __host__ __device__ void init(int M, int N, int G_, int c_) { nM = M / BM; nN = N / BM; nwg = nM * nN; G = G_; c = c_; }
    __host__ __device__ bool next(int i, Unit& u) const {
        const long L = (long)i * G + c; if (L >= nwg) return false;
        int wgid = (int)L; { const int q = nwg / NXCD, r = nwg % NXCD, xcd = wgid % NXCD, off = wgid / NXCD; wgid = (xcd < r ? xcd * (q + 1) : r * (q + 1) + (xcd - r) * q) + off; }
        const int nig = WGM * nN, gid = wgid / nig, fm = gid * WGM, gsz = (nM - fm) < WGM ? (nM - fm) : WGM;
        u.pm = fm + ((wgid % nig) % gsz); u.pn = (wgid % nig) / gsz; return true;
    }
    __device__ __forceinline__ void a_ready(const Unit&) const {}
    __device__ __forceinline__ void done(const Unit&) const {}
};

__device__ __forceinline__ unsigned cvt_pk_bf16(float lo, float hi) { unsigned r; asm volatile("v_cvt_pk_bf16_f32 %0, %1, %2" : "=v"(r) : "v"(lo), "v"(hi)); return r; }
typedef float f32x2 __attribute__((ext_vector_type(2)));
__device__ __forceinline__ f32x2 gelu_pk(f32x2 v) {
    const f32x2 av = __builtin_elementwise_abs(v), d = av * 0.2316418882f + 1.0f;
    f32x2 t; t.x = __builtin_amdgcn_rcpf(d.x); t.y = __builtin_amdgcn_rcpf(d.y);
    f32x2 q = t * 0.5307027145f + (-0.7265760135f); q = q * t + 0.7107068705f; q = q * t + (-0.142248368f); q = q * t + 0.127414796f; q = q * t;
    const f32x2 s = (v * v) * (-0.72134752044f);
    f32x2 e; e.x = __builtin_amdgcn_exp2f(s.x); e.y = __builtin_amdgcn_exp2f(s.y);
    const f32x2 m = v * (q * e), r = v - m;
    f32x2 o; o.x = v.x < 0.f ? m.x : r.x; o.y = v.y < 0.f ? m.y : r.y; return o;
}

template <int ACT  > struct EpiBf16 {
    static constexpr bool PERM = true, AFTER_DRAIN = false; static_assert(ACT == 0 || ACT == 1, "EpiBf16: ACT is 0 (none) or 1 (gelu_pk)");
    bf16_t* O; int ldc; const float* bias; int split_cols; size_t split_stride; float scale0;
    __device__ __forceinline__ void operator()(const f32x4 (&acc)[2][2][4][2], const Unit& u, int wr, int wc, int fr, int fq) const {
        const int row0 = u.pm * BM + wr * 64 + fr; int colt = u.pn * BM; bf16_t* base = O;
        float sc = 1.f; if (split_cols) { const int t = colt / split_cols; base += (size_t)t * split_stride; colt -= t * split_cols; if (t == 0) sc = scale0; }
        const int col0 = colt + wc * 32 + 8 * fq, bcol0 = u.pn * BM + wc * 32 + 8 * fq;
        f32x4 bv[2][2];
#pragma unroll
        for (int bj = 0; bj < 2; ++bj)
#pragma unroll
            for (int n = 0; n < 2; ++n) bv[bj][n] = bias ? *(const f32x4*)(bias + bcol0 + bj * HALF + 4 * n) : (f32x4){0.f, 0.f, 0.f, 0.f};
#pragma unroll
        for (int ai = 0; ai < 2; ++ai)
#pragma unroll
            for (int m = 0; m < 4; ++m) { bf16_t* rowp = base + (size_t)(row0 + ai * HALF + m * 16) * ldc + col0;
#pragma unroll
                for (int bj = 0; bj < 2; ++bj) { f32x4 v0 = acc[ai][bj][m][0] + bv[bj][0], v1 = acc[ai][bj][m][1] + bv[bj][1];
                    if (ACT == 1) { f32x2 a = gelu_pk((f32x2){v0[0], v0[1]}), b = gelu_pk((f32x2){v0[2], v0[3]}), c = gelu_pk((f32x2){v1[0], v1[1]}), d = gelu_pk((f32x2){v1[2], v1[3]});
                        v0 = (f32x4){a.x, a.y, b.x, b.y}; v1 = (f32x4){c.x, c.y, d.x, d.y}; }
                    v0 = v0 * sc; v1 = v1 * sc; u32x4 w; w.x = cvt_pk_bf16(v0[0], v0[1]); w.y = cvt_pk_bf16(v0[2], v0[3]); w.z = cvt_pk_bf16(v1[0], v1[1]); w.w = cvt_pk_bf16(v1[2], v1[3]);
                    *(u32x4*)(rowp + bj * HALF) = w; } }
    }
};

struct PanelStats {
    unsigned* xbuf;
    unsigned* cnt;
    unsigned* tmo;
    int ntn; float eps;
    unsigned code;
    __device__ __forceinline__ bool run(const f32x4 (&v)[2][2][4][2], const Unit& u, int wr, int wc, int fr, int fq, PG8_LAS unsigned char* lds, int wid, int lane) const {
        typedef float f32x2v __attribute__((ext_vector_type(2)));
        PG8_LAS f32x2v* P = (PG8_LAS f32x2v*)lds;
        PG8_LAS f32x2v* S = (PG8_LAS f32x2v*)(lds + 8192);
        PG8_LAS unsigned* flag = (PG8_LAS unsigned*)(lds + 8192 + 2048);
#pragma unroll
        for (int ai = 0; ai < 2; ++ai)
#pragma unroll
            for (int m = 0; m < 4; ++m) {
                float s = 0.f;
#pragma unroll
                for (int bj = 0; bj < 2; ++bj)
#pragma unroll
                    for (int n = 0; n < 2; ++n) { const f32x4 x = v[ai][bj][m][n]; s += (x[0] + x[1]) + (x[2] + x[3]); }
                s += __shfl_xor(s, 16); s += __shfl_xor(s, 32);
                const float mw = s * (1.0f / 64.0f); float q = 0.f;
#pragma unroll
                for (int bj = 0; bj < 2; ++bj)
#pragma unroll
                    for (int n = 0; n < 2; ++n) { const f32x4 d = v[ai][bj][m][n] - mw; q += (d[0] * d[0] + d[1] * d[1]) + (d[2] * d[2] + d[3] * d[3]); }
                q += __shfl_xor(q, 16); q += __shfl_xor(q, 32);
                if (fq == 0) P[(ai * HALF + wr * 64 + m * 16 + fr) * 4 + wc] = (f32x2v){mw, q};
            }
        asm volatile("s_waitcnt lgkmcnt(0)" ::: "memory"); __builtin_amdgcn_s_barrier(); asm volatile("" ::: "memory");
#if defined(BROKEN_EXCHANGE_NO_WAIT)
#warning BROKEN CONTROL BUILD: the row-statistics exchange does not wait; results are wrong by design
        if (blockIdx.x >= 64) { const long long t0_ = clock64(); while (clock64() - t0_ < 60000) __builtin_amdgcn_s_sleep(8); }
#endif
        const int row = wid * 32 + (lane & 31);
        if (lane < 32) {
            const f32x2v a = P[row * 4 + 0], b = P[row * 4 + 1], c = P[row * 4 + 2], d = P[row * 4 + 3];
            const float mt = (a.x + b.x + c.x + d.x) * 0.25f;
            const float da = a.x - mt, db = b.x - mt, dc = c.x - mt, dd = d.x - mt;
            const float m2 = (a.y + b.y) + (c.y + d.y) + 64.0f * ((da * da + db * db) + (dc * dc + dd * dd));
            unsigned long long* slot = (unsigned long long*)xbuf + ((size_t)(u.pm * BM + row) * 4 + u.pn);
            __hip_atomic_store(slot, ((unsigned long long)__float_as_uint(m2) << 32) | __float_as_uint(mt), __ATOMIC_RELAXED, __HIP_MEMORY_SCOPE_AGENT);
        }
        asm volatile("s_waitcnt vmcnt(0)" ::: "memory");
        if (lane == 0) __hip_atomic_fetch_add(cnt + 64 * u.pm, 1u, __ATOMIC_RELAXED, __HIP_MEMORY_SCOPE_AGENT);
        if (wid == 0) {
            bool dead = false; const unsigned long long t0 = __builtin_amdgcn_s_memrealtime(); const unsigned want = 8u * (unsigned)ntn;
            for (;;) {
#if defined(BROKEN_EXCHANGE_NO_WAIT)
                break;
#endif
                if ((unsigned)__builtin_amdgcn_readfirstlane(__hip_atomic_load(cnt + 64 * u.pm, __ATOMIC_RELAXED, __HIP_MEMORY_SCOPE_AGENT)) >= want) break;
                if (__builtin_amdgcn_s_memrealtime() - t0 > 2000000ull) {
                    if (lane == 0) { unsigned expect = 0u; __hip_atomic_compare_exchange_strong(tmo + 1, &expect, code | (unsigned)(u.pm & 0xff), __ATOMIC_RELAXED, __ATOMIC_RELAXED, __HIP_MEMORY_SCOPE_AGENT);
                                     __hip_atomic_store(tmo, 1u, __ATOMIC_RELAXED, __HIP_MEMORY_SCOPE_AGENT); }
                    dead = true; break; }
                __builtin_amdgcn_s_sleep(2);
            }
            __builtin_amdgcn_fence(__ATOMIC_ACQUIRE, "agent");
            if (lane == 0) flag[0] = dead ? 1u : 0u;
        }
        asm volatile("s_waitcnt vmcnt(0) lgkmcnt(0)" ::: "memory"); __builtin_amdgcn_s_barrier(); asm volatile("" ::: "memory");
        const bool bad = flag[0] != 0u;
        if (lane < 32) {
            const unsigned long long* slot = (const unsigned long long*)xbuf + (size_t)(u.pm * BM + row) * 4; float mt[4], m2[4]; float ms = 0.f;
#pragma unroll
            for (int t = 0; t < 4; ++t) { if (t < ntn) { const unsigned long long w = __hip_atomic_load(slot + t, __ATOMIC_RELAXED, __HIP_MEMORY_SCOPE_AGENT); mt[t] = __uint_as_float((unsigned)w); m2[t] = __uint_as_float((unsigned)(w >> 32)); } else { mt[t] = 0.f; m2[t] = 0.f; } ms += mt[t]; }
            const float mean = ms / (float)ntn; float q = 0.f;
#pragma unroll
            for (int t = 0; t < 4; ++t) if (t < ntn) { const float dm = mt[t] - mean; q += m2[t] + 256.0f * dm * dm; }
            S[row] = (f32x2v){mean, 1.0f / sqrtf(q / (256.0f * (float)ntn) + eps)};
        }
        asm volatile("s_waitcnt lgkmcnt(0)" ::: "memory"); __builtin_amdgcn_s_barrier(); asm volatile("" ::: "memory");
        return bad;
    }
};
struct EpiLnRes {
    static constexpr bool PERM = false, AFTER_DRAIN = true;
    const float* base; float* out; int ldc; const float* bias; PanelStats st; unsigned poison;
    __device__ __forceinline__ void fused(f32x4 (&acc)[2][2][4][2], const Unit& u, int wr, int wc, int fr, int fq, PG8_LAS unsigned char* lds, int wid, int lane) const {
        typedef float f32x2v __attribute__((ext_vector_type(2)));
        const PG8_LAS f32x2v* S = (const PG8_LAS f32x2v*)(lds + 8192);
        const int col0 = u.pn * BM + wc * 32 + 4 * fq;
#pragma unroll
        for (int bj = 0; bj < 2; ++bj)
#pragma unroll
            for (int n = 0; n < 2; ++n) { const f32x4 bv = bias ? *(const f32x4*)(bias + col0 + bj * HALF + n * 16) : (f32x4){0.f, 0.f, 0.f, 0.f};
#pragma unroll
                for (int ai = 0; ai < 2; ++ai)
#pragma unroll
                    for (int m = 0; m < 4; ++m) acc[ai][bj][m][n] += bv; }
        f32x4 pre[4][2][2];
#pragma unroll
        for (int m = 0; m < 4; ++m) { const size_t off = (size_t)(u.pm * BM + wr * 64 + m * 16 + fr) * ldc + col0;
#pragma unroll
            for (int bj = 0; bj < 2; ++bj)
#pragma unroll
                for (int n = 0; n < 2; ++n) pre[m][bj][n] = *(const f32x4*)(base + off + bj * HALF + n * 16); }
        const bool bad = st.run(acc, u, wr, wc, fr, fq, lds, wid, lane) || poison != 0u;
        const float qnan = __builtin_nanf("");
#pragma unroll
        for (int ai = 0; ai < 2; ++ai)
#pragma unroll
            for (int m = 0; m < 4; ++m) { const int r = ai * HALF + wr * 64 + m * 16 + fr; const f32x2v sr = S[r]; const size_t off = (size_t)(u.pm * BM + r) * ldc + col0;
#pragma unroll
                for (int bj = 0; bj < 2; ++bj)
#pragma unroll
                    for (int n = 0; n < 2; ++n) { const f32x4 bs = ai == 0 ? pre[m][bj][n] : *(const f32x4*)(base + off + bj * HALF + n * 16); f32x4 o = bs + (acc[ai][bj][m][n] - sr.x) * sr.y;
                        if (bad) o = (f32x4){qnan, qnan, qnan, qnan}; *(f32x4*)(out + off + bj * HALF + n * 16) = o; }
                if (m & 1) asm volatile("" ::: "memory"); }
    }
};
struct EpiLnResLn {
    static constexpr bool PERM = false, AFTER_DRAIN = true;
    const float* base; float* out; bf16_t* xn; int ldc; const float* bias; PanelStats st1, st2; unsigned poison;
    __device__ __forceinline__ void fused(f32x4 (&acc)[2][2][4][2], const Unit& u, int wr, int wc, int fr, int fq, PG8_LAS unsigned char* lds, int wid, int lane) const {
        typedef float f32x2v __attribute__((ext_vector_type(2))); typedef unsigned u32x2v __attribute__((ext_vector_type(2)));
        const PG8_LAS f32x2v* S = (const PG8_LAS f32x2v*)(lds + 8192);
        const int col0 = u.pn * BM + wc * 32 + 4 * fq;
#pragma unroll
        for (int bj = 0; bj < 2; ++bj)
#pragma unroll
            for (int n = 0; n < 2; ++n) { const f32x4 bv = bias ? *(const f32x4*)(bias + col0 + bj * HALF + n * 16) : (f32x4){0.f, 0.f, 0.f, 0.f};
#pragma unroll
                for (int ai = 0; ai < 2; ++ai)
#pragma unroll
                    for (int m = 0; m < 4; ++m) acc[ai][bj][m][n] += bv; }
        bool bad = st1.run(acc, u, wr, wc, fr, fq, lds, wid, lane) || poison != 0u;
        const float qnan = __builtin_nanf("");
#pragma unroll
        for (int ai = 0; ai < 2; ++ai)
#pragma unroll
            for (int m = 0; m < 4; ++m) { const int r = ai * HALF + wr * 64 + m * 16 + fr; const f32x2v sr = S[r]; const size_t off = (size_t)(u.pm * BM + r) * ldc + col0;
#pragma unroll
                for (int bj = 0; bj < 2; ++bj)
#pragma unroll
                    for (int n = 0; n < 2; ++n) { const f32x4 bs = *(const f32x4*)(base + off + bj * HALF + n * 16); acc[ai][bj][m][n] = bs + (acc[ai][bj][m][n] - sr.x) * sr.y; }
                asm volatile("" : "+v"(acc[ai][0][m][0]), "+v"(acc[ai][0][m][1]), "+v"(acc[ai][1][m][0]), "+v"(acc[ai][1][m][1]));
                if (m & 1) asm volatile("" ::: "memory"); }
        const bool bad1 = bad;
        bad = st2.run(acc, u, wr, wc, fr, fq, lds, wid, lane) || bad;
#pragma unroll
        for (int ai = 0; ai < 2; ++ai)
#pragma unroll
            for (int m = 0; m < 4; ++m) { const int r = ai * HALF + wr * 64 + m * 16 + fr; const f32x2v sr = S[r]; const size_t off = (size_t)(u.pm * BM + r) * ldc + col0;
#pragma unroll
                for (int bj = 0; bj < 2; ++bj)
#pragma unroll
                    for (int n = 0; n < 2; ++n) { const f32x4 x1 = acc[ai][bj][m][n]; *(f32x4*)(out + off + bj * HALF + n * 16) = bad1 ? (f32x4){qnan, qnan, qnan, qnan} : x1;
                        const f32x4 o = (x1 - sr.x) * sr.y; u32x2v w; w.x = cvt_pk_bf16(o[0], o[1]); w.y = cvt_pk_bf16(o[2], o[3]);
                        if (bad) { w.x = 0x7fc07fc0u; w.y = 0x7fc07fc0u; } *(u32x2v*)(xn + off + bj * HALF + n * 16) = w; }
                asm volatile("" ::: "memory"); }
    }
};

template <class Epi, class Sched, bool ALIGN_EPI = false, bool SP2 = false>
__device__ __forceinline__ void gemm_phase(PG8_LAS unsigned char* lds, const Gemm g, const Sched& S, const Epi& E) {
    int tid_ = threadIdx.x; asm volatile("" : "+v"(tid_));
    const int tid = tid_, wid = __builtin_amdgcn_readfirstlane(tid >> 6), lane = tid & 63, wr = wid >> 2, wc = wid & 3, fr = lane & 15, fq = lane >> 4;
    const int K = g.K, nt = K / BK;
    unsigned voffA[2], voffB[2];
#pragma unroll
    for (int i = 0; i < 2; ++i) { int R, C; stage_rc(tid * 16 + i * 8192, R, C); const int Rb = Epi::PERM ? ((R & ~31) + perm32(R & 31)) : R;
        voffA[i] = (unsigned)(R * K + C) * 2u; voffB[i] = (unsigned)(Rb * K + C) * 2u; }
    const size_t kstep = (size_t)(BK * 2);
    const size_t hstep = (size_t)HALF * K * 2;
    const size_t tstep = 2 * hstep;
    const unsigned ldsw = (unsigned)wid * 1024u;
    const int aoff = lds_byte(wr * 64 + fr, fq * 8), boff = lds_byte(wc * 32 + fr, fq * 8);
#define PG8_SA(b, h) (((b) * 2 + (h)) * HTB)
#define PG8_SB(b, h) ((4 + (b) * 2 + (h)) * HTB)
#define PG8_STAGE(bufoff, gbase, voff) do { _Pragma("unroll") for (int _i = 0; _i < 2; ++_i) \
        __builtin_amdgcn_global_load_lds((const unsigned*)((const char*)(gbase) + (voff)[_i]), (PG8_LAS unsigned*)(lds + (bufoff) + ldsw + _i * 8192), 16, 0, 0); } while (0)
#define PG8_LDA(dst, b, h) do { _Pragma("unroll") for (int m = 0; m < 4; ++m) _Pragma("unroll") for (int k = 0; k < 2; ++k) dst[m][k] = *(const PG8_LAS bf16x8*)(lds + PG8_SA(b, h) + aoff + m * 2048 + k * 1024); } while (0)
#define PG8_LDB(dst, b, h) do { _Pragma("unroll") for (int n = 0; n < 2; ++n) _Pragma("unroll") for (int k = 0; k < 2; ++k) dst[n][k] = *(const PG8_LAS bf16x8*)(lds + PG8_SB(b, h) + boff + n * 2048 + k * 1024); } while (0)
#define PG8_MMA(ai, bj, At, Bt) do { __builtin_amdgcn_s_setprio(1); _Pragma("unroll") for (int m = 0; m < 4; ++m) _Pragma("unroll") for (int n = 0; n < 2; ++n) _Pragma("unroll") for (int k = 0; k < 2; ++k) \
        acc[ai][bj][m][n] = __builtin_amdgcn_mfma_f32_16x16x32_bf16(Bt[n][k], At[m][k], acc[ai][bj][m][n], 0, 0, 0); __builtin_amdgcn_s_setprio(0); } while (0)
#define PG8_WAIT_V(n) asm volatile("s_waitcnt vmcnt(" #n ")" ::: "memory")
#define PG8_WAIT_L(n) asm volatile("s_waitcnt lgkmcnt(" #n ")" ::: "memory")
#define PG8_BAR __builtin_amdgcn_s_barrier()
#define PG8_SCHED __builtin_amdgcn_sched_barrier(0)
    Unit cur, nxt; int ui = 0;
    if (!S.next(0, cur)) return;
    f32x4 acc[2][2][4][2];
#pragma unroll
    for (int a = 0; a < 2; ++a)
#pragma unroll
        for (int b = 0; b < 2; ++b)
#pragma unroll
            for (int m = 0; m < 4; ++m)
#pragma unroll
                for (int n = 0; n < 2; ++n) acc[a][b][m][n] = (f32x4){0.f, 0.f, 0.f, 0.f};
    bf16x8 At[4][2], B0[2][2], B1[2][2];
    const char* cA = (const char*)g.A + (size_t)cur.pm * tstep; const char* cB = (const char*)g.Bt + (size_t)cur.pn * tstep;
    S.a_ready(cur);
    if constexpr (SP2) {
        PG8_STAGE(PG8_SB(0, 0), cB, voffB); PG8_STAGE(PG8_SB(0, 1), cB + hstep, voffB); PG8_STAGE(PG8_SA(0, 0), cA, voffA); PG8_STAGE(PG8_SA(0, 1), cA + hstep, voffA);
        if (wr == 1) PG8_BAR;
        PG8_WAIT_V(2); PG8_BAR;
        PG8_STAGE(PG8_SB(1, 0), cB + kstep, voffB); PG8_STAGE(PG8_SA(1, 0), cA + kstep, voffA); PG8_STAGE(PG8_SB(1, 1), cB + hstep + kstep, voffB);
        PG8_WAIT_V(6); PG8_BAR;
    } else {
        PG8_STAGE(PG8_SB(0, 0), cB, voffB); PG8_STAGE(PG8_SA(0, 0), cA, voffA); PG8_STAGE(PG8_SB(0, 1), cB + hstep, voffB); PG8_STAGE(PG8_SA(0, 1), cA + hstep, voffA);
        if (wr == 1) PG8_BAR;
        PG8_WAIT_V(4); PG8_BAR;
        PG8_STAGE(PG8_SB(1, 0), cB + kstep, voffB); PG8_STAGE(PG8_SA(1, 0), cA + kstep, voffA); PG8_STAGE(PG8_SB(1, 1), cB + hstep + kstep, voffB);
        PG8_WAIT_V(6); PG8_BAR;
    }
    for (;;) {
        const bool has_next = S.next(ui + 1, nxt);
        const char* nA = has_next ? (const char*)g.A + (size_t)nxt.pm * tstep : cA; const char* nB = has_next ? (const char*)g.Bt + (size_t)nxt.pn * tstep : cB;
        for (int t = 0; t < nt; t += 2) {
            const bool last = (t == nt - 2);
            const char* a1 = cA + (size_t)(t + 1) * kstep;
            const char* a2 = last ? nA : cA + (size_t)(t + 2) * kstep; const char* b2 = last ? nB : cB + (size_t)(t + 2) * kstep;
            const char* a3 = a2 + kstep; const char* b3 = b2 + kstep;
            if (last && has_next) S.a_ready(nxt);
            if constexpr (SP2) {
            PG8_LDB(B0, 0, 0); PG8_LDB(B1, 0, 1); PG8_SCHED; PG8_LDA(At, 0, 0); PG8_STAGE(PG8_SA(1, 1), a1 + hstep, voffA);
            PG8_WAIT_V(8); PG8_WAIT_L(0); PG8_BAR; PG8_MMA(0, 0, At, B0); PG8_MMA(0, 1, At, B1); PG8_BAR; PG8_SCHED;
            PG8_LDA(At, 0, 1); PG8_STAGE(PG8_SB(0, 0), b2, voffB); PG8_STAGE(PG8_SB(0, 1), b2 + hstep, voffB); PG8_STAGE(PG8_SA(0, 0), a2, voffA);
            PG8_WAIT_V(8); PG8_WAIT_L(0); PG8_BAR; PG8_MMA(1, 0, At, B0); PG8_MMA(1, 1, At, B1); PG8_BAR; PG8_SCHED;
            PG8_LDB(B0, 1, 0); PG8_LDB(B1, 1, 1); PG8_SCHED; PG8_LDA(At, 1, 0); PG8_STAGE(PG8_SA(0, 1), a2 + hstep, voffA);
            PG8_WAIT_V(8); PG8_WAIT_L(0); PG8_BAR; PG8_MMA(0, 0, At, B0); PG8_MMA(0, 1, At, B1); PG8_BAR; PG8_SCHED;
            PG8_LDA(At, 1, 1); PG8_STAGE(PG8_SB(1, 0), b3, voffB); PG8_STAGE(PG8_SB(1, 1), b3 + hstep, voffB); PG8_STAGE(PG8_SA(1, 0), a3, voffA);
            PG8_WAIT_V(8); PG8_WAIT_L(0); PG8_BAR; PG8_MMA(1, 0, At, B0); PG8_MMA(1, 1, At, B1); PG8_BAR; PG8_SCHED;
            } else {
            PG8_LDB(B0, 0, 0); PG8_SCHED; PG8_LDA(At, 0, 0); PG8_STAGE(PG8_SA(1, 1), a1 + hstep, voffA);
            PG8_WAIT_L(8); PG8_BAR; PG8_WAIT_L(0); PG8_MMA(0, 0, At, B0); PG8_BAR; PG8_SCHED;
            PG8_LDB(B1, 0, 1); PG8_STAGE(PG8_SB(0, 0), b2, voffB);
            PG8_BAR; PG8_WAIT_L(0); PG8_MMA(0, 1, At, B1); PG8_BAR;
            PG8_LDA(At, 0, 1); PG8_STAGE(PG8_SA(0, 0), a2, voffA);
            PG8_BAR; PG8_WAIT_L(0); PG8_MMA(1, 0, At, B0); PG8_BAR; PG8_SCHED;
            PG8_STAGE(PG8_SB(0, 1), b2 + hstep, voffB);
            PG8_WAIT_V(6); PG8_BAR; PG8_MMA(1, 1, At, B1); PG8_BAR;
            PG8_LDB(B0, 1, 0); PG8_SCHED; PG8_LDA(At, 1, 0); PG8_STAGE(PG8_SA(0, 1), a2 + hstep, voffA);
            PG8_WAIT_L(8); PG8_BAR; PG8_WAIT_L(0); PG8_MMA(0, 0, At, B0); PG8_BAR; PG8_SCHED;
            PG8_LDB(B1, 1, 1); PG8_STAGE(PG8_SB(1, 0), b3, voffB);
            PG8_BAR; PG8_WAIT_L(0); PG8_MMA(0, 1, At, B1); PG8_BAR;
            PG8_LDA(At, 1, 1); PG8_STAGE(PG8_SA(1, 0), a3, voffA);
            PG8_BAR; PG8_WAIT_L(0); PG8_MMA(1, 0, At, B0); PG8_BAR; PG8_SCHED;
            PG8_STAGE(PG8_SB(1, 1), b3 + hstep, voffB);
            PG8_WAIT_V(6); PG8_BAR; PG8_MMA(1, 1, At, B1); PG8_BAR;
            }
        }
        if constexpr (ALIGN_EPI) { if (wr == 0) PG8_BAR; }
        if constexpr (!Epi::AFTER_DRAIN) { E(acc, cur, wr, wc, fr, fq); S.done(cur); }
        if (!has_next) break;
#pragma unroll
        for (int a = 0; a < 2; ++a)
#pragma unroll
            for (int b = 0; b < 2; ++b)
#pragma unroll
                for (int m = 0; m < 4; ++m)
#pragma unroll
                    for (int n = 0; n < 2; ++n) acc[a][b][m][n] = (f32x4){0.f, 0.f, 0.f, 0.f};
        cur = nxt; cA = nA; cB = nB; ++ui;
        if constexpr (ALIGN_EPI) { if (wr == 1) PG8_BAR; }
    }
    PG8_WAIT_V(0);
    if constexpr (!ALIGN_EPI) { if (wr == 0) PG8_BAR; }
    PG8_BAR;
    if constexpr (Epi::AFTER_DRAIN) { E.fused(acc, cur, wr, wc, fr, fq, lds, wid, lane); S.done(cur); }
#undef PG8_SA
#undef PG8_SB
#undef PG8_STAGE
#undef PG8_LDA
#undef PG8_LDB
#undef PG8_MMA
#undef PG8_WAIT_V
#undef PG8_WAIT_L
#undef PG8_BAR
#undef PG8_SCHED
}
}
#define GAS __attribute__((address_space(1)))
#define LAS __attribute__((address_space(3)))
typedef unsigned short bf16;
typedef unsigned v4u __attribute__((ext_vector_type(4)));
typedef float f32x4 __attribute__((ext_vector_type(4)));
typedef short bf16x8 __attribute__((ext_vector_type(8)));
typedef GAS unsigned gu32;
typedef GAS unsigned long long gu64;
#define RLX_AGENT __ATOMIC_RELAXED, __HIP_MEMORY_SCOPE_AGENT
#define LDS_WAIT() asm volatile("s_waitcnt lgkmcnt(0)" ::: "memory")
#define VM_WAIT() asm volatile("s_waitcnt vmcnt(0)" ::: "memory")
__device__ __forceinline__ unsigned long long rt() { return __builtin_amdgcn_s_memrealtime(); }
#define XB_TMO      128
#define XB_XCNT(j)  (256  + 64 * (j))
#define XB_XSUB(j)  (1280 + 64 * (j))
#define XB_XGEN(j)  (2304 + 64 * (j))
#define XB_TOP      3328
#define XB_TOPGEN   3392
#define XCD_BAR_WORDS 3456
#define XB_SPIN_CAP (1u << 18)

__device__ __forceinline__ unsigned xb_ld(unsigned* p)              { return __hip_atomic_load(p, __ATOMIC_RELAXED, __HIP_MEMORY_SCOPE_AGENT); }
__device__ __forceinline__ unsigned xb_add(unsigned* p, unsigned v) { return __hip_atomic_fetch_add(p, v, __ATOMIC_RELAXED, __HIP_MEMORY_SCOPE_AGENT); }
__device__ __forceinline__ unsigned xb_xcc_id() { return (unsigned)__builtin_amdgcn_s_getreg((3 << 11) | 20) & 0xFu; }
#define XB_SPIN(cond, bar) do { unsigned _sp = 0; while (cond) { __builtin_amdgcn_s_sleep(1); \
    if ((++_sp & 255u) == 0u) { if (xb_ld(&(bar)[XB_TMO])) break; if (_sp > XB_SPIN_CAP) { atomicAdd(&(bar)[XB_TMO], 1u); break; } } } } while (0)

struct XcdBarrier {
    unsigned* bar; unsigned x;
    volatile LAS unsigned* st;
};

__device__ __forceinline__ XcdBarrier xcd_barrier_post(unsigned* bar, volatile LAS unsigned* st) {
    XcdBarrier b; b.bar = bar; b.x = xb_xcc_id(); b.st = st;
    if (threadIdx.x == 0) (void)xb_add(&bar[XB_XCNT(b.x)], 1u);
    return b;
}
__device__ __forceinline__ void xcd_barrier_complete(unsigned* bar, unsigned x, unsigned& nloc, unsigned& nx) {
    const unsigned G = gridDim.x * gridDim.y * gridDim.z;
    unsigned sum, cnt, mine, sp = 0u;
    for (;;) {
        sum = 0u; cnt = 0u; mine = 0u;
#pragma unroll
        for (unsigned j = 0; j < 16; ++j) { const unsigned c = xb_ld(&bar[XB_XCNT(j)]); sum += c; cnt += (c > 0u) ? 1u : 0u; mine = (j == x) ? c : mine; }
        if (sum == G) break;
        __builtin_amdgcn_s_sleep(1);
        if ((++sp & 255u) == 0u) { if (xb_ld(&bar[XB_TMO])) break; if (sp > XB_SPIN_CAP) { atomicAdd(&bar[XB_TMO], 1u); break; } }
    }
    nloc = mine > 0u ? mine : 1u; nx = cnt > 0u ? cnt : 1u;
}

__device__ __forceinline__ void xcd_barrier(const XcdBarrier& b) {
    asm volatile("s_waitcnt vmcnt(0)" ::: "memory");
    __syncthreads();
    if (threadIdx.x == 0) {
        unsigned* bar = b.bar;
        __builtin_amdgcn_s_waitcnt(0);
        unsigned nloc = b.st[0], nx = b.st[1];
        if (nloc == 0u) { xcd_barrier_complete(bar, b.x, nloc, nx); b.st[0] = nloc; b.st[1] = nx; }
        const unsigned old = xb_add(&bar[XB_XSUB(b.x)], 1u);
        const unsigned gen = old / nloc;
        if (old + 1u == (gen + 1u) * nloc) {
            __builtin_amdgcn_fence(__ATOMIC_RELEASE, "agent");
            asm volatile("s_waitcnt vmcnt(0)" ::: "memory");
            const unsigned og = xb_add(&bar[XB_TOP], 1u);
            const unsigned tg = og / nx;
            if (og + 1u == (tg + 1u) * nx) xb_add(&bar[XB_TOPGEN], 1u);
            else XB_SPIN(xb_ld(&bar[XB_TOPGEN]) == tg, bar);
            __builtin_amdgcn_fence(__ATOMIC_ACQUIRE, "agent");
            xb_add(&bar[XB_XGEN(b.x)], 1u);
            asm volatile("s_waitcnt vmcnt(0)" ::: "memory");
        } else {
            XB_SPIN(xb_ld(&bar[XB_XGEN(b.x)]) == gen, bar);
            __builtin_amdgcn_fence(__ATOMIC_ACQUIRE, "agent");
            asm volatile("s_waitcnt vmcnt(0)" ::: "memory");
        }
    }
    __syncthreads();
}
__device__ __forceinline__ int fresh_tid() { int t = threadIdx.x; asm volatile("" : "+v"(t)); return t; }

constexpr int NB = 8, S = 8192, M = NB * S, D = 1024, FF = 4096, NMEMT = 256;
constexpr int NDIFF = 2560, NDSA_L = 1736, NDSA = 1792;
constexpr float EPS = 1e-6f;
constexpr int NWAVES = 8, NTHR = 512;
constexpr float C2 = 0.125f * 1.4426950408889634f;
constexpr int DQ = 0, DK = 768, DV = 832, DIQ = 896, DIK = 1408, DIW = 1472, DQM = 1480;

typedef unsigned short bf16_t;
typedef unsigned u32x4 __attribute__((ext_vector_type(4)));
typedef float f32x4 __attribute__((ext_vector_type(4)));

constexpr size_t MiB = 1u << 20;
constexpr size_t WS_CTL = 0;
constexpr size_t WS_WIN0 = 1 * MiB, WS_WIN1 = 6 * MiB, WS_WOUT = 10 * MiB, WS_WUP = 14 * MiB, WS_WDN = 30 * MiB, WS_WKV = 46 * MiB;
constexpr size_t WS_MEMN = 48 * MiB, WS_MEMKV = 56 * MiB, WS_ROPE = 60 * MiB, WS_TOPK = 76 * MiB;
constexpr size_t WS_H = 108 * MiB, WS_PROJ = 236 * MiB, WS_O = 556 * MiB, WS_HID = 236 * MiB, WS_Y = 748 * MiB, WS_END = 1004 * MiB;

constexpr size_t P0_Q = 0, P0_K = (size_t)M * 768, P0_V = (size_t)M * 1536, P0_QM = (size_t)M * 2304;
constexpr size_t P1_Q = 0, P1_K = (size_t)M * 768, P1_V = (size_t)M * 832, P1_IK = (size_t)M * 896, P1_IQ = (size_t)M * 960, P1_QM = (size_t)M * 1472, P1_IW = (size_t)M * 1728;
constexpr float IW_SCALE = 0.04419417382415922f;
constexpr size_t MKV_K = 0, MKV_V = 524288, MKV_LAYER = 1048576;
__device__ __forceinline__ float bf2f(bf16_t v) { return __uint_as_float((unsigned)v << 16); }
__device__ __forceinline__ unsigned f2bf(float f) { unsigned u = __float_as_uint(f); return (u + 0x7fffu + ((u >> 16) & 1u)) >> 16; }
__device__ __forceinline__ unsigned pk2(float lo, float hi) { return f2bf(lo) | (f2bf(hi) << 16); }
__device__ __forceinline__ float wave_sum(float v) {
#pragma unroll
    for (int o = 1; o < 64; o <<= 1) v += __shfl_xor(v, o);
    return v;
}

template <int ACT> struct EpiB {
    static constexpr bool PERM = true, AFTER_DRAIN = false;
    bf16_t* O; int ldc;
    __device__ __forceinline__ void operator()(const pg8::f32x4 (&acc)[2][2][4][2], const pg8::Unit& u, int wr, int wc, int fr, int fq) const {
        const int row0 = u.pm * 256 + wr * 64 + fr, col0 = u.pn * 256 + wc * 32 + 8 * fq;
#pragma unroll
        for (int ai = 0; ai < 2; ++ai)
#pragma unroll
            for (int m = 0; m < 4; ++m) { bf16_t* rowp = O + (size_t)(row0 + ai * 128 + m * 16) * ldc + col0;
#pragma unroll
                for (int bj = 0; bj < 2; ++bj) { pg8::f32x4 v0 = acc[ai][bj][m][0], v1 = acc[ai][bj][m][1];
                    if (ACT == 2) {
#pragma unroll
                        for (int e = 0; e < 4; ++e) { float a = fmaxf(v0[e], 0.f); v0[e] = a * a; float b = fmaxf(v1[e], 0.f); v1[e] = b * b; } }
                    u32x4 w; w.x = pg8::cvt_pk_bf16(v0[0], v0[1]); w.y = pg8::cvt_pk_bf16(v0[2], v0[3]); w.z = pg8::cvt_pk_bf16(v1[0], v1[1]); w.w = pg8::cvt_pk_bf16(v1[2], v1[3]);
                    *(u32x4*)(rowp + bj * 128) = w; } }
    }
};
struct EpiF {
    static constexpr bool PERM = false, AFTER_DRAIN = false;
    float* C; int ldc;
    __device__ __forceinline__ void operator()(const pg8::f32x4 (&acc)[2][2][4][2], const pg8::Unit& u, int wr, int wc, int fr, int fq) const {
        const int row0 = u.pm * 256 + wr * 64 + fr, col0 = u.pn * 256 + wc * 32 + 4 * fq;
#pragma unroll
        for (int ai = 0; ai < 2; ++ai)
#pragma unroll
            for (int m = 0; m < 4; ++m) { float* rowp = C + (size_t)(row0 + ai * 128 + m * 16) * ldc + col0;
#pragma unroll
                for (int bj = 0; bj < 2; ++bj)
#pragma unroll
                    for (int n = 0; n < 2; ++n) *(pg8::f32x4*)(rowp + bj * 128 + n * 16) = acc[ai][bj][m][n]; }
    }
};


struct EpiProj0 {
    static constexpr bool PERM = true, AFTER_DRAIN = false;
    bf16_t* P; const float2* rope;
    __device__ __forceinline__ void operator()(const pg8::f32x4 (&acc)[2][2][4][2], const pg8::Unit& u, int wr, int wc, int fr, int fq) const {
        const int pn = u.pn;
        const int b = (u.pm * 256) / S;
        const int m0 = u.pm * 256 + wr * 64 + fr;
#pragma unroll
        for (int ai = 0; ai < 2; ++ai)
#pragma unroll
            for (int mm = 0; mm < 4; ++mm) {
                const int mrow = m0 + ai * 128 + mm * 16; const int s = mrow - b * S; const int t = s >> 6, r = s & 63;
                float x1[8], x2[8];
#pragma unroll
                for (int j = 0; j < 8; ++j) { x1[j] = acc[ai][0][mm][j >> 2][j & 3]; x2[j] = acc[ai][1][mm][j >> 2][j & 3]; }
                if (pn < 6) {
                    const pg8::f32x4* cs = (const pg8::f32x4*)(rope + (size_t)mrow * 32 + 8 * fq);
                    pg8::f32x4 cv[4];
#pragma unroll
                    for (int k = 0; k < 4; ++k) cv[k] = cs[k];
#pragma unroll
                    for (int j = 0; j < 8; ++j) { const float c = cv[j >> 1][(j & 1) * 2], sn = cv[j >> 1][(j & 1) * 2 + 1];
                        const float a = x1[j] * c - x2[j] * sn, bb = x2[j] * c + x1[j] * sn; x1[j] = a; x2[j] = bb; }
                }
                if (pn < 3 || pn == 9) {
#pragma unroll
                    for (int j = 0; j < 8; ++j) { x1[j] *= C2; x2[j] *= C2; }
                }
                u32x4 w1, w2;
                w1.x = pg8::cvt_pk_bf16(x1[0], x1[1]); w1.y = pg8::cvt_pk_bf16(x1[2], x1[3]); w1.z = pg8::cvt_pk_bf16(x1[4], x1[5]); w1.w = pg8::cvt_pk_bf16(x1[6], x1[7]);
                w2.x = pg8::cvt_pk_bf16(x2[0], x2[1]); w2.y = pg8::cvt_pk_bf16(x2[2], x2[3]); w2.z = pg8::cvt_pk_bf16(x2[4], x2[5]); w2.w = pg8::cvt_pk_bf16(x2[6], x2[7]);
                bf16_t *d1, *d2;
                if (pn < 3) { bf16_t* q = P + P0_Q + ((size_t)(b * 12 + 4 * pn + wc) * S + s) * 64 + 8 * fq; d1 = q; d2 = q + 32; }
                else if (pn < 6) { bf16_t* k = P + P0_K + ((((size_t)(b * 12 + 4 * (pn - 3) + wc) * 128 + t) * 8 + fq) * 512 + r * 8); d1 = k; d2 = k + 4 * 512; }
                else if (pn < 9) { const int hsv = 4 * (pn - 6) + wc; bf16_t* v = P + P0_V + (((((size_t)(b * 6 + (hsv >> 1)) * 128 + t) * 4 + 2 * (hsv & 1)) * 64 + r) * 32 + 8 * fq); d1 = v; d2 = v + 64 * 32; }
                else { bf16_t* q = P + P0_QM + ((size_t)(b * 4 + wc) * S + s) * 64 + 8 * fq; d1 = q; d2 = q + 32; }
                *(u32x4*)d1 = w1; *(u32x4*)d2 = w2;
            }
    }
};
__device__ __forceinline__ unsigned pk_f16(float lo, float hi) { typedef float f2 __attribute__((ext_vector_type(2))); typedef _Float16 h2 __attribute__((ext_vector_type(2))); const f2 v = {lo, hi}; return __builtin_bit_cast(unsigned, __builtin_convertvector(v, h2)); }
struct EpiProj1 {
    static constexpr bool PERM = true, AFTER_DRAIN = false;
    bf16_t* P; const float2* rope;
    __device__ __forceinline__ void operator()(const pg8::f32x4 (&acc)[2][2][4][2], const pg8::Unit& u, int wr, int wc, int fr, int fq) const {
        const int pn = u.pn;
        const int b = (u.pm * 256) / S;
        const int m0 = u.pm * 256 + wr * 64 + fr;
        const bool do_rope = (pn < 3) || (pn == 3 && (wc == 0 || wc == 2)) || pn == 4 || pn == 5;
        const bool f16out = (pn == 3 && wc == 2) || pn == 4 || pn == 5;
#pragma unroll
        for (int ai = 0; ai < 2; ++ai)
#pragma unroll
            for (int mm = 0; mm < 4; ++mm) {
                const int mrow = m0 + ai * 128 + mm * 16; const int s = mrow - b * S; const int t = s >> 6, r = s & 63;
                float x1[8], x2[8];
#pragma unroll
                for (int j = 0; j < 8; ++j) { x1[j] = acc[ai][0][mm][j >> 2][j & 3]; x2[j] = acc[ai][1][mm][j >> 2][j & 3]; }
                if (pn == 3 && wc == 3) {
                    if (fq == 0) { float* w = (float*)(P + P1_IW) + (size_t)mrow * 8;
                        *(pg8::f32x4*)w = (pg8::f32x4){x1[0] * IW_SCALE, x1[1] * IW_SCALE, x1[2] * IW_SCALE, x1[3] * IW_SCALE};
                        *(pg8::f32x4*)(w + 4) = (pg8::f32x4){x1[4] * IW_SCALE, x1[5] * IW_SCALE, x1[6] * IW_SCALE, x1[7] * IW_SCALE}; }
                    continue;
                }
                if (do_rope) {
                    const pg8::f32x4* cs = (const pg8::f32x4*)(rope + (size_t)mrow * 32 + 8 * fq);
                    pg8::f32x4 cv[4];
#pragma unroll
                    for (int k = 0; k < 4; ++k) cv[k] = cs[k];
#pragma unroll
                    for (int j = 0; j < 8; ++j) { const float c = cv[j >> 1][(j & 1) * 2], sn = cv[j >> 1][(j & 1) * 2 + 1];
                        const float a = x1[j] * c - x2[j] * sn, bb = x2[j] * c + x1[j] * sn; x1[j] = a; x2[j] = bb; }
                }
                if (pn < 3 || pn == 6) {
#pragma unroll
                    for (int j = 0; j < 8; ++j) { x1[j] *= C2; x2[j] *= C2; }
                }
                u32x4 w1, w2;
                if (f16out) {
                    w1.x = pk_f16(x1[0], x1[1]); w1.y = pk_f16(x1[2], x1[3]); w1.z = pk_f16(x1[4], x1[5]); w1.w = pk_f16(x1[6], x1[7]);
                    w2.x = pk_f16(x2[0], x2[1]); w2.y = pk_f16(x2[2], x2[3]); w2.z = pk_f16(x2[4], x2[5]); w2.w = pk_f16(x2[6], x2[7]);
                } else {
                    w1.x = pg8::cvt_pk_bf16(x1[0], x1[1]); w1.y = pg8::cvt_pk_bf16(x1[2], x1[3]); w1.z = pg8::cvt_pk_bf16(x1[4], x1[5]); w1.w = pg8::cvt_pk_bf16(x1[6], x1[7]);
                    w2.x = pg8::cvt_pk_bf16(x2[0], x2[1]); w2.y = pg8::cvt_pk_bf16(x2[2], x2[3]); w2.z = pg8::cvt_pk_bf16(x2[4], x2[5]); w2.w = pg8::cvt_pk_bf16(x2[6], x2[7]);
                }
                bf16_t *d1, *d2;
                if (pn < 3) { bf16_t* q = P + P1_Q + (size_t)mrow * 768 + (4 * pn + wc) * 64 + 8 * fq; d1 = q; d2 = q + 32; }
                else if (pn == 3) {
                    if (wc == 0) { bf16_t* k = P + P1_K + (size_t)mrow * 64 + 8 * fq; d1 = k; d2 = k + 32; }
                    else if (wc == 1) { bf16_t* v = P + P1_V + (size_t)mrow * 64 + 8 * fq; d1 = v; d2 = v + 32; }
                    else { bf16_t* k = P + P1_IK + ((((size_t)b * 128 + t) * 8 + fq) * 512 + r * 8); d1 = k; d2 = k + 4 * 512; }
                }
                else if (pn < 6) { bf16_t* q = P + P1_IQ + (size_t)mrow * 512 + (4 * (pn - 4) + wc) * 64 + 8 * fq; d1 = q; d2 = q + 32; }
                else { bf16_t* q = P + P1_QM + ((size_t)(b * 4 + wc) * S + s) * 64 + 8 * fq; d1 = q; d2 = q + 32; }
                *(u32x4*)d1 = w1; *(u32x4*)d2 = w2;
            }
    }
};
struct EpiMemKV {
    static constexpr bool PERM = true, AFTER_DRAIN = false;
    bf16_t* P;
    __device__ __forceinline__ void operator()(const pg8::f32x4 (&acc)[2][2][4][2], const pg8::Unit& u, int wr, int wc, int fr, int fq) const {
        const int b = u.pm;
#pragma unroll
        for (int ai = 0; ai < 2; ++ai)
#pragma unroll
            for (int mm = 0; mm < 4; ++mm) {
                const int mt = ai * 128 + wr * 64 + mm * 16 + fr; const int t = mt >> 6, r = mt & 63;
#pragma unroll
                for (int bj = 0; bj < 2; ++bj) {
                    const pg8::f32x4 v0 = acc[ai][bj][mm][0], v1 = acc[ai][bj][mm][1];
                    u32x4 w; w.x = pg8::cvt_pk_bf16(v0[0], v0[1]); w.y = pg8::cvt_pk_bf16(v0[2], v0[3]); w.z = pg8::cvt_pk_bf16(v1[0], v1[1]); w.w = pg8::cvt_pk_bf16(v1[2], v1[3]);
                    bf16_t* dst = (u.pn == 0) ? P + MKV_K + ((((size_t)(b * 4 + wc) * 4 + t) * 8 + 4 * bj + fq) * 512 + r * 8)
                                              : P + MKV_V + (((((size_t)(b * 4 + wc) * 4 + t) * 2 + bj) * 64 + r) * 32 + 8 * fq);
                    *(u32x4*)dst = w;
                }
            }
    }
};

#ifndef FA_DEBUG_SYNC
#define FA_DEBUG_SYNC 0
#endif
namespace fa {
typedef short bf16x8 __attribute__((ext_vector_type(8)));
typedef short s16x4 __attribute__((ext_vector_type(4)));
typedef float f32x16 __attribute__((ext_vector_type(16)));
typedef __attribute__((address_space(3))) const char* lds_cptr;
typedef short v4i16_t __attribute__((ext_vector_type(4)));
__device__ __forceinline__ int crow(int r, int hi) { return (r & 3) + 8 * (r >> 2) + 4 * hi; }
__device__ __forceinline__ void glds16(const void* gsrc, unsigned lds_dst) { unsigned keep;
    asm volatile("s_mov_b32 %0, m0\n\ts_mov_b32 m0, %2\n\ts_nop 0\n\tglobal_load_lds_dwordx4 %1, off\n\ts_mov_b32 m0, %0" : "=&s"(keep) : "v"(gsrc), "s"(lds_dst) : "memory"); }
typedef float f32x2_t __attribute__((ext_vector_type(2))); typedef __bf16 bf16x2_t __attribute__((ext_vector_type(2)));
__device__ __forceinline__ unsigned cvtpk(float lo, float hi) { const f32x2_t v = {lo, hi}; return __builtin_bit_cast(unsigned, __builtin_convertvector(v, bf16x2_t)); }
__device__ __forceinline__ s16x4 vtr(lds_cptr p) { return __builtin_bit_cast(s16x4, __builtin_amdgcn_ds_read_tr16_b64_v4i16((__attribute__((address_space(3))) v4i16_t*)p)); }
__device__ __forceinline__ float swapmax(float m) { auto rr = __builtin_amdgcn_permlane32_swap(__float_as_uint(m), __float_as_uint(m), false, false); return fmaxf(__uint_as_float(rr[0]), __uint_as_float(rr[1])); }
__device__ __forceinline__ float swapsum(float m) { auto rr = __builtin_amdgcn_permlane32_swap(__float_as_uint(m), __float_as_uint(m), false, false); return __uint_as_float(rr[0]) + __uint_as_float(rr[1]); }

template <int NBR, int DV> struct Cfg {
    static constexpr int NVB = DV / 32, VBYTES = 64 * DV * 2, STG = NBR * 8192 + VBYTES, PPW = STG / 8192, ROWS = 256 / NBR;
    static constexpr int NSLOT = 4;
    static constexpr int EXCH_OFF = 65536;
};
struct Unit { const bf16_t* q0; const bf16_t* q1; const bf16_t* k0; const bf16_t* k1; const bf16_t* v; int qrow0; int nt; int same_tile; };

__device__ __forceinline__ void load_k(bf16x8 (&kf)[8], lds_cptr stage, int br, int r32, int hi) {
    const lds_cptr kp = stage + br * 8192 + hi * 1024 + r32 * 16;
#pragma unroll
    for (int d0 = 0; d0 < 4; ++d0) { kf[2 * d0] = *(const __attribute__((address_space(3))) bf16x8*)(kp + d0 * 2048); kf[2 * d0 + 1] = *(const __attribute__((address_space(3))) bf16x8*)(kp + d0 * 2048 + 512); }
}
template <int NVB> __device__ __forceinline__ void load_v(bf16x8 (&vf)[NVB], lds_cptr vp, int ks) {
#pragma unroll
    for (int db = 0; db < NVB; ++db) { const s16x4 lo = vtr(vp + db * 4096 + ks * 1024), hh = vtr(vp + db * 4096 + ks * 1024 + 512);
        vf[db] = (bf16x8){lo[0], lo[1], lo[2], lo[3], hh[0], hh[1], hh[2], hh[3]}; }
}
constexpr float THR = 8.0f;
template <int NBR, int DV> __device__ __forceinline__ void tile_x(lds_cptr stage, const bf16x8 (&kf)[8], const bf16x8 (&qr)[4], f32x16 (&o)[DV / 32], u32x4 (&pw)[4], bf16x8 (&vf0)[DV / 32], float& m, float& l, bool first, int hi, int lane) {
    typedef Cfg<NBR, DV> C;
    f32x16 p0 = (f32x16){}, p1 = (f32x16){};
#pragma unroll
    for (int d0 = 0; d0 < 4; ++d0) {
        p0 = __builtin_amdgcn_mfma_f32_32x32x16_bf16(kf[2 * d0], qr[d0], p0, 0, 0, 0);
        p1 = __builtin_amdgcn_mfma_f32_32x32x16_bf16(kf[2 * d0 + 1], qr[d0], p1, 0, 0, 0);
    }
    const lds_cptr vp = stage + NBR * 8192 + ((lane >> 4) & 1) * 32 + (lane & 3) * 8 + (4 * hi + ((lane & 15) >> 2)) * 64;
    load_v<C::NVB>(vf0, vp, 0);
    __builtin_amdgcn_sched_barrier(0);
#pragma unroll
    for (int r = 0; r < 16; ++r) { p0[r] -= m; p1[r] -= m; }
    float mx = fmaxf(p0[0], p1[0]);
#pragma unroll
    for (int r = 1; r < 16; ++r) mx = fmaxf(mx, fmaxf(p0[r], p1[r]));
    mx = swapmax(mx);
    if (first || __any(mx > THR)) {
        const float dl = first ? mx : fmaxf(mx, 0.f), alpha = __builtin_amdgcn_exp2f(-dl);
        m += dl; l *= alpha;
#pragma unroll
        for (int r = 0; r < 16; ++r) { p0[r] -= dl; p1[r] -= dl; }
#pragma unroll
        for (int db = 0; db < C::NVB; ++db)
#pragma unroll
            for (int r = 0; r < 16; ++r) o[db][r] *= alpha;
    }
    float ls = 0.f;
#pragma unroll
    for (int r = 0; r < 16; ++r) { p0[r] = __builtin_amdgcn_exp2f(p0[r]); p1[r] = __builtin_amdgcn_exp2f(p1[r]); ls += p0[r] + p1[r]; }
    l += ls;
#pragma unroll
    for (int i = 0; i < 4; ++i) { pw[0][i] = cvtpk(p0[2 * i], p0[2 * i + 1]); pw[1][i] = cvtpk(p0[8 + 2 * i], p0[9 + 2 * i]); pw[2][i] = cvtpk(p1[2 * i], p1[2 * i + 1]); pw[3][i] = cvtpk(p1[8 + 2 * i], p1[9 + 2 * i]); }
    __builtin_amdgcn_sched_barrier(0);
}
template <int NBR, int DV> __device__ __forceinline__ void tile_y(lds_cptr stage, lds_cptr stage_next, bool load_next, int br, f32x16 (&o)[DV / 32], const u32x4 (&pw)[4], bf16x8 (&vf0)[DV / 32], bf16x8 (&kf)[8], int r32, int hi, int lane) {
    typedef Cfg<NBR, DV> C;
    const lds_cptr vp = stage + NBR * 8192 + ((lane >> 4) & 1) * 32 + (lane & 3) * 8 + (4 * hi + ((lane & 15) >> 2)) * 64;
    if (load_next) load_k(kf, stage_next, br, r32, hi);
    bf16x8 vf1[C::NVB];
    load_v<C::NVB>(vf1, vp, 1);
    __builtin_amdgcn_sched_barrier(0);
#pragma unroll
    for (int db = 0; db < C::NVB; ++db) o[db] = __builtin_amdgcn_mfma_f32_32x32x16_bf16(vf0[db], __builtin_bit_cast(bf16x8, pw[0]), o[db], 0, 0, 0);
    load_v<C::NVB>(vf0, vp, 2);
    __builtin_amdgcn_sched_barrier(0);
#pragma unroll
    for (int db = 0; db < C::NVB; ++db) o[db] = __builtin_amdgcn_mfma_f32_32x32x16_bf16(vf1[db], __builtin_bit_cast(bf16x8, pw[1]), o[db], 0, 0, 0);
    load_v<C::NVB>(vf1, vp, 3);
    __builtin_amdgcn_sched_barrier(0);
#pragma unroll
    for (int db = 0; db < C::NVB; ++db) o[db] = __builtin_amdgcn_mfma_f32_32x32x16_bf16(vf0[db], __builtin_bit_cast(bf16x8, pw[2]), o[db], 0, 0, 0);
    __builtin_amdgcn_sched_barrier(0);
#pragma unroll
    for (int db = 0; db < C::NVB; ++db) o[db] = __builtin_amdgcn_mfma_f32_32x32x16_bf16(vf1[db], __builtin_bit_cast(bf16x8, pw[3]), o[db], 0, 0, 0);
    __builtin_amdgcn_sched_barrier(0);
}

template <int NBR, int DV> __device__ __forceinline__ void attn_unit(const Unit& U, bool causal, bf16_t* out, int out_row0, int ocol, float lam, const float* gsub, float oscale, LAS unsigned char* lds_) {
    typedef Cfg<NBR, DV> C;
    const int tid = fresh_tid(), lane = tid & 63, r32 = lane & 31, hi = lane >> 5; const int wid = __builtin_amdgcn_readfirstlane(tid >> 6);
    const int br = (NBR == 2) ? (wid >> 2) : 0, rw = (NBR == 2) ? (wid & 3) : wid;
    const lds_cptr lds = (lds_cptr)lds_;
    const unsigned lds0 = (unsigned)(uintptr_t)lds_;
    const int myrow0 = U.qrow0 + 32 * rw;
    const int NT = U.nt, my_nt = causal ? ((myrow0 >> 6) + 1) : NT;
    const int pc0 = wid * C::PPW;
    const char* src; int srcstep;
    if (pc0 < 8 * NBR) { src = (const char*)((pc0 >> 3) ? U.k1 : U.k0) + (pc0 & 7) * 1024; srcstep = 8192; }
    else { src = (const char*)U.v + (pc0 - 8 * NBR) * 1024; srcstep = C::VBYTES; }
    src += lane * 16;
    if (U.same_tile) srcstep = 0;
    const unsigned dst0 = lds0 + pc0 * 1024;
#if FA_DEBUG_SYNC == 2
#define FA_DMA(t, slot) do { _Pragma("unroll") for (int i_ = 0; i_ < C::PPW; ++i_) { const u32x4 v_ = *(const u32x4*)(src + (size_t)(t) * srcstep + i_ * 1024); \
        *(LAS u32x4*)(lds_ + pc0 * 1024 + (slot) * C::STG + i_ * 1024 + lane * 16) = v_; } } while (0)
#else
#define FA_DMA(t, slot) do { _Pragma("unroll") for (int i_ = 0; i_ < C::PPW; ++i_) glds16(src + (size_t)(t) * srcstep + i_ * 1024, (unsigned)__builtin_amdgcn_readfirstlane(dst0 + (slot) * C::STG + i_ * 1024)); } while (0)
#endif
    bf16x8 qr[4];
    FA_DMA(0, 0);
    if (NT > 1) FA_DMA(1, 1);
    if (NT > 2) FA_DMA(2, 2);
    { const bf16_t* qp = (br ? U.q1 : U.q0) + (size_t)(myrow0 + r32) * 64 + hi * 8;
#pragma unroll
      for (int d0 = 0; d0 < 4; ++d0) qr[d0] = *(const bf16x8*)(qp + d0 * 16);
      asm volatile("" : "+v"(qr[0]), "+v"(qr[1]), "+v"(qr[2]), "+v"(qr[3])); }
    f32x16 o[C::NVB];
#pragma unroll
    for (int db = 0; db < C::NVB; ++db) o[db] = (f32x16){};
    float m = 0.f, l = 0.f;
    const bool late = wid >= 4;
    u32x4 pw[4]; bf16x8 kf[8], vf0[C::NVB];
    asm volatile("s_waitcnt vmcnt(0) lgkmcnt(0)" ::: "memory");
    if (late) asm volatile("s_barrier" ::: "memory");
    asm volatile("s_barrier" ::: "memory");
    load_k(kf, lds, br, r32, hi);
#pragma unroll 1
    for (int t = 0; t < NT; ++t) {
        const lds_cptr st = lds + (t & 3) * C::STG;
        if (t < my_nt) tile_x<NBR, DV>(st, kf, qr, o, pw, vf0, m, l, t == 0, hi, lane);
        if (t + 2 < NT) { if (C::PPW == 4) asm volatile("s_waitcnt vmcnt(4) lgkmcnt(0)\n\ts_barrier" ::: "memory"); else asm volatile("s_waitcnt vmcnt(2) lgkmcnt(0)\n\ts_barrier" ::: "memory"); }
        else asm volatile("s_waitcnt vmcnt(0) lgkmcnt(0)\n\ts_barrier" ::: "memory");
        if (t + 3 < NT) FA_DMA(t + 3, (t + 3) & 3);
        if (t < my_nt) tile_y<NBR, DV>(st, lds + ((t + 1) & 3) * C::STG, t + 1 < my_nt, br, o, pw, vf0, kf, r32, hi, lane);
        asm volatile("s_waitcnt lgkmcnt(0)\n\ts_barrier" ::: "memory");
    }
    if (!late) asm volatile("s_barrier" ::: "memory");
#undef FA_DMA
    asm volatile("s_waitcnt vmcnt(0) lgkmcnt(0)\n\ts_barrier" ::: "memory");
    l = swapsum(l);
    if (NBR == 2) {
        LAS float* ex = (LAS float*)(lds_ + C::EXCH_OFF) + rw * 4096 + lane;
        if (br == 1) {
            const float f = lam / l;
#pragma unroll
            for (int db = 0; db < C::NVB; ++db)
#pragma unroll
                for (int r = 0; r < 16; ++r) ex[(db * 16 + r) * 64] = o[db][r] * f;
        }
        asm volatile("s_waitcnt lgkmcnt(0)\n\ts_barrier" ::: "memory");
        if (br == 0) {
            const float il = 1.f / l; float ss = 0.f;
#pragma unroll
            for (int db = 0; db < C::NVB; ++db)
#pragma unroll
                for (int r = 0; r < 16; ++r) { const float v = o[db][r] * il - ex[(db * 16 + r) * 64]; o[db][r] = v; ss += v * v; }
            ss = swapsum(ss);
            const float rstd = oscale / sqrtf(ss * (1.f / (float)DV) + EPS);
            bf16_t* orow = out + (size_t)(out_row0 + myrow0 + r32) * D + ocol + 4 * hi;
#pragma unroll
            for (int db = 0; db < C::NVB; ++db)
#pragma unroll
                for (int g = 0; g < 4; ++g) { const f32x4 gg = *(const f32x4*)(gsub + db * 32 + 8 * g + 4 * hi);
                    uint2 w; w.x = cvtpk(o[db][4 * g] * rstd * gg.x, o[db][4 * g + 1] * rstd * gg.y); w.y = cvtpk(o[db][4 * g + 2] * rstd * gg.z, o[db][4 * g + 3] * rstd * gg.w);
                    *(uint2*)(orow + db * 32 + 8 * g) = w; }
        }
    } else {
        const float il = 1.f / l;
        bf16_t* orow = out + (size_t)(out_row0 + myrow0 + r32) * D + ocol + 4 * hi;
#pragma unroll
        for (int db = 0; db < C::NVB; ++db)
#pragma unroll
            for (int g = 0; g < 4; ++g) { uint2 w; w.x = cvtpk(o[db][4 * g] * il, o[db][4 * g + 1] * il); w.y = cvtpk(o[db][4 * g + 2] * il, o[db][4 * g + 3] * il);
                *(uint2*)(orow + db * 32 + 8 * g) = w; }
    }
    asm volatile("s_waitcnt lgkmcnt(0)\n\ts_barrier" ::: "memory");
}
}

namespace ix {
typedef _Float16 f16x8 __attribute__((ext_vector_type(8)));
typedef float f32x16 __attribute__((ext_vector_type(16)));
constexpr int HROW = 513 * 4;
constexpr int L_HIST = 0, L_BMAP = 0, BROW = 1024;
constexpr int L_ROW = 32 * HROW;
constexpr int POOL = 4096;
constexpr int L_CK = L_ROW + 32 * 32;
constexpr int L_CI = L_CK + POOL * 4;
constexpr int L_END = L_CI + POOL * 2;
static_assert(L_END <= 131072, "indexer LDS map");
constexpr float BIN_K = 2.0f, BIN_OFF = 256.0f;

__device__ __forceinline__ unsigned bin_of(float s, float scale) { const float t = __builtin_fmaf(s, scale, BIN_OFF); return (unsigned)(int)__builtin_amdgcn_fmed3f(t, 0.0f, 511.0f); }
__device__ __forceinline__ unsigned skey(unsigned bits) { return (bits & 0x80000000u) ? ~bits : (bits | 0x80000000u); }

__device__ __forceinline__ void topk_row_exact(int m, const bf16_t* __restrict__ proj, unsigned short* __restrict__ topk, LAS unsigned char* lds) {
    LAS unsigned* keys = (LAS unsigned*)lds;
    LAS float* iqs = (LAS float*)(lds + 32768);
    LAS float* ws = (LAS float*)(lds + 32768 + 2048);
    LAS unsigned* cnt_s = (LAS unsigned*)(lds + 32768 + 2048 + 64);
    LAS unsigned* scan_g = (LAS unsigned*)(lds + 36864);
    LAS unsigned* scan_e = (LAS unsigned*)(lds + 36864 + 2048);
    const int tid = fresh_tid();
    const int b = m / S, t = m % S; const int n = 64 * (t / 64 + 1);
    unsigned short* out = topk + (size_t)m * 256;
    __syncthreads();
    iqs[tid] = (float)((const _Float16*)(proj + P1_IQ))[(size_t)m * 512 + tid];
    if (tid < 8) ws[tid] = ((const float*)(proj + P1_IW))[(size_t)m * 8 + tid];
    __syncthreads();
    for (int j = tid; j < n; j += NTHR) {
        const _Float16* kp = (const _Float16*)(proj + P1_IK) + (((size_t)b * 128 + (j >> 6)) * 8) * 512 + (j & 63) * 8;
        float kf[64];
#pragma unroll
        for (int d = 0; d < 64; ++d) kf[d] = (float)kp[(d >> 3) * 512 + (d & 7)];
        float sc = 0.f;
#pragma unroll 1
        for (int hh = 0; hh < 8; ++hh) { float lg = 0.f;
#pragma unroll
            for (int d = 0; d < 64; ++d) lg += iqs[hh * 64 + d] * kf[d];
            sc += fmaxf(lg, 0.f) * ws[hh]; }
        sc += 0.0f;
        keys[j] = skey(__float_as_uint(sc));
    }
    __syncthreads();
    unsigned T = 0u;
    for (int bit = 31; bit >= 0; --bit) {
        const unsigned cand = T | (1u << bit);
        if (tid == 0) cnt_s[0] = 0u;
        __syncthreads();
        unsigned c0 = 0u;
        for (int j = tid; j < n; j += NTHR) c0 += (keys[j] >= cand) ? 1u : 0u;
        c0 = (unsigned)wave_sum((float)c0);
        if ((tid & 63) == 0) atomicAdd((unsigned*)cnt_s, c0);
        __syncthreads();
        if (cnt_s[0] >= 256u) T = cand;
        __syncthreads();
    }
    const int per = (n + NTHR - 1) / NTHR; const int j0 = tid * per, j1 = (j0 + per < n) ? j0 + per : n;
    unsigned g = 0u, e = 0u;
    for (int j = j0; j < j1; ++j) { const unsigned k = keys[j]; g += (k > T) ? 1u : 0u; e += (k == T) ? 1u : 0u; }
    scan_g[tid] = g; scan_e[tid] = e;
    __syncthreads();
    unsigned pg = 0u, pe = 0u, tg = 0u, te = 0u;
    for (int i = 0; i < NTHR; ++i) { const unsigned gi = scan_g[i], ei = scan_e[i]; if (i < tid) { pg += gi; pe += ei; } tg += gi; te += ei; }
    const unsigned R = 256u - tg;
    unsigned pos = pg + (pe < R ? pe : R), oe = pe;
    for (int j = j0; j < j1; ++j) { const unsigned k = keys[j];
        if (k > T) { out[pos] = (unsigned short)j; ++pos; }
        else if (k == T) { if (oe < R) { out[pos] = (unsigned short)j; ++pos; } ++oe; } }
    __syncthreads();
}

__device__ __forceinline__ void score_tile(f32x4 (&sc)[4], const f16x8 (&kf)[4][2], const f16x8 (&iqf)[8][2], const f16x8 (&cf)[2], const float (&w)[8]) {
#pragma unroll
    for (int blk = 0; blk < 4; ++blk) sc[blk] = __builtin_amdgcn_mfma_f32_16x16x32_f16(kf[blk][0], cf[0], (f32x4){0.f, 0.f, 0.f, 0.f}, 0, 0, 0);
#pragma unroll
    for (int blk = 0; blk < 4; ++blk) sc[blk] = __builtin_amdgcn_mfma_f32_16x16x32_f16(kf[blk][1], cf[1], sc[blk], 0, 0, 0);
#pragma unroll
    for (int h = 0; h < 8; ++h) {
        f32x4 L[4];
#pragma unroll
        for (int blk = 0; blk < 4; ++blk) L[blk] = __builtin_amdgcn_mfma_f32_16x16x32_f16(kf[blk][0], iqf[h][0], (f32x4){0.f, 0.f, 0.f, 0.f}, 0, 0, 0);
#pragma unroll
        for (int blk = 0; blk < 4; ++blk) L[blk] = __builtin_amdgcn_mfma_f32_16x16x32_f16(kf[blk][1], iqf[h][1], L[blk], 0, 0, 0);
#pragma unroll
        for (int blk = 0; blk < 4; ++blk)
#pragma unroll
            for (int r = 0; r < 4; ++r) sc[blk][r] = __builtin_fmaf(__builtin_fabsf(L[blk][r]), w[h], sc[blk][r]);
        asm volatile("" : "+v"(sc[0]), "+v"(sc[1]), "+v"(sc[2]), "+v"(sc[3]));
        __builtin_amdgcn_sched_barrier(0);
    }
}
#define IX_LOADK(dst, t_) do { _Pragma("unroll") for (int blk_ = 0; blk_ < 4; ++blk_) _Pragma("unroll") for (int s_ = 0; s_ < 2; ++s_) dst[blk_][s_] = *(const f16x8*)(ikb + (size_t)(t_) * 8192 + s_ * 4096 + blk_ * 256); } while (0)

__device__ __forceinline__ void topk_unit(int b, int j, const bf16_t* __restrict__ proj, unsigned short* __restrict__ topk, LAS unsigned char* lds, bool force_exact) {
    const int tid = fresh_tid(), lane = tid & 63, q16 = lane & 15, kq = lane >> 4; const int wid = __builtin_amdgcn_readfirstlane(tid >> 6);
    const int qh = wid >> 2, kw = wid & 3, qr = 16 * qh + q16;
    const int row0 = 32 * j, c = row0 >> 6, n = 64 * (c + 1), NT = c + 1;
    const size_t m0 = (size_t)b * S + row0;
    if (n <= 256) {
        for (int i = tid; i < 32 * 256; i += NTHR) { const int k = i & 255; topk[(m0 + (i >> 8)) * 256 + k] = (k < n) ? (unsigned short)k : (unsigned short)0xFFFFu; }
        return;
    }
    if (force_exact) { for (int r = 0; r < 32; ++r) topk_row_exact((int)m0 + r, proj, topk, lds); return; }
    for (int i = tid; i < (32 * HROW) / 4; i += NTHR) ((LAS unsigned*)(lds + L_HIST))[i] = 0u;
    f16x8 iqf[8][2], cf[2]; float w[8]; float bscale;
    {
        const _Float16* iqp = (const _Float16*)(proj + P1_IQ) + (m0 + qr) * 512 + 8 * kq;
#pragma unroll
        for (int h = 0; h < 8; ++h)
#pragma unroll
            for (int s2 = 0; s2 < 2; ++s2) iqf[h][s2] = *(const f16x8*)(iqp + h * 64 + s2 * 32);
        const float* wp = (const float*)(proj + P1_IW) + (m0 + qr) * 8;
        const f32x4 w0 = *(const f32x4*)wp, w1 = *(const f32x4*)(wp + 4);
        w[0] = 0.5f * w0.x; w[1] = 0.5f * w0.y; w[2] = 0.5f * w0.z; w[3] = 0.5f * w0.w; w[4] = 0.5f * w1.x; w[5] = 0.5f * w1.y; w[6] = 0.5f * w1.z; w[7] = 0.5f * w1.w;
        { float ss = 0.f;
#pragma unroll
          for (int h = 0; h < 8; ++h) ss = __builtin_fmaf(w[h], w[h], ss);
          bscale = __builtin_amdgcn_fmed3f(BIN_K * __builtin_amdgcn_rsqf(ss), 0.125f, 65536.0f); }
#pragma unroll
        for (int s2 = 0; s2 < 2; ++s2)
#pragma unroll
            for (int e = 0; e < 8; ++e) { float a = 0.f;
#pragma unroll
                for (int h = 0; h < 8; ++h) a = __builtin_fmaf(w[h], (float)iqf[h][s2][e], a);
                cf[s2][e] = (_Float16)a; }
    }
    const char* ikb = (const char*)((const _Float16*)(proj + P1_IK) + (size_t)b * S * 64) + kq * 1024 + q16 * 16;
    asm volatile("s_waitcnt lgkmcnt(0)\n\ts_barrier" ::: "memory");
#ifndef IX_PROBE
#define IX_PROBE 0
#endif
#pragma unroll 1
    for (int rep = 0; rep < (IX_PROBE ? 2 : 1); ++rep) {
        const unsigned addv = rep ? 0u : 1u; unsigned dummy = 0u;
        LAS unsigned char* hrow = lds + L_HIST + qr * HROW;
        f16x8 kf[4][2], kn[4][2];
        if (kw < NT) IX_LOADK(kn, kw);
#pragma unroll 1
        for (int t = kw; t < NT; t += 4) {
#pragma unroll
            for (int blk = 0; blk < 4; ++blk) { kf[blk][0] = kn[blk][0]; kf[blk][1] = kn[blk][1]; }
            if (t + 4 < NT) IX_LOADK(kn, t + 4);
            __builtin_amdgcn_sched_barrier(0);
            f32x4 sc[4]; score_tile(sc, kf, iqf, cf, w);
            __builtin_amdgcn_sched_barrier(0);
#pragma unroll
            for (int blk = 0; blk < 4; ++blk)
#pragma unroll
                for (int r = 0; r < 4; ++r) { const unsigned bn = bin_of(sc[blk][r], bscale);
                    if (IX_PROBE == 2 && rep) dummy ^= bn; else __hip_atomic_fetch_add((LAS unsigned*)(hrow + bn * 4), addv, __ATOMIC_RELAXED, __HIP_MEMORY_SCOPE_WORKGROUP); }
        }
        if (IX_PROBE == 2 && dummy == 0xFFFFFFFFu) ((LAS unsigned*)(lds + L_ROW))[7] = 0u;
    }
    asm volatile("s_waitcnt lgkmcnt(0)\n\ts_barrier" ::: "memory");
#pragma unroll 1
    for (int rr_ = 0; rr_ < (IX_PROBE == 3 ? 8 : 4); ++rr_) { const int rr = rr_ & 3;
        const int q = 4 * wid + rr;
        const LAS unsigned* hr = (const LAS unsigned*)(lds + L_HIST + q * HROW);
        unsigned cb[8]; unsigned tot = 0u;
#pragma unroll
        for (int i = 0; i < 8; ++i) { cb[i] = hr[511 - 8 * lane - i]; tot += cb[i]; }
        unsigned incl = tot;
#pragma unroll
        for (int o = 1; o < 64; o <<= 1) { const unsigned v = __shfl_up(incl, o); if (lane >= o) incl += v; }
        const unsigned excl = incl - tot;
        const unsigned long long bal = __ballot(incl >= 256u);
        const int L = __builtin_ctzll(bal);
        unsigned run = excl; int tbi = 0; unsigned above = 0u, mcnt = 0u; bool found = false;
#pragma unroll
        for (int i = 0; i < 8; ++i) { if (!found) { if (run + cb[i] >= 256u) { found = true; tbi = 511 - 8 * lane - i; above = run; mcnt = cb[i]; } else run += cb[i]; } }
        const unsigned tb = (unsigned)__shfl(tbi, L), ab = __shfl(above, L), mc = __shfl(mcnt, L);
        if (lane < 8) ((LAS unsigned*)(lds + L_ROW))[8 * q + lane] = (lane == 0) ? tb : (lane == 1) ? ab : (lane == 2) ? mc : 0u;
    }
    asm volatile("s_waitcnt lgkmcnt(0)\n\ts_barrier" ::: "memory");
    for (int i = tid; i < (32 * BROW) / 4; i += NTHR) ((LAS unsigned*)(lds + L_BMAP))[i] = 0u;
    asm volatile("s_waitcnt lgkmcnt(0)\n\ts_barrier" ::: "memory");
    unsigned my_off, my_lim;
    {
        const unsigned Ml = (lane < 32) ? ((const LAS unsigned*)(lds + L_ROW))[8 * (lane & 31) + 2] : 0u;
        unsigned incl = Ml;
#pragma unroll
        for (int o = 1; o < 32; o <<= 1) { const unsigned v = __shfl_up(incl, o); if (lane >= o) incl += v; }
        const bool fits = (incl <= (unsigned)POOL) && (Ml <= 512u);
        const unsigned offl = incl - Ml, liml = fits ? incl : offl;
        if (wid == 0 && lane < 32 && !fits) ((LAS unsigned*)(lds + L_ROW))[8 * lane + 5] = 1u;
        my_off = __shfl(offl, qr); my_lim = __shfl(liml, qr);
        if (wid == 0 && lane < 32) ((LAS unsigned*)(lds + L_ROW))[8 * lane + 3] = offl;
    }
    {
        const unsigned tb = ((const LAS unsigned*)(lds + L_ROW))[8 * qr];
        LAS unsigned char* brow = lds + L_BMAP + qr * BROW;
        LAS unsigned* rcnt = (LAS unsigned*)(lds + L_ROW) + 8 * qr + 4;
        LAS unsigned* ck = (LAS unsigned*)(lds + L_CK); LAS unsigned short* ci = (LAS unsigned short*)(lds + L_CI);
        f16x8 kf[4][2], kn[4][2];
        if (kw < NT) IX_LOADK(kn, kw);
#pragma unroll 1
        for (int t = kw; t < NT; t += 4) {
#pragma unroll
            for (int blk = 0; blk < 4; ++blk) { kf[blk][0] = kn[blk][0]; kf[blk][1] = kn[blk][1]; }
            if (t + 4 < NT) IX_LOADK(kn, t + 4);
            __builtin_amdgcn_sched_barrier(0);
            f32x4 sc[4]; score_tile(sc, kf, iqf, cf, w);
            __builtin_amdgcn_sched_barrier(0);
            unsigned gm[4], em = 0u;
#pragma unroll
            for (int blk = 0; blk < 4; ++blk) { gm[blk] = 0u;
#pragma unroll
                for (int r = 0; r < 4; ++r) { const unsigned bn = bin_of(sc[blk][r], bscale); gm[blk] |= (bn > tb) ? (1u << r) : 0u; em |= (bn == tb) ? (1u << (4 * blk + r)) : 0u; } }
            const unsigned w0 = (gm[0] | (gm[1] << 16)) << (4 * kq), w1 = (gm[2] | (gm[3] << 16)) << (4 * kq);
            if (w0) __hip_atomic_fetch_or((LAS unsigned*)(brow + (2 * t) * 4), w0, __ATOMIC_RELAXED, __HIP_MEMORY_SCOPE_WORKGROUP);
            if (w1) __hip_atomic_fetch_or((LAS unsigned*)(brow + (2 * t + 1) * 4), w1, __ATOMIC_RELAXED, __HIP_MEMORY_SCOPE_WORKGROUP);
            if (__any(em != 0u)) {
                unsigned k = my_off;
                if (em) k += __hip_atomic_fetch_add(rcnt, (unsigned)__builtin_popcount(em), __ATOMIC_RELAXED, __HIP_MEMORY_SCOPE_WORKGROUP);
                const int kbase = 64 * t + 4 * kq;
#pragma unroll
                for (int blk = 0; blk < 4; ++blk)
#pragma unroll
                    for (int r = 0; r < 4; ++r) { if (em & (1u << (4 * blk + r))) { if (k < my_lim) { ck[k] = __float_as_uint(sc[blk][r]); ci[k] = (unsigned short)(kbase + 16 * blk + r); } ++k; } }
            }
        }
    }
    asm volatile("s_waitcnt lgkmcnt(0)\n\ts_barrier" ::: "memory");
#pragma unroll 1
    for (int rr_ = 0; rr_ < (IX_PROBE == 4 ? 8 : 4); ++rr_) { const int rr = rr_ & 3;
        const int q = 4 * wid + rr;
        const LAS unsigned* rw = (const LAS unsigned*)(lds + L_ROW) + 8 * q;
        const unsigned above = rw[1], Mq = rw[2], offq = rw[3]; const bool over = rw[5] != 0u;
        const unsigned R = 256u - above;
        LAS unsigned* bm = (LAS unsigned*)(lds + L_BMAP + q * BROW);
        if (!over) {
            const LAS unsigned* sk = (const LAS unsigned*)(lds + L_CK) + offq;
            const LAS unsigned short* si = (const LAS unsigned short*)(lds + L_CI) + offq;
            if (Mq <= 64u) {
                const bool vd = (unsigned)lane < Mq; const unsigned ee = vd ? lane : 0u;
                const unsigned ky = skey(sk[ee]), ixx = si[ee]; unsigned rk = 0u;
#pragma unroll 4
                for (unsigned e = 0; e < Mq; ++e) { const unsigned kj = skey(sk[e]), ij = si[e]; rk += ((kj > ky) || (kj == ky && ij < ixx)) ? 1u : 0u; }
                if (vd && rk < R) __hip_atomic_fetch_or(bm + (ixx >> 5), 1u << (ixx & 31), __ATOMIC_RELAXED, __HIP_MEMORY_SCOPE_WORKGROUP);
            } else {
                unsigned ky[8], ixx[8], rk[8]; bool vd[8];
#pragma unroll
                for (int k = 0; k < 8; ++k) { const unsigned e = lane + 64 * k; vd[k] = e < Mq; const unsigned ee = vd[k] ? e : 0u; ky[k] = skey(sk[ee]); ixx[k] = si[ee]; rk[k] = 0u; }
#pragma unroll 1
                for (unsigned e = 0; e < Mq; ++e) { const unsigned kj = skey(sk[e]), ij = si[e];
#pragma unroll
                    for (int k = 0; k < 8; ++k) rk[k] += ((kj > ky[k]) || (kj == ky[k] && ij < ixx[k])) ? 1u : 0u; }
#pragma unroll
                for (int k = 0; k < 8; ++k) if (vd[k] && rk[k] < R) __hip_atomic_fetch_or(bm + (ixx[k] >> 5), 1u << (ixx[k] & 31), __ATOMIC_RELAXED, __HIP_MEMORY_SCOPE_WORKGROUP);
            }
        }
        asm volatile("s_waitcnt lgkmcnt(0)" ::: "memory");
        const u32x4 wv = *(const LAS u32x4*)(bm + 4 * lane);
        unsigned wd[4] = {wv.x, wv.y, wv.z, wv.w};
        const unsigned pc = __builtin_popcount(wd[0]) + __builtin_popcount(wd[1]) + __builtin_popcount(wd[2]) + __builtin_popcount(wd[3]);
        unsigned incl = pc;
#pragma unroll
        for (int o = 1; o < 64; o <<= 1) { const unsigned v = __shfl_up(incl, o); if (lane >= o) incl += v; }
        unsigned pos = incl - pc;
        unsigned short* out = topk + (m0 + q) * 256;
        if (!over) {
#pragma unroll
            for (int i = 0; i < 4; ++i) { unsigned x = wd[i]; while (x) { const int bpos = __builtin_ctz(x); if (pos < 256u) out[pos] = (unsigned short)(128 * lane + 32 * i + bpos); ++pos; x &= x - 1u; } }
        }
    }
    asm volatile("s_waitcnt vmcnt(0) lgkmcnt(0)\n\ts_barrier" ::: "memory");
    {
        const bool anyf = __any(((const LAS unsigned*)(lds + L_ROW))[8 * (lane & 31) + 5] != 0u);
        if (anyf) {
            __syncthreads();
#pragma unroll 1
            for (int r = 0; r < 32; ++r) { const unsigned f = ((const LAS unsigned*)(lds + L_ROW))[8 * r + 5]; if (f && IX_PROBE != 6) { topk_row_exact((int)m0 + r, proj, topk, lds); if (IX_PROBE == 5) topk_row_exact((int)m0 + r, proj, topk, lds); } }
        }
        __syncthreads();
    }
}

__device__ __forceinline__ void ph_topk(const bf16_t* proj, unsigned short* topk, LAS unsigned char* lds, bool force_exact) {
    const int G = (int)gridDim.x, bid = (int)blockIdx.x;
    if (G == 256) {
        const int b = bid & 7, idx = bid >> 3;
#pragma unroll 1
        for (int i = 0; i < 8; ++i) { const int j = (i & 1) ? 64 * (i >> 1) + 63 - idx : 64 * (i >> 1) + idx; topk_unit(b, j, proj, topk, lds, force_exact); }
    } else {
        for (int u = bid; u < NB * 256; u += G) topk_unit(u >> 8, u & 255, proj, topk, lds, force_exact);
    }
}
}

namespace sa {
typedef short bf16x8 __attribute__((ext_vector_type(8)));
typedef short s16x4 __attribute__((ext_vector_type(4)));
typedef short v4i16_t __attribute__((ext_vector_type(4)));
typedef unsigned u32x2 __attribute__((ext_vector_type(2)));
typedef __attribute__((address_space(3))) const char* lds_cptr;
constexpr int VROW = 144, WLDS = 512 + 64 * VROW;
static_assert(8 * WLDS <= 131072, "sparse attention LDS");
__device__ __forceinline__ s16x4 vtr(lds_cptr p) { return __builtin_bit_cast(s16x4, __builtin_amdgcn_ds_read_tr16_b64_v4i16((__attribute__((address_space(3))) v4i16_t*)p)); }
__device__ __forceinline__ unsigned pk(float lo, float hi) { typedef float f2 __attribute__((ext_vector_type(2))); typedef __bf16 b2 __attribute__((ext_vector_type(2))); const f2 v = {lo, hi}; return __builtin_bit_cast(unsigned, __builtin_convertvector(v, b2)); }
__device__ __forceinline__ float xmax(float v) { v = fmaxf(v, __shfl_xor(v, 16)); return fmaxf(v, __shfl_xor(v, 32)); }
__device__ __forceinline__ float xsum(float v) { v += __shfl_xor(v, 16); return v + __shfl_xor(v, 32); }

__device__ __forceinline__ void query(int m, int b, int nvalid, const bf16_t* __restrict__ P, const unsigned short* __restrict__ topk, bf16_t* __restrict__ O, LAS unsigned char* wl, int lane) {
    const int ks = lane & 15, kq = lane >> 4;
    LAS unsigned short* idxs = (LAS unsigned short*)wl; LAS unsigned char* vst = wl + 512;
    { u32x2 iv = *(const u32x2*)(topk + (size_t)m * 256 + 4 * lane);
      if ((iv.x & 0xFFFFu) == 0xFFFFu) iv.x &= 0xFFFF0000u; if ((iv.x >> 16) == 0xFFFFu) iv.x &= 0x0000FFFFu;
      if ((iv.y & 0xFFFFu) == 0xFFFFu) iv.y &= 0xFFFF0000u; if ((iv.y >> 16) == 0xFFFFu) iv.y &= 0x0000FFFFu;
      *(LAS u32x2*)(idxs + 4 * lane) = iv; }
    const bf16_t* qp = P + P1_Q + (size_t)m * 768 + (ks < 12 ? ks : 11) * 64 + 8 * kq;
    const bf16x8 q0 = *(const bf16x8*)qp, q1 = *(const bf16x8*)(qp + 32);
    const u32x4 ia = *(const LAS u32x4*)(idxs + 16 * ks), ib = *(const LAS u32x4*)(idxs + 16 * ks + 8);
    const unsigned iw[8] = {ia.x, ia.y, ia.z, ia.w, ib.x, ib.y, ib.z, ib.w};
    const bf16_t* Kb = P + P1_K + (size_t)b * S * 64 + 8 * kq;
    const bf16_t* Vb = P + P1_V + (size_t)b * S * 64 + 8 * (lane & 7);
    f32x4 Sx[16];
#pragma unroll
    for (int gb = 0; gb < 4; ++gb) {
        bf16x8 ka[4], kb[4];
#pragma unroll
        for (int gg = 0; gg < 4; ++gg) { const int g = 4 * gb + gg; const unsigned id = (g & 1) ? (iw[g >> 1] >> 16) : (iw[g >> 1] & 0xFFFFu);
            const bf16_t* kp = Kb + (size_t)id * 64; ka[gg] = *(const bf16x8*)kp; kb[gg] = *(const bf16x8*)(kp + 32); }
#pragma unroll
        for (int gg = 0; gg < 4; ++gg) { const int g = 4 * gb + gg;
            Sx[g] = __builtin_amdgcn_mfma_f32_16x16x32_bf16(ka[gg], q0, (f32x4){0.f, 0.f, 0.f, 0.f}, 0, 0, 0);
            Sx[g] = __builtin_amdgcn_mfma_f32_16x16x32_bf16(kb[gg], q1, Sx[g], 0, 0, 0); }
    }
    float mx = -INFINITY;
#pragma unroll
    for (int g = 0; g < 16; ++g)
#pragma unroll
        for (int r = 0; r < 4; ++r) { if (64 * kq + 16 * r + g >= nvalid) Sx[g][r] = -INFINITY; mx = fmaxf(mx, Sx[g][r]); }
    mx = xmax(mx);
    float sum = 0.f;
#pragma unroll
    for (int g = 0; g < 16; ++g)
#pragma unroll
        for (int r = 0; r < 4; ++r) { Sx[g][r] = __builtin_amdgcn_exp2f(Sx[g][r] - mx); sum += Sx[g][r]; }
    sum = xsum(sum);
    f32x4 o[4];
#pragma unroll
    for (int n = 0; n < 4; ++n) o[n] = (f32x4){0.f, 0.f, 0.f, 0.f};
    const lds_cptr vrd = (lds_cptr)vst + (4 * kq + ((lane & 15) >> 2)) * VROW + (lane & 3) * 8;
#pragma unroll
    for (int vb = 0; vb < 4; ++vb) {
        u32x4 vv[8];
#pragma unroll
        for (int i = 0; i < 8; ++i) { const int g = 4 * vb + (i >> 1); const unsigned id = idxs[16 * (8 * (i & 1) + (lane >> 3)) + g]; vv[i] = *(const u32x4*)(Vb + (size_t)id * 64); }
#pragma unroll
        for (int i = 0; i < 8; ++i) *(LAS u32x4*)(vst + (8 * i + (lane >> 3)) * VROW + (lane & 7) * 16) = vv[i];
#pragma unroll
        for (int Gl = 0; Gl < 2; ++Gl) {
            const int G2 = 2 * vb + Gl;
            u32x4 pw; pw.x = pk(Sx[2 * G2][0], Sx[2 * G2][1]); pw.y = pk(Sx[2 * G2][2], Sx[2 * G2][3]); pw.z = pk(Sx[2 * G2 + 1][0], Sx[2 * G2 + 1][1]); pw.w = pk(Sx[2 * G2 + 1][2], Sx[2 * G2 + 1][3]);
#pragma unroll
            for (int n = 0; n < 4; ++n) {
                const s16x4 lo = vtr(vrd + (32 * Gl) * VROW + n * 32), hh = vtr(vrd + (32 * Gl + 16) * VROW + n * 32);
                const bf16x8 vf = (bf16x8){lo[0], lo[1], lo[2], lo[3], hh[0], hh[1], hh[2], hh[3]};
                o[n] = __builtin_amdgcn_mfma_f32_16x16x32_bf16(vf, __builtin_bit_cast(bf16x8, pw), o[n], 0, 0, 0);
            }
        }
    }
    if (ks < 12) {
        const float il = 1.f / sum;
        bf16_t* op = O + (size_t)m * D + ks * 64 + 4 * kq;
#pragma unroll
        for (int n = 0; n < 4; ++n) { u32x2 w; w.x = pk(o[n][0] * il, o[n][1] * il); w.y = pk(o[n][2] * il, o[n][3] * il); *(u32x2*)(op + 16 * n) = w; }
    }
}

__device__ __forceinline__ void ph_dsa_attn(const bf16_t* P, const unsigned short* topk, bf16_t* O, LAS unsigned char* lds) {
    const int tid = fresh_tid(), lane = tid & 63; const int wid = __builtin_amdgcn_readfirstlane(tid >> 6);
    LAS unsigned char* wl = lds + wid * WLDS;
    const int G = (int)gridDim.x, bid = (int)blockIdx.x;
    if (G == 256) {
        const int b = bid & 7, w0 = (bid >> 3) * 8 + wid;
#pragma unroll 1
        for (int i = 0; i < 32; ++i) { const int t = w0 + 256 * i; const int nv = 64 * (t / 64 + 1); query(b * S + t, b, nv < 256 ? nv : 256, P, topk, O, wl, lane); }
    } else {
        for (int m = bid * NWAVES + wid; m < M; m += G * NWAVES) { const int t = m % S; const int nv = 64 * (t / 64 + 1); query(m, m / S, nv < 256 ? nv : 256, P, topk, O, wl, lane); }
    }
}
}

constexpr int RING_BYTES = 131072, LDSCTL_OFF = RING_BYTES, LDS_BYTES = 147456;
constexpr size_t CTL_ZERO_BYTES = 1 * MiB;
constexpr int CW_TMO = 0, CW_BAR = 4096;

struct Args { const void* in[19]; float* out; unsigned char* ws; };

#define FRESH_IDS const int tid = fresh_tid(), lane = tid & 63, wave = __builtin_amdgcn_readfirstlane(tid >> 6); (void)lane; (void)wave
#define GSTRIDE_WAVES(gw, NGW) const int gw = (int)blockIdx.x * NWAVES + wave, NGW = (int)gridDim.x * NWAVES

__device__ __forceinline__ int src_col(int p, int N, int mode) {
    if (mode == 0) return (p < N) ? p : -1;
    const int tile = p >> 8, wc = (p >> 5) & 3, d = 32 * ((p >> 7) & 1) + (p & 31);
    if (mode == 1) return tile * 256 + 64 * wc + d;
    if (tile < 3) return DQ + 64 * (4 * tile + wc) + d;
    if (tile == 3) return wc == 0 ? DK + d : wc == 1 ? DV + d : wc == 2 ? DIK + d : (d < 8 ? DIW + d : -1);
    if (tile < 6) return DIQ + 64 * (4 * (tile - 4) + wc) + d;
    return DQM + 64 * wc + d;
}
__device__ __forceinline__ void prep_item(const float* __restrict__ W, int K, int N, bf16_t* __restrict__ Wt, int Nout, int mode, LAS float* scr, int item, int lane) {
    const int nblk = Nout / 32, kb = item / nblk, nb = item % nblk, k0 = 64 * kb, p0 = 32 * nb;
    const int p = src_col(p0 + (lane & 31), N, mode);
#pragma unroll 8
    for (int i = 0; i < 32; ++i) { const int kk = 2 * i + (lane >> 5); scr[kk * 33 + (lane & 31)] = (p >= 0) ? W[(size_t)(k0 + kk) * N + p] : 0.f; }
    LDS_WAIT(); asm volatile("" ::: "memory");
    const int c = lane & 7;
#pragma unroll
    for (int j = 0; j < 4; ++j) { const int n = (lane >> 3) + 8 * j; const LAS float* s = scr + (8 * c) * 33 + n;
        u32x4 o; o.x = pk2(s[0 * 33], s[1 * 33]); o.y = pk2(s[2 * 33], s[3 * 33]); o.z = pk2(s[4 * 33], s[5 * 33]); o.w = pk2(s[6 * 33], s[7 * 33]);
        *(u32x4*)(Wt + (size_t)(p0 + n) * K + k0 + 8 * c) = o; }
    LDS_WAIT(); asm volatile("" ::: "memory");
}
__device__ __forceinline__ void prep_matrix(const float* W, int K, int N, bf16_t* Wt, int Nout, int mode, LAS float* scr, int gw, int NGW, int lane) {
    const int nitems = (K / 64) * (Nout / 32);
    for (int it = gw; it < nitems; it += NGW) prep_item(W, K, N, Wt, Nout, mode, scr, it, lane);
}
__device__ __forceinline__ void rms_row_bf16(const float* xrow, const float* g, bf16_t* orow, int lane) {
    const f32x4* xr = (const f32x4*)xrow + lane; const f32x4* gr = (const f32x4*)g + lane;
    f32x4 v[4]; float s = 0.f;
#pragma unroll
    for (int j = 0; j < 4; ++j) { v[j] = xr[64 * j]; s += (v[j].x * v[j].x + v[j].y * v[j].y) + (v[j].z * v[j].z + v[j].w * v[j].w); }
    const float rstd = 1.f / sqrtf(wave_sum(s) * (1.f / D) + EPS);
    unsigned long long* o8 = (unsigned long long*)orow + lane;
#pragma unroll
    for (int j = 0; j < 4; ++j) { const f32x4 gg = gr[64 * j];
        o8[64 * j] = (unsigned long long)pk2(v[j].x * rstd * gg.x, v[j].y * rstd * gg.y) | ((unsigned long long)pk2(v[j].z * rstd * gg.z, v[j].w * rstd * gg.w) << 32); }
}
__device__ __forceinline__ f32x4 ld4(const float* p) { return *(const f32x4*)p; }
__device__ __forceinline__ f32x4 ld4(const bf16_t* p) { const unsigned long long u = *(const unsigned long long*)p; return (f32x4){__uint_as_float((unsigned)u << 16), __uint_as_float((unsigned)u & 0xFFFF0000u), __uint_as_float((unsigned)(u >> 32) << 16), __uint_as_float((unsigned)(u >> 32) & 0xFFFF0000u)}; }
__device__ __forceinline__ void st4(float* p, f32x4 v) { *(f32x4*)p = v; }
__device__ __forceinline__ void st4(bf16_t* p, f32x4 v) { *(unsigned long long*)p = (unsigned long long)pk2(v.x, v.y) | ((unsigned long long)pk2(v.z, v.w) << 32); }
template <class TI, class TO> __device__ __forceinline__ void norm_res_row(const bf16_t* yrow, const TI* xin, const float* g1, TO* xout, const float* g2, bf16_t* hrow, int lane) {
    f32x4 v[4], xv[4]; float s = 0.f;
#pragma unroll
    for (int j = 0; j < 4; ++j) { v[j] = ld4(yrow + 4 * lane + 256 * j); xv[j] = ld4(xin + 4 * lane + 256 * j); s += (v[j].x * v[j].x + v[j].y * v[j].y) + (v[j].z * v[j].z + v[j].w * v[j].w); }
    const float rstd = 1.f / sqrtf(wave_sum(s) * (1.f / D) + EPS);
    float s2 = 0.f;
#pragma unroll
    for (int j = 0; j < 4; ++j) { const f32x4 gg = ((const f32x4*)g1 + lane)[64 * j]; xv[j] = xv[j] + v[j] * rstd * gg;
        s2 += (xv[j].x * xv[j].x + xv[j].y * xv[j].y) + (xv[j].z * xv[j].z + xv[j].w * xv[j].w);
        st4(xout + 4 * lane + 256 * j, xv[j]); }
    if (g2) {
        const float r2 = 1.f / sqrtf(wave_sum(s2) * (1.f / D) + EPS);
#pragma unroll
        for (int j = 0; j < 4; ++j) { const f32x4 gg = ((const f32x4*)g2 + lane)[64 * j]; st4(hrow + 4 * lane + 256 * j, (f32x4){xv[j].x * r2 * gg.x, xv[j].y * r2 * gg.y, xv[j].z * r2 * gg.z, xv[j].w * r2 * gg.w}); }
    }
}
template <class TI, class TO> __device__ __forceinline__ void ph_norm_res(const bf16_t* Y, const TI* xin, const float* g1, TO* xout, const float* g2, bf16_t* H, int wave, int lane) {
    GSTRIDE_WAVES(gw, NGW);
    for (int m = gw; m < M; m += NGW) norm_res_row(Y + (size_t)m * D, xin + (size_t)m * D, g1, xout + (size_t)m * D, g2, H + (size_t)m * D, lane);
}
__device__ __forceinline__ void ph_attn_diff(const bf16_t* P, bf16_t* O, const float* lq1, const float* lk1, const float* lq2, const float* lk2, const float* gsub, LAS unsigned char* lds, int same_tile = 0) {
    float a1 = 0.f, a2 = 0.f;
    for (int i = 0; i < 64; ++i) { a1 += lq1[i] * lk1[i]; a2 += lq2[i] * lk2[i]; }
    const float lam = expf(a1) - expf(a2) + 0.2f;
    const int G = (int)gridDim.x, bid = (int)blockIdx.x; const int vcu = (G % 8 == 0) ? (bid % 8) * (G / 8) + bid / 8 : bid;
    for (int i = 0; ; ++i) {
        const int pu = vcu + (i >> 1) * G; if (pu >= NB * 6 * 32) break;
        const int bh = pu >> 5, pair = pu & 31, b = bh / 6, h = bh % 6; const int qblk = (i & 1) ? pair : 63 - pair;
        fa::Unit U;
        U.q0 = P + P0_Q + (size_t)(b * 12 + 2 * h) * S * 64; U.q1 = U.q0 + (size_t)S * 64;
        U.k0 = P + P0_K + (size_t)(b * 12 + 2 * h) * S * 64; U.k1 = U.k0 + (size_t)S * 64;
        U.v = P + P0_V + (size_t)(b * 6 + h) * S * 128; U.qrow0 = qblk * 128; U.nt = 2 * qblk + 2; U.same_tile = same_tile;
        fa::attn_unit<2, 128>(U, true, O, b * S, h * 128, lam, gsub, 0.8f, lds);
    }
}
__device__ __forceinline__ void ph_attn_mem(const bf16_t* QM, const bf16_t* kv, bf16_t* O, LAS unsigned char* lds) {
    for (int u = (int)blockIdx.x; u < NB * 4 * (S / 256); u += (int)gridDim.x) {
        const int b = u >> 7, mh = (u >> 5) & 3, qb = u & 31;
        fa::Unit U;
        U.q0 = QM + (size_t)(b * 4 + mh) * S * 64; U.q1 = U.q0;
        U.k0 = kv + MKV_K + (size_t)(b * 4 + mh) * NMEMT * 64; U.k1 = U.k0;
        U.v = kv + MKV_V + (size_t)(b * 4 + mh) * NMEMT * 64; U.qrow0 = qb * 256; U.nt = 4; U.same_tile = 0;
        fa::attn_unit<1, 64>(U, false, O, b * S, 768 + mh * 64, 0.f, nullptr, 1.f, lds);
    }
}

#ifndef DUP_MASK
#define DUP_MASK 0
#endif
#define REP(k, ...) do { __VA_ARGS__; if ((DUP_MASK >> (k)) & 1) { __VA_ARGS__; } } while (0)
#ifndef IX_FORCE_EXACT
#define IX_FORCE_EXACT 0
#endif
#define GEMM_PHASE(EPI, Aptr, Bptr, Mr, Nn, Kk, ...) do { pg8::Gemm g_{(Aptr), (Bptr), (Mr), (Nn), (Kk)}; pg8::StaticOrder S_; S_.init((Mr), (Nn), (int)gridDim.x, (int)blockIdx.x); \
    EPI E_{__VA_ARGS__}; pg8::gemm_phase<EPI, pg8::StaticOrder, true, true>(lds, g_, S_, E_); } while (0)

__global__ void __launch_bounds__(NTHR, 2) mk_fwd(Args args) {
    extern __shared__ __attribute__((aligned(16))) unsigned char lds_raw[];
    LAS unsigned char* lds = (LAS unsigned char*)lds_raw;
    unsigned char* ws = args.ws; float* out = args.out;
    const float* x = (const float*)args.in[0]; const float* mem = (const float*)args.in[1]; const int* pos = (const int*)args.in[2];
    const float* g_pre_mix = (const float*)args.in[3]; const float* g_post_mix = (const float*)args.in[4]; const float* g_mem = (const float*)args.in[5];
    const float* w_mem_kv = (const float*)args.in[6]; const float* w_out = (const float*)args.in[7]; const float* g_pre_mlp = (const float*)args.in[8];
    const float* g_post_mlp = (const float*)args.in[9]; const float* w_up = (const float*)args.in[10]; const float* w_dn = (const float*)args.in[11];
    const float* w_in_diff = (const float*)args.in[12]; const float* lq1 = (const float*)args.in[13]; const float* lk1 = (const float*)args.in[14];
    const float* lq2 = (const float*)args.in[15]; const float* lk2 = (const float*)args.in[16]; const float* gsub = (const float*)args.in[17]; const float* w_in_dsa = (const float*)args.in[18];
    bf16_t* Win0 = (bf16_t*)(ws + WS_WIN0); bf16_t* Win1 = (bf16_t*)(ws + WS_WIN1); bf16_t* Wout = (bf16_t*)(ws + WS_WOUT);
    bf16_t* Wup = (bf16_t*)(ws + WS_WUP); bf16_t* Wdn = (bf16_t*)(ws + WS_WDN); bf16_t* Wkv = (bf16_t*)(ws + WS_WKV);
    bf16_t* memn = (bf16_t*)(ws + WS_MEMN); bf16_t* memkv = (bf16_t*)(ws + WS_MEMKV); float2* rope = (float2*)(ws + WS_ROPE);
    unsigned short* topk = (unsigned short*)(ws + WS_TOPK); bf16_t* H = (bf16_t*)(ws + WS_H); bf16_t* proj = (bf16_t*)(ws + WS_PROJ);
    bf16_t* O = (bf16_t*)(ws + WS_O); bf16_t* hid = (bf16_t*)(ws + WS_HID); bf16_t* Y = (bf16_t*)(ws + WS_Y); bf16_t* X16 = (bf16_t*)(ws + WS_Y + 128 * MiB);
    gu32* ctl = (gu32*)(ws + WS_CTL);

    for (int u = threadIdx.x; u < (LDS_BYTES - LDSCTL_OFF) / 4; u += NTHR) ((LAS unsigned*)(lds + LDSCTL_OFF))[u] = 0u;
    __syncthreads();
    XcdBarrier bar = xcd_barrier_post((unsigned*)(ctl + CW_BAR), (volatile LAS unsigned*)(lds + LDSCTL_OFF + 64));
#define GRID_BAR() xcd_barrier(bar)

    for (int rep0 = 0; rep0 < 1 + ((DUP_MASK >> 0) & 1); ++rep0) {
        FRESH_IDS;
        LAS float* scr = (LAS float*)(lds + wave * 16384);
        GSTRIDE_WAVES(gw, NGW);
        prep_matrix(w_in_diff, D, NDIFF, Win0, NDIFF, 1, scr, gw, NGW, lane);
        prep_matrix(w_in_dsa, D, NDSA_L, Win1, NDSA, 2, scr, gw, NGW, lane);
#pragma unroll 1
        for (int l = 0; l < 2; ++l) {
            prep_matrix(w_out + (size_t)l * D * D, D, D, Wout + (size_t)l * D * D, D, 0, scr, gw, NGW, lane);
            prep_matrix(w_up + (size_t)l * D * FF, D, FF, Wup + (size_t)l * D * FF, FF, 0, scr, gw, NGW, lane);
            prep_matrix(w_dn + (size_t)l * D * FF, FF, D, Wdn + (size_t)l * D * FF, D, 0, scr, gw, NGW, lane);
            prep_matrix(w_mem_kv + (size_t)l * D * 512, D, 512, Wkv + (size_t)l * D * 512, 512, 1, scr, gw, NGW, lane);
            for (int m = gw; m < NB * NMEMT; m += NGW) rms_row_bf16(mem + (size_t)m * D, g_mem + l * D, memn + ((size_t)l * NB * NMEMT + m) * D, lane);
        }
        for (int idx = (int)blockIdx.x * NTHR + tid; idx < M * 32; idx += (int)gridDim.x * NTHR) {
            const int m = idx >> 5, i = idx & 31;
            const double inv = pow(10000.0, -(double)i / 32.0); const double ang = (double)pos[m] * inv;
            rope[idx] = make_float2((float)cos(ang), (float)sin(ang));
        }
        for (int m = gw; m < M; m += NGW) rms_row_bf16(x + (size_t)m * D, g_pre_mix, H + (size_t)m * D, lane);
    }
    GRID_BAR();
    REP(1, GEMM_PHASE(EpiMemKV, memn, Wkv, NB * NMEMT, 512, D, memkv);
           GEMM_PHASE(EpiMemKV, memn + (size_t)NB * NMEMT * D, Wkv + (size_t)D * 512, NB * NMEMT, 512, D, memkv + MKV_LAYER);
           GEMM_PHASE(EpiProj0, H, Win0, M, NDIFF, D, proj, rope));
    GRID_BAR();
    REP(2, ph_attn_diff(proj, O, lq1, lk1, lq2, lk2, gsub, lds));
    if ((DUP_MASK >> 14) & 1) ph_attn_diff(proj, Y, lq1, lk1, lq2, lk2, gsub, lds, 1);
    REP(3, ph_attn_mem(proj + P0_QM, memkv, O, lds));
    GRID_BAR();
    REP(4, GEMM_PHASE(EpiB<0>, O, Wout, M, D, D, Y, D));
    GRID_BAR();
    { FRESH_IDS; ph_norm_res(Y, x, g_post_mix, X16, g_pre_mlp, H, wave, lane); }
    GRID_BAR();
    REP(5, GEMM_PHASE(EpiB<2>, H, Wup, M, FF, D, hid, FF));
    GRID_BAR();
    REP(6, GEMM_PHASE(EpiB<0>, hid, Wdn, M, D, FF, Y, D));
    GRID_BAR();
    { FRESH_IDS; ph_norm_res(Y, X16, g_post_mlp, X16, g_pre_mix + D, H, wave, lane); }
    GRID_BAR();
    REP(7, GEMM_PHASE(EpiProj1, H, Win1, M, NDSA, D, proj, rope));
    GRID_BAR();
    REP(8, ix::ph_topk(proj, topk, lds, IX_FORCE_EXACT != 0));
    GRID_BAR();
    REP(9, sa::ph_dsa_attn(proj, topk, O, lds); __syncthreads());
    REP(3, ph_attn_mem(proj + P1_QM, memkv + MKV_LAYER, O, lds));
    GRID_BAR();
    GEMM_PHASE(EpiB<0>, O, Wout + (size_t)D * D, M, D, D, Y, D);
    GRID_BAR();
    { FRESH_IDS; ph_norm_res(Y, X16, g_post_mix + D, X16, g_pre_mlp + D, H, wave, lane); }
    GRID_BAR();
    GEMM_PHASE(EpiB<2>, H, Wup + (size_t)D * FF, M, FF, D, hid, FF);
    GRID_BAR();
    GEMM_PHASE(EpiB<0>, hid, Wdn + (size_t)D * FF, M, D, FF, Y, D);
    GRID_BAR();
    { FRESH_IDS; ph_norm_res(Y, X16, g_post_mlp + D, out, (const float*)nullptr, H, wave, lane); }
}

extern "C" void kernel_launch(void* const* d_in, const int* in_sizes, int n_in, void* d_out, int out_size, void* d_ws, size_t ws_size, hipStream_t stream) {
    static int grid = 0;
    if (grid == 0) {
        if (n_in != 19 || out_size != M * D || ws_size < WS_END) { fprintf(stderr, "kernel_launch: unexpected shapes n_in %d out %d ws %zu\n", n_in, out_size, ws_size); grid = -1; return; }
        int dev = 0, cus = 0, per_cu = 0;
        if (hipGetDevice(&dev) != hipSuccess || hipDeviceGetAttribute(&cus, hipDeviceAttributeMultiprocessorCount, dev) != hipSuccess) { grid = -1; return; }
        if (hipFuncSetAttribute((const void*)mk_fwd, hipFuncAttributeMaxDynamicSharedMemorySize, LDS_BYTES) != hipSuccess) { fprintf(stderr, "kernel_launch: hipFuncSetAttribute failed\n"); grid = -1; return; }
        if (hipOccupancyMaxActiveBlocksPerMultiprocessor(&per_cu, (const void*)mk_fwd, NTHR, LDS_BYTES) != hipSuccess || per_cu < 1) { fprintf(stderr, "kernel_launch: occupancy query says %d blocks per CU\n", per_cu); grid = -1; (void)hipGetLastError(); return; }
        grid = cus;
    }
    if (grid < 0) return;
    (void)hipMemsetAsync((char*)d_ws + WS_CTL, 0, CTL_ZERO_BYTES, stream);
    Args a; memset(&a, 0, sizeof(a));
    for (int i = 0; i < 19; ++i) a.in[i] = d_in[i];
    a.out = (float*)d_out; a.ws = (unsigned char*)d_ws;
    hipLaunchKernelGGL(mk_fwd, dim3(grid), dim3(NTHR), LDS_BYTES, stream, a);
}
```

```cpp
#include <hip/hip_runtime.h>
#include <cstdio>
#include <cstdint>
#include <cstring>

namespace pg8 {
#define PG8_LAS __attribute__((address_space(3)))
typedef unsigned short bf16_t;
typedef short bf16x8 __attribute__((ext_vector_type(8)));
typedef float f32x4 __attribute__((ext_vector_type(4)));
typedef unsigned u32x4 __attribute__((ext_vector_type(4)));
constexpr int BM = 256, BK = 64, HALF = 128, HTB = HALF * BK * 2  , STAGE_BYTES = 8 * HTB, NXCD = 8, WGM = 8;

__host__ __device__ __forceinline__ int lds_byte(int r, int c) { const int st = (r >> 4) * 2 + (c >> 5), rr = r & 15, cc = c & 31, ob = rr * 64 + cc * 2; return st * 1024 + (ob ^ (((ob >> 9) & 1) << 5)); }
__host__ __device__ __forceinline__ void stage_rc(int b, int& R, int& C) { const int st = b / 1024, sb = b % 1024, swz = sb ^ (((sb >> 9) & 1) << 5); R = (st >> 1) * 16 + swz / 64; C = (st & 1) * 32 + (swz % 64) / 2; }
__host__ __device__ __forceinline__ int perm32(int rho) { const int n = rho >> 4, i = rho & 15; return 8 * (i >> 2) + 4 * n + (i & 3); }

struct Unit { int pm, pn; };
struct Gemm { const bf16_t* A; const bf16_t* Bt; int M, N, K; };

struct StaticOrder {
    int nM, nN, nwg, G, c;
    __host__ __device__ void init(int M, int N, int G_, int c_) { nM = M / BM; nN = N / BM; nwg = nM * nN; G = G_; c = c_; }
    __host__ __device__ bool next(int i, Unit& u) const {
        const long L = (long)i * G + c; if (L >= nwg) return false;
        int wgid = (int)L; { const int q = nwg / NXCD, r = nwg % NXCD, xcd = wgid % NXCD, off = wgid / NXCD; wgid = (xcd < r ? xcd * (q + 1) : r * (q + 1) + (xcd - r) * q) + off; }
        const int nig = WGM * nN, gid = wgid / nig, fm = gid * WGM, gsz = (nM - fm) < WGM ? (nM - fm) : WGM;
        u.pm = fm + ((wgid % nig) % gsz); u.pn = (wgid % nig) / gsz; return true;
    }
    __device__ __forceinline__ void a_ready(const Unit&) const {}
    __device__ __forceinline__ void done(const Unit&) const {}
};

__device__ __forceinline__ unsigned cvt_pk_bf16(float lo, float hi) { unsigned r; asm volatile("v_cvt_pk_bf16_f32 %0, %1, %2" : "=v"(r) : "v"(lo), "v"(hi)); return r; }
typedef float f32x2 __attribute__((ext_vector_type(2)));
__device__ __forceinline__ f32x2 gelu_pk(f32x2 v) {
    const f32x2 av = __builtin_elementwise_abs(v), d = av * 0.2316418882f + 1.0f;
    f32x2 t; t.x = __builtin_amdgcn_rcpf(d.x); t.y = __builtin_amdgcn_rcpf(d.y);
    f32x2 q = t * 0.5307027145f + (-0.7265760135f); q = q * t + 0.7107068705f; q = q * t + (-0.142248368f); q = q * t + 0.127414796f; q = q * t;
    const f32x2 s = (v * v) * (-0.72134752044f);
    f32x2 e; e.x = __builtin_amdgcn_exp2f(s.x); e.y = __builtin_amdgcn_exp2f(s.y);
    const f32x2 m = v * (q * e), r = v - m;
    f32x2 o; o.x = v.x < 0.f ? m.x : r.x; o.y = v.y < 0.f ? m.y : r.y; return o;
}

template <int ACT  > struct EpiBf16 {
    static constexpr bool PERM = true, AFTER_DRAIN = false; static_assert(ACT == 0 || ACT == 1, "EpiBf16: ACT is 0 (none) or 1 (gelu_pk)");
    bf16_t* O; int ldc; const float* bias; int split_cols; size_t split_stride; float scale0;
    __device__ __forceinline__ void operator()(const f32x4 (&acc)[2][2][4][2], const Unit& u, int wr, int wc, int fr, int fq) const {
        const int row0 = u.pm * BM + wr * 64 + fr; int colt = u.pn * BM; bf16_t* base = O;
        float sc = 1.f; if (split_cols) { const int t = colt / split_cols; base += (size_t)t * split_stride; colt -= t * split_cols; if (t == 0) sc = scale0; }
        const int col0 = colt + wc * 32 + 8 * fq, bcol0 = u.pn * BM + wc * 32 + 8 * fq;
        f32x4 bv[2][2];
#pragma unroll
        for (int bj = 0; bj < 2; ++bj)
#pragma unroll
            for (int n = 0; n < 2; ++n) bv[bj][n] = bias ? *(const f32x4*)(bias + bcol0 + bj * HALF + 4 * n) : (f32x4){0.f, 0.f, 0.f, 0.f};
#pragma unroll
        for (int ai = 0; ai < 2; ++ai)
#pragma unroll
            for (int m = 0; m < 4; ++m) { bf16_t* rowp = base + (size_t)(row0 + ai * HALF + m * 16) * ldc + col0;
#pragma unroll
                for (int bj = 0; bj < 2; ++bj) { f32x4 v0 = acc[ai][bj][m][0] + bv[bj][0], v1 = acc[ai][bj][m][1] + bv[bj][1];
                    if (ACT == 1) { f32x2 a = gelu_pk((f32x2){v0[0], v0[1]}), b = gelu_pk((f32x2){v0[2], v0[3]}), c = gelu_pk((f32x2){v1[0], v1[1]}), d = gelu_pk((f32x2){v1[2], v1[3]});
                        v0 = (f32x4){a.x, a.y, b.x, b.y}; v1 = (f32x4){c.x, c.y, d.x, d.y}; }
                    v0 = v0 * sc; v1 = v1 * sc; u32x4 w; w.x = cvt_pk_bf16(v0[0], v0[1]); w.y = cvt_pk_bf16(v0[2], v0[3]); w.z = cvt_pk_bf16(v1[0], v1[1]); w.w = cvt_pk_bf16(v1[2], v1[3]);
                    *(u32x4*)(rowp + bj * HALF) = w; } }
    }
};

struct PanelStats {
    unsigned* xbuf;
    unsigned* cnt;
    unsigned* tmo;
    int ntn; float eps;
    unsigned code;
    __device__ __forceinline__ bool run(const f32x4 (&v)[2][2][4][2], const Unit& u, int wr, int wc, int fr, int fq, PG8_LAS unsigned char* lds, int wid, int lane) const {
        typedef float f32x2v __attribute__((ext_vector_type(2)));
        PG8_LAS f32x2v* P = (PG8_LAS f32x2v*)lds;
        PG8_LAS f32x2v* S = (PG8_LAS f32x2v*)(lds + 8192);
        PG8_LAS unsigned* flag = (PG8_LAS unsigned*)(lds + 8192 + 2048);
#pragma unroll
        for (int ai = 0; ai < 2; ++ai)
#pragma unroll
            for (int m = 0; m < 4; ++m) {
                float s = 0.f;
#pragma unroll
                for (int bj = 0; bj < 2; ++bj)
#pragma unroll
                    for (int n = 0; n < 2; ++n) { const f32x4 x = v[ai][bj][m][n]; s += (x[0] + x[1]) + (x[2] + x[3]); }
                s += __shfl_xor(s, 16); s += __shfl_xor(s, 32);
                const float mw = s * (1.0f / 64.0f); float q = 0.f;
#pragma unroll
                for (int bj = 0; bj < 2; ++bj)
#pragma unroll
                    for (int n = 0; n < 2; ++n) { const f32x4 d = v[ai][bj][m][n] - mw; q += (d[0] * d[0] + d[1] * d[1]) + (d[2] * d[2] + d[3] * d[3]); }
                q += __shfl_xor(q, 16); q += __shfl_xor(q, 32);
                if (fq == 0) P[(ai * HALF + wr * 64 + m * 16 + fr) * 4 + wc] = (f32x2v){mw, q};
            }
        asm volatile("s_waitcnt lgkmcnt(0)" ::: "memory"); __builtin_amdgcn_s_barrier(); asm volatile("" ::: "memory");
#if defined(BROKEN_EXCHANGE_NO_WAIT)
#warning BROKEN CONTROL BUILD: the row-statistics exchange does not wait; results are wrong by design
        if (blockIdx.x >= 64) { const long long t0_ = clock64(); while (clock64() - t0_ < 60000) __builtin_amdgcn_s_sleep(8); }
#endif
        const int row = wid * 32 + (lane & 31);
        if (lane < 32) {
            const f32x2v a = P[row * 4 + 0], b = P[row * 4 + 1], c = P[row * 4 + 2], d = P[row * 4 + 3];
            const float mt = (a.x + b.x + c.x + d.x) * 0.25f;
            const float da = a.x - mt, db = b.x - mt, dc = c.x - mt, dd = d.x - mt;
            const float m2 = (a.y + b.y) + (c.y + d.y) + 64.0f * ((da * da + db * db) + (dc * dc + dd * dd));
            unsigned long long* slot = (unsigned long long*)xbuf + ((size_t)(u.pm * BM + row) * 4 + u.pn);
            __hip_atomic_store(slot, ((unsigned long long)__float_as_uint(m2) << 32) | __float_as_uint(mt), __ATOMIC_RELAXED, __HIP_MEMORY_SCOPE_AGENT);
        }
        asm volatile("s_waitcnt vmcnt(0)" ::: "memory");
        if (lane == 0) __hip_atomic_fetch_add(cnt + 64 * u.pm, 1u, __ATOMIC_RELAXED, __HIP_MEMORY_SCOPE_AGENT);
        if (wid == 0) {
            bool dead = false; const unsigned long long t0 = __builtin_amdgcn_s_memrealtime(); const unsigned want = 8u * (unsigned)ntn;
            for (;;) {
#if defined(BROKEN_EXCHANGE_NO_WAIT)
                break;
#endif
                if ((unsigned)__builtin_amdgcn_readfirstlane(__hip_atomic_load(cnt + 64 * u.pm, __ATOMIC_RELAXED, __HIP_MEMORY_SCOPE_AGENT)) >= want) break;
                if (__builtin_amdgcn_s_memrealtime() - t0 > 2000000ull) {
                    if (lane == 0) { unsigned expect = 0u; __hip_atomic_compare_exchange_strong(tmo + 1, &expect, code | (unsigned)(u.pm & 0xff), __ATOMIC_RELAXED, __ATOMIC_RELAXED, __HIP_MEMORY_SCOPE_AGENT);
                                     __hip_atomic_store(tmo, 1u, __ATOMIC_RELAXED, __HIP_MEMORY_SCOPE_AGENT); }
                    dead = true; break; }
                __builtin_amdgcn_s_sleep(2);
            }
            __builtin_amdgcn_fence(__ATOMIC_ACQUIRE, "agent");
            if (lane == 0) flag[0] = dead ? 1u : 0u;
        }
        asm volatile("s_waitcnt vmcnt(0) lgkmcnt(0)" ::: "memory"); __builtin_amdgcn_s_barrier(); asm volatile("" ::: "memory");
        const bool bad = flag[0] != 0u;
        if (lane < 32) {
            const unsigned long long* slot = (const unsigned long long*)xbuf + (size_t)(u.pm * BM + row) * 4; float mt[4], m2[4]; float ms = 0.f;
#pragma unroll
            for (int t = 0; t < 4; ++t) { if (t < ntn) { const unsigned long long w = __hip_atomic_load(slot + t, __ATOMIC_RELAXED, __HIP_MEMORY_SCOPE_AGENT); mt[t] = __uint_as_float((unsigned)w); m2[t] = __uint_as_float((unsigned)(w >> 32)); } else { mt[t] = 0.f; m2[t] = 0.f; } ms += mt[t]; }
            const float mean = ms / (float)ntn; float q = 0.f;
#pragma unroll
            for (int t = 0; t < 4; ++t) if (t < ntn) { const float dm = mt[t] - mean; q += m2[t] + 256.0f * dm * dm; }
            S[row] = (f32x2v){mean, 1.0f / sqrtf(q / (256.0f * (float)ntn) + eps)};
        }
        asm volatile("s_waitcnt lgkmcnt(0)" ::: "memory"); __builtin_amdgcn_s_barrier(); asm volatile("" ::: "memory");
        return bad;
    }
};
struct EpiLnRes {
    static constexpr bool PERM = false, AFTER_DRAIN = true;
    const float* base; float* out; int ldc; const float* bias; PanelStats st; unsigned poison;
    __device__ __forceinline__ void fused(f32x4 (&acc)[2][2][4][2], const Unit& u, int wr, int wc, int fr, int fq, PG8_LAS unsigned char* lds, int wid, int lane) const {
        typedef float f32x2v __attribute__((ext_vector_type(2)));
        const PG8_LAS f32x2v* S = (const PG8_LAS f32x2v*)(lds + 8192);
        const int col0 = u.pn * BM + wc * 32 + 4 * fq;
#pragma unroll
        for (int bj = 0; bj < 2; ++bj)
#pragma unroll
            for (int n = 0; n < 2; ++n) { const f32x4 bv = bias ? *(const f32x4*)(bias + col0 + bj * HALF + n * 16) : (f32x4){0.f, 0.f, 0.f, 0.f};
#pragma unroll
                for (int ai = 0; ai < 2; ++ai)
#pragma unroll
                    for (int m = 0; m < 4; ++m) acc[ai][bj][m][n] += bv; }
        f32x4 pre[4][2][2];
#pragma unroll
        for (int m = 0; m < 4; ++m) { const size_t off = (size_t)(u.pm * BM + wr * 64 + m * 16 + fr) * ldc + col0;
#pragma unroll
            for (int bj = 0; bj < 2; ++bj)
#pragma unroll
                for (int n = 0; n < 2; ++n) pre[m][bj][n] = *(const f32x4*)(base + off + bj * HALF + n * 16); }
        const bool bad = st.run(acc, u, wr, wc, fr, fq, lds, wid, lane) || poison != 0u;
        const float qnan = __builtin_nanf("");
#pragma unroll
        for (int ai = 0; ai < 2; ++ai)
#pragma unroll
            for (int m = 0; m < 4; ++m) { const int r = ai * HALF + wr * 64 + m * 16 + fr; const f32x2v sr = S[r]; const size_t off = (size_t)(u.pm * BM + r) * ldc + col0;
#pragma unroll
                for (int bj = 0; bj < 2; ++bj)
#pragma unroll
                    for (int n = 0; n < 2; ++n) { const f32x4 bs = ai == 0 ? pre[m][bj][n] : *(const f32x4*)(base + off + bj * HALF + n * 16); f32x4 o = bs + (acc[ai][bj][m][n] - sr.x) * sr.y;
                        if (bad) o = (f32x4){qnan, qnan, qnan, qnan}; *(f32x4*)(out + off + bj * HALF + n * 16) = o; }
                if (m & 1) asm volatile("" ::: "memory"); }
    }
};
struct EpiLnResLn {
    static constexpr bool PERM = false, AFTER_DRAIN = true;
    const float* base; float* out; bf16_t* xn; int ldc; const float* bias; PanelStats st1, st2; unsigned poison;
    __device__ __forceinline__ void fused(f32x4 (&acc)[2][2][4][2], const Unit& u, int wr, int wc, int fr, int fq, PG8_LAS unsigned char* lds, int wid, int lane) const {
        typedef float f32x2v __attribute__((ext_vector_type(2))); typedef unsigned u32x2v __attribute__((ext_vector_type(2)));
        const PG8_LAS f32x2v* S = (const PG8_LAS f32x2v*)(lds + 8192);
        const int col0 = u.pn * BM + wc * 32 + 4 * fq;
#pragma unroll
        for (int bj = 0; bj < 2; ++bj)
#pragma unroll
            for (int n = 0; n < 2; ++n) { const f32x4 bv = bias ? *(const f32x4*)(bias + col0 + bj * HALF + n * 16) : (f32x4){0.f, 0.f, 0.f, 0.f};
#pragma unroll
                for (int ai = 0; ai < 2; ++ai)
#pragma unroll
                    for (int m = 0; m < 4; ++m) acc[ai][bj][m][n] += bv; }
        bool bad = st1.run(acc, u, wr, wc, fr, fq, lds, wid, lane) || poison != 0u;
        const float qnan = __builtin_nanf("");
#pragma unroll
        for (int ai = 0; ai < 2; ++ai)
#pragma unroll
            for (int m = 0; m < 4; ++m) { const int r = ai * HALF + wr * 64 + m * 16 + fr; const f32x2v sr = S[r]; const size_t off = (size_t)(u.pm * BM + r) * ldc + col0;
#pragma unroll
                for (int bj = 0; bj < 2; ++bj)
#pragma unroll
                    for (int n = 0; n < 2; ++n) { const f32x4 bs = *(const f32x4*)(base + off + bj * HALF + n * 16); acc[ai][bj][m][n] = bs + (acc[ai][bj][m][n] - sr.x) * sr.y; }
                asm volatile("" : "+v"(acc[ai][0][m][0]), "+v"(acc[ai][0][m][1]), "+v"(acc[ai][1][m][0]), "+v"(acc[ai][1][m][1]));
                if (m & 1) asm volatile("" ::: "memory"); }
        const bool bad1 = bad;
        bad = st2.run(acc, u, wr, wc, fr, fq, lds, wid, lane) || bad;
#pragma unroll
        for (int ai = 0; ai < 2; ++ai)
#pragma unroll
            for (int m = 0; m < 4; ++m) { const int r = ai * HALF + wr * 64 + m * 16 + fr; const f32x2v sr = S[r]; const size_t off = (size_t)(u.pm * BM + r) * ldc + col0;
#pragma unroll
                for (int bj = 0; bj < 2; ++bj)
#pragma unroll
                    for (int n = 0; n < 2; ++n) { const f32x4 x1 = acc[ai][bj][m][n]; *(f32x4*)(out + off + bj * HALF + n * 16) = bad1 ? (f32x4){qnan, qnan, qnan, qnan} : x1;
                        const f32x4 o = (x1 - sr.x) * sr.y; u32x2v w; w.x = cvt_pk_bf16(o[0], o[1]); w.y = cvt_pk_bf16(o[2], o[3]);
                        if (bad) { w.x = 0x7fc07fc0u; w.y = 0x7fc07fc0u; } *(u32x2v*)(xn + off + bj * HALF + n * 16) = w; }
                asm volatile("" ::: "memory"); }
    }
};

template <class Epi, class Sched, bool ALIGN_EPI = false, bool SP2 = false>
__device__ __forceinline__ void gemm_phase(PG8_LAS unsigned char* lds, const Gemm g, const Sched& S, const Epi& E) {
    int tid_ = threadIdx.x; asm volatile("" : "+v"(tid_));
    const int tid = tid_, wid = __builtin_amdgcn_readfirstlane(tid >> 6), lane = tid & 63, wr = wid >> 2, wc = wid & 3, fr = lane & 15, fq = lane >> 4;
    const int K = g.K, nt = K / BK;
    unsigned voffA[2], voffB[2];
#pragma unroll
    for (int i = 0; i < 2; ++i) { int R, C; stage_rc(tid * 16 + i * 8192, R, C); const int Rb = Epi::PERM ? ((R & ~31) + perm32(R & 31)) : R;
        voffA[i] = (unsigned)(R * K + C) * 2u; voffB[i] = (unsigned)(Rb * K + C) * 2u; }
    const size_t kstep = (size_t)(BK * 2);
    const size_t hstep = (size_t)HALF * K * 2;
    const size_t tstep = 2 * hstep;
    const unsigned ldsw = (unsigned)wid * 1024u;
    const int aoff = lds_byte(wr * 64 + fr, fq * 8), boff = lds_byte(wc * 32 + fr, fq * 8);
#define PG8_SA(b, h) (((b) * 2 + (h)) * HTB)
#define PG8_SB(b, h) ((4 + (b) * 2 + (h)) * HTB)
#define PG8_STAGE(bufoff, gbase, voff) do { _Pragma("unroll") for (int _i = 0; _i < 2; ++_i) \
        __builtin_amdgcn_global_load_lds((const unsigned*)((const char*)(gbase) + (voff)[_i]), (PG8_LAS unsigned*)(lds + (bufoff) + ldsw + _i * 8192), 16, 0, 0); } while (0)
#define PG8_LDA(dst, b, h) do { _Pragma("unroll") for (int m = 0; m < 4; ++m) _Pragma("unroll") for (int k = 0; k < 2; ++k) dst[m][k] = *(const PG8_LAS bf16x8*)(lds + PG8_SA(b, h) + aoff + m * 2048 + k * 1024); } while (0)
#define PG8_LDB(dst, b, h) do { _Pragma("unroll") for (int n = 0; n < 2; ++n) _Pragma("unroll") for (int k = 0; k < 2; ++k) dst[n][k] = *(const PG8_LAS bf16x8*)(lds + PG8_SB(b, h) + boff + n * 2048 + k * 1024); } while (0)
#define PG8_MMA(ai, bj, At, Bt) do { __builtin_amdgcn_s_setprio(1); _Pragma("unroll") for (int m = 0; m < 4; ++m) _Pragma("unroll") for (int n = 0; n < 2; ++n) _Pragma("unroll") for (int k = 0; k < 2; ++k) \
        acc[ai][bj][m][n] = __builtin_amdgcn_mfma_f32_16x16x32_bf16(Bt[n][k], At[m][k], acc[ai][bj][m][n], 0, 0, 0); __builtin_amdgcn_s_setprio(0); } while (0)
#define PG8_WAIT_V(n) asm volatile("s_waitcnt vmcnt(" #n ")" ::: "memory")
#define PG8_WAIT_L(n) asm volatile("s_waitcnt lgkmcnt(" #n ")" ::: "memory")
#define PG8_BAR __builtin_amdgcn_s_barrier()
#define PG8_SCHED __builtin_amdgcn_sched_barrier(0)
    Unit cur, nxt; int ui = 0;
    if (!S.next(0, cur)) return;
    f32x4 acc[2][2][4][2];
#pragma unroll
    for (int a = 0; a < 2; ++a)
#pragma unroll
        for (int b = 0; b < 2; ++b)
#pragma unroll
            for (int m = 0; m < 4; ++m)
#pragma unroll
                for (int n = 0; n < 2; ++n) acc[a][b][m][n] = (f32x4){0.f, 0.f, 0.f, 0.f};
    bf16x8 At[4][2], B0[2][2], B1[2][2];
    const char* cA = (const char*)g.A + (size_t)cur.pm * tstep; const char* cB = (const char*)g.Bt + (size_t)cur.pn * tstep;
    S.a_ready(cur);
    if constexpr (SP2) {
        PG8_STAGE(PG8_SB(0, 0), cB, voffB); PG8_STAGE(PG8_SB(0, 1), cB + hstep, voffB); PG8_STAGE(PG8_SA(0, 0), cA, voffA); PG8_STAGE(PG8_SA(0, 1), cA + hstep, voffA);
        if (wr == 1) PG8_BAR;
        PG8_WAIT_V(2); PG8_BAR;
        PG8_STAGE(PG8_SB(1, 0), cB + kstep, voffB); PG8_STAGE(PG8_SA(1, 0), cA + kstep, voffA); PG8_STAGE(PG8_SB(1, 1), cB + hstep + kstep, voffB);
        PG8_WAIT_V(6); PG8_BAR;
    } else {
        PG8_STAGE(PG8_SB(0, 0), cB, voffB); PG8_STAGE(PG8_SA(0, 0), cA, voffA); PG8_STAGE(PG8_SB(0, 1), cB + hstep, voffB); PG8_STAGE(PG8_SA(0, 1), cA + hstep, voffA);
        if (wr == 1) PG8_BAR;
        PG8_WAIT_V(4); PG8_BAR;
        PG8_STAGE(PG8_SB(1, 0), cB + kstep, voffB); PG8_STAGE(PG8_SA(1, 0), cA + kstep, voffA); PG8_STAGE(PG8_SB(1, 1), cB + hstep + kstep, voffB);
        PG8_WAIT_V(6); PG8_BAR;
    }
    for (;;) {
        const bool has_next = S.next(ui + 1, nxt);
        const char* nA = has_next ? (const char*)g.A + (size_t)nxt.pm * tstep : cA; const char* nB = has_next ? (const char*)g.Bt + (size_t)nxt.pn * tstep : cB;
        for (int t = 0; t < nt; t += 2) {
            const bool last = (t == nt - 2);
            const char* a1 = cA + (size_t)(t + 1) * kstep;
            const char* a2 = last ? nA : cA + (size_t)(t + 2) * kstep; const char* b2 = last ? nB : cB + (size_t)(t + 2) * kstep;
            const char* a3 = a2 + kstep; const char* b3 = b2 + kstep;
            if (last && has_next) S.a_ready(nxt);
            if constexpr (SP2) {
            PG8_LDB(B0, 0, 0); PG8_LDB(B1, 0, 1); PG8_SCHED; PG8_LDA(At, 0, 0); PG8_STAGE(PG8_SA(1, 1), a1 + hstep, voffA);
            PG8_WAIT_V(8); PG8_WAIT_L(0); PG8_BAR; PG8_MMA(0, 0, At, B0); PG8_MMA(0, 1, At, B1); PG8_BAR; PG8_SCHED;
            PG8_LDA(At, 0, 1); PG8_STAGE(PG8_SB(0, 0), b2, voffB); PG8_STAGE(PG8_SB(0, 1), b2 + hstep, voffB); PG8_STAGE(PG8_SA(0, 0), a2, voffA);
            PG8_WAIT_V(8); PG8_WAIT_L(0); PG8_BAR; PG8_MMA(1, 0, At, B0); PG8_MMA(1, 1, At, B1); PG8_BAR; PG8_SCHED;
            PG8_LDB(B0, 1, 0); PG8_LDB(B1, 1, 1); PG8_SCHED; PG8_LDA(At, 1, 0); PG8_STAGE(PG8_SA(0, 1), a2 + hstep, voffA);
            PG8_WAIT_V(8); PG8_WAIT_L(0); PG8_BAR; PG8_MMA(0, 0, At, B0); PG8_MMA(0, 1, At, B1); PG8_BAR; PG8_SCHED;
            PG8_LDA(At, 1, 1); PG8_STAGE(PG8_SB(1, 0), b3, voffB); PG8_STAGE(PG8_SB(1, 1), b3 + hstep, voffB); PG8_STAGE(PG8_SA(1, 0), a3, voffA);
            PG8_WAIT_V(8); PG8_WAIT_L(0); PG8_BAR; PG8_MMA(1, 0, At, B0); PG8_MMA(1, 1, At, B1); PG8_BAR; PG8_SCHED;
            } else {
            PG8_LDB(B0, 0, 0); PG8_SCHED; PG8_LDA(At, 0, 0); PG8_STAGE(PG8_SA(1, 1), a1 + hstep, voffA);
            PG8_WAIT_L(8); PG8_BAR; PG8_WAIT_L(0); PG8_MMA(0, 0, At, B0); PG8_BAR; PG8_SCHED;
            PG8_LDB(B1, 0, 1); PG8_STAGE(PG8_SB(0, 0), b2, voffB);
            PG8_BAR; PG8_WAIT_L(0); PG8_MMA(0, 1, At, B1); PG8_BAR;
            PG8_LDA(At, 0, 1); PG8_STAGE(PG8_SA(0, 0), a2, voffA);
            PG8_BAR; PG8_WAIT_L(0); PG8_MMA(1, 0, At, B0); PG8_BAR; PG8_SCHED;
            PG8_STAGE(PG8_SB(0, 1), b2 + hstep, voffB);
            PG8_WAIT_V(6); PG8_BAR; PG8_MMA(1, 1, At, B1); PG8_BAR;
            PG8_LDB(B0, 1, 0); PG8_SCHED; PG8_LDA(At, 1, 0); PG8_STAGE(PG8_SA(0, 1), a2 + hstep, voffA);
            PG8_WAIT_L(8); PG8_BAR; PG8_WAIT_L(0); PG8_MMA(0, 0, At, B0); PG8_BAR; PG8_SCHED;
            PG8_LDB(B1, 1, 1); PG8_STAGE(PG8_SB(1, 0), b3, voffB);
            PG8_BAR; PG8_WAIT_L(0); PG8_MMA(0, 1, At, B1); PG8_BAR;
            PG8_LDA(At, 1, 1); PG8_STAGE(PG8_SA(1, 0), a3, voffA);
            PG8_BAR; PG8_WAIT_L(0); PG8_MMA(1, 0, At, B0); PG8_BAR; PG8_SCHED;
            PG8_STAGE(PG8_SB(1, 1), b3 + hstep, voffB);
            PG8_WAIT_V(6); PG8_BAR; PG8_MMA(1, 1, At, B1); PG8_BAR;
            }
        }
        if constexpr (ALIGN_EPI) { if (wr == 0) PG8_BAR; }
        if constexpr (!Epi::AFTER_DRAIN) { E(acc, cur, wr, wc, fr, fq); S.done(cur); }
        if (!has_next) break;
#pragma unroll
        for (int a = 0; a < 2; ++a)
#pragma unroll
            for (int b = 0; b < 2; ++b)
#pragma unroll
                for (int m = 0; m < 4; ++m)
#pragma unroll
                    for (int n = 0; n < 2; ++n) acc[a][b][m][n] = (f32x4){0.f, 0.f, 0.f, 0.f};
        cur = nxt; cA = nA; cB = nB; ++ui;
        if constexpr (ALIGN_EPI) { if (wr == 1) PG8_BAR; }
    }
    PG8_WAIT_V(0);
    if constexpr (!ALIGN_EPI) { if (wr == 0) PG8_BAR; }
    PG8_BAR;
    if constexpr (Epi::AFTER_DRAIN) { E.fused(acc, cur, wr, wc, fr, fq, lds, wid, lane); S.done(cur); }
#undef PG8_SA
#undef PG8_SB
#undef PG8_STAGE
#undef PG8_LDA
#undef PG8_LDB
#undef PG8_MMA
#undef PG8_WAIT_V
#undef PG8_WAIT_L
#undef PG8_BAR
#undef PG8_SCHED
}
}
#define GAS __attribute__((address_space(1)))
#define LAS __attribute__((address_space(3)))
typedef unsigned short bf16;
typedef unsigned v4u __attribute__((ext_vector_type(4)));
typedef float f32x4 __attribute__((ext_vector_type(4)));
typedef short bf16x8 __attribute__((ext_vector_type(8)));
typedef GAS unsigned gu32;
typedef GAS unsigned long long gu64;
#define RLX_AGENT __ATOMIC_RELAXED, __HIP_MEMORY_SCOPE_AGENT
#define LDS_WAIT() asm volatile("s_waitcnt lgkmcnt(0)" ::: "memory")
#define VM_WAIT() asm volatile("s_waitcnt vmcnt(0)" ::: "memory")
__device__ __forceinline__ unsigned long long rt() { return __builtin_amdgcn_s_memrealtime(); }
#define XB_TMO      128
#define XB_XCNT(j)  (256  + 64 * (j))
#define XB_XSUB(j)  (1280 + 64 * (j))
#define XB_XGEN(j)  (2304 + 64 * (j))
#define XB_TOP      3328
#define XB_TOPGEN   3392
#define XCD_BAR_WORDS 3456
#define XB_SPIN_CAP (1u << 18)

__device__ __forceinline__ unsigned xb_ld(unsigned* p)              { return __hip_atomic_load(p, __ATOMIC_RELAXED, __HIP_MEMORY_SCOPE_AGENT); }
__device__ __forceinline__ unsigned xb_add(unsigned* p, unsigned v) { return __hip_atomic_fetch_add(p, v, __ATOMIC_RELAXED, __HIP_MEMORY_SCOPE_AGENT); }
__device__ __forceinline__ unsigned xb_xcc_id() { return (unsigned)__builtin_amdgcn_s_getreg((3 << 11) | 20) & 0xFu; }
#define XB_SPIN(cond, bar) do { unsigned _sp = 0; while (cond) { __builtin_amdgcn_s_sleep(1); \
    if ((++_sp & 255u) == 0u) { if (xb_ld(&(bar)[XB_TMO])) break; if (_sp > XB_SPIN_CAP) { atomicAdd(&(bar)[XB_TMO], 1u); break; } } } } while (0)

struct XcdBarrier {
    unsigned* bar; unsigned x;
    volatile LAS unsigned* st;
};

__device__ __forceinline__ XcdBarrier xcd_barrier_post(unsigned* bar, volatile LAS unsigned* st) {
    XcdBarrier b; b.bar = bar; b.x = xb_xcc_id(); b.st = st;
    if (threadIdx.x == 0) (void)xb_add(&bar[XB_XCNT(b.x)], 1u);
    return b;
}
__device__ __forceinline__ void xcd_barrier_complete(unsigned* bar, unsigned x, unsigned& nloc, unsigned& nx) {
    const unsigned G = gridDim.x * gridDim.y * gridDim.z;
    unsigned sum, cnt, mine, sp = 0u;
    for (;;) {
        sum = 0u; cnt = 0u; mine = 0u;
#pragma unroll
        for (unsigned j = 0; j < 16; ++j) { const unsigned c = xb_ld(&bar[XB_XCNT(j)]); sum += c; cnt += (c > 0u) ? 1u : 0u; mine = (j == x) ? c : mine; }
        if (sum == G) break;
        __builtin_amdgcn_s_sleep(1);
        if ((++sp & 255u) == 0u) { if (xb_ld(&bar[XB_TMO])) break; if (sp > XB_SPIN_CAP) { atomicAdd(&bar[XB_TMO], 1u); break; } }
    }
    nloc = mine > 0u ? mine : 1u; nx = cnt > 0u ? cnt : 1u;
}

__device__ __forceinline__ void xcd_barrier(const XcdBarrier& b) {
    asm volatile("s_waitcnt vmcnt(0)" ::: "memory");
    __syncthreads();
    if (threadIdx.x == 0) {
        unsigned* bar = b.bar;
        __builtin_amdgcn_s_waitcnt(0);
        unsigned nloc = b.st[0], nx = b.st[1];
        if (nloc == 0u) { xcd_barrier_complete(bar, b.x, nloc, nx); b.st[0] = nloc; b.st[1] = nx; }
        const unsigned old = xb_add(&bar[XB_XSUB(b.x)], 1u);
        const unsigned gen = old / nloc;
        if (old + 1u == (gen + 1u) * nloc) {
            __builtin_amdgcn_fence(__ATOMIC_RELEASE, "agent");
            asm volatile("s_waitcnt vmcnt(0)" ::: "memory");
            const unsigned og = xb_add(&bar[XB_TOP], 1u);
            const unsigned tg = og / nx;
            if (og + 1u == (tg + 1u) * nx) xb_add(&bar[XB_TOPGEN], 1u);
            else XB_SPIN(xb_ld(&bar[XB_TOPGEN]) == tg, bar);
            __builtin_amdgcn_fence(__ATOMIC_ACQUIRE, "agent");
            xb_add(&bar[XB_XGEN(b.x)], 1u);
            asm volatile("s_waitcnt vmcnt(0)" ::: "memory");
        } else {
            XB_SPIN(xb_ld(&bar[XB_XGEN(b.x)]) == gen, bar);
            __builtin_amdgcn_fence(__ATOMIC_ACQUIRE, "agent");
            asm volatile("s_waitcnt vmcnt(0)" ::: "memory");
        }
    }
    __syncthreads();
}
__device__ __forceinline__ int fresh_tid() { int t = threadIdx.x; asm volatile("" : "+v"(t)); return t; }

constexpr int NB = 8, S = 8192, M = NB * S, D = 1024, FF = 4096, NMEMT = 256;
constexpr int NDIFF = 2560, NDSA_L = 1736, NDSA = 1792;
constexpr float EPS = 1e-6f;
constexpr int NWAVES = 8, NTHR = 512;
constexpr float C2 = 0.125f * 1.4426950408889634f;
constexpr int DQ = 0, DK = 768, DV = 832, DIQ = 896, DIK = 1408, DIW = 1472, DQM = 1480;

typedef unsigned short bf16_t;
typedef unsigned u32x4 __attribute__((ext_vector_type(4)));
typedef float f32x4 __attribute__((ext_vector_type(4)));

constexpr size_t MiB = 1u << 20;
constexpr size_t WS_CTL = 0;
constexpr size_t WS_WIN0 = 1 * MiB, WS_WIN1 = 6 * MiB, WS_WOUT = 10 * MiB, WS_WUP = 14 * MiB, WS_WDN = 30 * MiB, WS_WKV = 46 * MiB;
constexpr size_t WS_MEMN = 48 * MiB, WS_MEMKV = 56 * MiB, WS_ROPE = 60 * MiB, WS_TOPK = 76 * MiB;
constexpr size_t WS_H = 108 * MiB, WS_PROJ = 236 * MiB, WS_O = 556 * MiB, WS_HID = 236 * MiB, WS_Y = 748 * MiB, WS_END = 1004 * MiB;

constexpr size_t P0_Q = 0, P0_K = (size_t)M * 768, P0_V = (size_t)M * 1536, P0_QM = (size_t)M * 2304;
constexpr size_t P1_Q = 0, P1_K = (size_t)M * 768, P1_V = (size_t)M * 832, P1_IK = (size_t)M * 896, P1_IQ = (size_t)M * 960, P1_QM = (size_t)M * 1472, P1_IW = (size_t)M * 1728;
constexpr float IW_SCALE = 0.04419417382415922f;
constexpr size_t MKV_K = 0, MKV_V = 524288, MKV_LAYER = 1048576;
__device__ __forceinline__ float bf2f(bf16_t v) { return __uint_as_float((unsigned)v << 16); }
__device__ __forceinline__ unsigned f2bf(float f) { unsigned u = __float_as_uint(f); return (u + 0x7fffu + ((u >> 16) & 1u)) >> 16; }
__device__ __forceinline__ unsigned pk2(float lo, float hi) { return f2bf(lo) | (f2bf(hi) << 16); }
__device__ __forceinline__ float wave_sum(float v) {
#pragma unroll
    for (int o = 1; o < 64; o <<= 1) v += __shfl_xor(v, o);
    return v;
}

template <int ACT> struct EpiB {
    static constexpr bool PERM = true, AFTER_DRAIN = false;
    bf16_t* O; int ldc;
    __device__ __forceinline__ void operator()(const pg8::f32x4 (&acc)[2][2][4][2], const pg8::Unit& u, int wr, int wc, int fr, int fq) const {
        const int row0 = u.pm * 256 + wr * 64 + fr, col0 = u.pn * 256 + wc * 32 + 8 * fq;
#pragma unroll
        for (int ai = 0; ai < 2; ++ai)
#pragma unroll
            for (int m = 0; m < 4; ++m) { bf16_t* rowp = O + (size_t)(row0 + ai * 128 + m * 16) * ldc + col0;
#pragma unroll
                for (int bj = 0; bj < 2; ++bj) { pg8::f32x4 v0 = acc[ai][bj][m][0], v1 = acc[ai][bj][m][1];
                    if (ACT == 2) {
#pragma unroll
                        for (int e = 0; e < 4; ++e) { float a = fmaxf(v0[e], 0.f); v0[e] = a * a; float b = fmaxf(v1[e], 0.f); v1[e] = b * b; } }
                    u32x4 w; w.x = pg8::cvt_pk_bf16(v0[0], v0[1]); w.y = pg8::cvt_pk_bf16(v0[2], v0[3]); w.z = pg8::cvt_pk_bf16(v1[0], v1[1]); w.w = pg8::cvt_pk_bf16(v1[2], v1[3]);
                    *(u32x4*)(rowp + bj * 128) = w; } }
    }
};
struct EpiF {
    static constexpr bool PERM = false, AFTER_DRAIN = false;
    float* C; int ldc;
    __device__ __forceinline__ void operator()(const pg8::f32x4 (&acc)[2][2][4][2], const pg8::Unit& u, int wr, int wc, int fr, int fq) const {
        const int row0 = u.pm * 256 + wr * 64 + fr, col0 = u.pn * 256 + wc * 32 + 4 * fq;
#pragma unroll
        for (int ai = 0; ai < 2; ++ai)
#pragma unroll
            for (int m = 0; m < 4; ++m) { float* rowp = C + (size_t)(row0 + ai * 128 + m * 16) * ldc + col0;
#pragma unroll
                for (int bj = 0; bj < 2; ++bj)
#pragma unroll
                    for (int n = 0; n < 2; ++n) *(pg8::f32x4*)(rowp + bj * 128 + n * 16) = acc[ai][bj][m][n]; }
    }
};


struct EpiProj0 {
    static constexpr bool PERM = true, AFTER_DRAIN = false;
    bf16_t* P; const float2* rope;
    __device__ __forceinline__ void operator()(const pg8::f32x4 (&acc)[2][2][4][2], const pg8::Unit& u, int wr, int wc, int fr, int fq) const {
        const int pn = u.pn;
        const int b = (u.pm * 256) / S;
        const int m0 = u.pm * 256 + wr * 64 + fr;
#pragma unroll
        for (int ai = 0; ai < 2; ++ai)
#pragma unroll
            for (int mm = 0; mm < 4; ++mm) {
                const int mrow = m0 + ai * 128 + mm * 16; const int s = mrow - b * S; const int t = s >> 6, r = s & 63;
                float x1[8], x2[8];
#pragma unroll
                for (int j = 0; j < 8; ++j) { x1[j] = acc[ai][0][mm][j >> 2][j & 3]; x2[j] = acc[ai][1][mm][j >> 2][j & 3]; }
                if (pn < 6) {
                    const pg8::f32x4* cs = (const pg8::f32x4*)(rope + (size_t)mrow * 32 + 8 * fq);
                    pg8::f32x4 cv[4];
#pragma unroll
                    for (int k = 0; k < 4; ++k) cv[k] = cs[k];
#pragma unroll
                    for (int j = 0; j < 8; ++j) { const float c = cv[j >> 1][(j & 1) * 2], sn = cv[j >> 1][(j & 1) * 2 + 1];
                        const float a = x1[j] * c - x2[j] * sn, bb = x2[j] * c + x1[j] * sn; x1[j] = a; x2[j] = bb; }
                }
                if (pn < 3 || pn == 9) {
#pragma unroll
                    for (int j = 0; j < 8; ++j) { x1[j] *= C2; x2[j] *= C2; }
                }
                u32x4 w1, w2;
                w1.x = pg8::cvt_pk_bf16(x1[0], x1[1]); w1.y = pg8::cvt_pk_bf16(x1[2], x1[3]); w1.z = pg8::cvt_pk_bf16(x1[4], x1[5]); w1.w = pg8::cvt_pk_bf16(x1[6], x1[7]);
                w2.x = pg8::cvt_pk_bf16(x2[0], x2[1]); w2.y = pg8::cvt_pk_bf16(x2[2], x2[3]); w2.z = pg8::cvt_pk_bf16(x2[4], x2[5]); w2.w = pg8::cvt_pk_bf16(x2[6], x2[7]);
                bf16_t *d1, *d2;
                if (pn < 3) { bf16_t* q = P + P0_Q + ((size_t)(b * 12 + 4 * pn + wc) * S + s) * 64 + 8 * fq; d1 = q; d2 = q + 32; }
                else if (pn < 6) { bf16_t* k = P + P0_K + ((((size_t)(b * 12 + 4 * (pn - 3) + wc) * 128 + t) * 8 + fq) * 512 + r * 8); d1 = k; d2 = k + 4 * 512; }
                else if (pn < 9) { const int hsv = 4 * (pn - 6) + wc; bf16_t* v = P + P0_V + (((((size_t)(b * 6 + (hsv >> 1)) * 128 + t) * 4 + 2 * (hsv & 1)) * 64 + r) * 32 + 8 * fq); d1 = v; d2 = v + 64 * 32; }
                else { bf16_t* q = P + P0_QM + ((size_t)(b * 4 + wc) * S + s) * 64 + 8 * fq; d1 = q; d2 = q + 32; }
                *(u32x4*)d1 = w1; *(u32x4*)d2 = w2;
            }
    }
};
__device__ __forceinline__ unsigned pk_f16(float lo, float hi) { typedef float f2 __attribute__((ext_vector_type(2))); typedef _Float16 h2 __attribute__((ext_vector_type(2))); const f2 v = {lo, hi}; return __builtin_bit_cast(unsigned, __builtin_convertvector(v, h2)); }
struct EpiProj1 {
    static constexpr bool PERM = true, AFTER_DRAIN = false;
    bf16_t* P; const float2* rope;
    __device__ __forceinline__ void operator()(const pg8::f32x4 (&acc)[2][2][4][2], const pg8::Unit& u, int wr, int wc, int fr, int fq) const {
        const int pn = u.pn;
        const int b = (u.pm * 256) / S;
        const int m0 = u.pm * 256 + wr * 64 + fr;
        const bool do_rope = (pn < 3) || (pn == 3 && (wc == 0 || wc == 2)) || pn == 4 || pn == 5;
        const bool f16out = (pn == 3 && wc == 2) || pn == 4 || pn == 5;
#pragma unroll
        for (int ai = 0; ai < 2; ++ai)
#pragma unroll
            for (int mm = 0; mm < 4; ++mm) {
                const int mrow = m0 + ai * 128 + mm * 16; const int s = mrow - b * S; const int t = s >> 6, r = s & 63;
                float x1[8], x2[8];
#pragma unroll
                for (int j = 0; j < 8; ++j) { x1[j] = acc[ai][0][mm][j >> 2][j & 3]; x2[j] = acc[ai][1][mm][j >> 2][j & 3]; }
                if (pn == 3 && wc == 3) {
                    if (fq == 0) { float* w = (float*)(P + P1_IW) + (size_t)mrow * 8;
                        *(pg8::f32x4*)w = (pg8::f32x4){x1[0] * IW_SCALE, x1[1] * IW_SCALE, x1[2] * IW_SCALE, x1[3] * IW_SCALE};
                        *(pg8::f32x4*)(w + 4) = (pg8::f32x4){x1[4] * IW_SCALE, x1[5] * IW_SCALE, x1[6] * IW_SCALE, x1[7] * IW_SCALE}; }
                    continue;
                }
                if (do_rope) {
                    const pg8::f32x4* cs = (const pg8::f32x4*)(rope + (size_t)mrow * 32 + 8 * fq);
                    pg8::f32x4 cv[4];
#pragma unroll
                    for (int k = 0; k < 4; ++k) cv[k] = cs[k];
#pragma unroll
                    for (int j = 0; j < 8; ++j) { const float c = cv[j >> 1][(j & 1) * 2], sn = cv[j >> 1][(j & 1) * 2 + 1];
                        const float a = x1[j] * c - x2[j] * sn, bb = x2[j] * c + x1[j] * sn; x1[j] = a; x2[j] = bb; }
                }
                if (pn < 3 || pn == 6) {
#pragma unroll
                    for (int j = 0; j < 8; ++j) { x1[j] *= C2; x2[j] *= C2; }
                }
                u32x4 w1, w2;
                if (f16out) {
                    w1.x = pk_f16(x1[0], x1[1]); w1.y = pk_f16(x1[2], x1[3]); w1.z = pk_f16(x1[4], x1[5]); w1.w = pk_f16(x1[6], x1[7]);
                    w2.x = pk_f16(x2[0], x2[1]); w2.y = pk_f16(x2[2], x2[3]); w2.z = pk_f16(x2[4], x2[5]); w2.w = pk_f16(x2[6], x2[7]);
                } else {
                    w1.x = pg8::cvt_pk_bf16(x1[0], x1[1]); w1.y = pg8::cvt_pk_bf16(x1[2], x1[3]); w1.z = pg8::cvt_pk_bf16(x1[4], x1[5]); w1.w = pg8::cvt_pk_bf16(x1[6], x1[7]);
                    w2.x = pg8::cvt_pk_bf16(x2[0], x2[1]); w2.y = pg8::cvt_pk_bf16(x2[2], x2[3]); w2.z = pg8::cvt_pk_bf16(x2[4], x2[5]); w2.w = pg8::cvt_pk_bf16(x2[6], x2[7]);
                }
                bf16_t *d1, *d2;
                if (pn < 3) { bf16_t* q = P + P1_Q + (size_t)mrow * 768 + (4 * pn + wc) * 64 + 8 * fq; d1 = q; d2 = q + 32; }
                else if (pn == 3) {
                    if (wc == 0) { bf16_t* k = P + P1_K + (size_t)mrow * 64 + 8 * fq; d1 = k; d2 = k + 32; }
                    else if (wc == 1) { bf16_t* v = P + P1_V + (size_t)mrow * 64 + 8 * fq; d1 = v; d2 = v + 32; }
                    else { bf16_t* k = P + P1_IK + ((((size_t)b * 128 + t) * 8 + fq) * 512 + r * 8); d1 = k; d2 = k + 4 * 512; }
                }
                else if (pn < 6) { bf16_t* q = P + P1_IQ + (size_t)mrow * 512 + (4 * (pn - 4) + wc) * 64 + 8 * fq; d1 = q; d2 = q + 32; }
                else { bf16_t* q = P + P1_QM + ((size_t)(b * 4 + wc) * S + s) * 64 + 8 * fq; d1 = q; d2 = q + 32; }
                *(u32x4*)d1 = w1; *(u32x4*)d2 = w2;
            }
    }
};
struct EpiMemKV {
    static constexpr bool PERM = true, AFTER_DRAIN = false;
    bf16_t* P;
    __device__ __forceinline__ void operator()(const pg8::f32x4 (&acc)[2][2][4][2], const pg8::Unit& u, int wr, int wc, int fr, int fq) const {
        const int b = u.pm;
#pragma unroll
        for (int ai = 0; ai < 2; ++ai)
#pragma unroll
            for (int mm = 0; mm < 4; ++mm) {
                const int mt = ai * 128 + wr * 64 + mm * 16 + fr; const int t = mt >> 6, r = mt & 63;
#pragma unroll
                for (int bj = 0; bj < 2; ++bj) {
                    const pg8::f32x4 v0 = acc[ai][bj][mm][0], v1 = acc[ai][bj][mm][1];
                    u32x4 w; w.x = pg8::cvt_pk_bf16(v0[0], v0[1]); w.y = pg8::cvt_pk_bf16(v0[2], v0[3]); w.z = pg8::cvt_pk_bf16(v1[0], v1[1]); w.w = pg8::cvt_pk_bf16(v1[2], v1[3]);
                    bf16_t* dst = (u.pn == 0) ? P + MKV_K + ((((size_t)(b * 4 + wc) * 4 + t) * 8 + 4 * bj + fq) * 512 + r * 8)
                                              : P + MKV_V + (((((size_t)(b * 4 + wc) * 4 + t) * 2 + bj) * 64 + r) * 32 + 8 * fq);
                    *(u32x4*)dst = w;
                }
            }
    }
};

#ifndef FA_SETPRIO
#define FA_SETPRIO 0
#endif
#ifndef FA_DEBUG_SYNC
#define FA_DEBUG_SYNC 0
#endif
namespace fa {
typedef short bf16x8 __attribute__((ext_vector_type(8)));
typedef short s16x4 __attribute__((ext_vector_type(4)));
typedef float f32x16 __attribute__((ext_vector_type(16)));
typedef __attribute__((address_space(3))) const char* lds_cptr;
typedef short v4i16_t __attribute__((ext_vector_type(4)));
__device__ __forceinline__ int crow(int r, int hi) { return (r & 3) + 8 * (r >> 2) + 4 * hi; }
__device__ __forceinline__ void glds16(const void* gsrc, unsigned lds_dst) { unsigned keep;
    asm volatile("s_mov_b32 %0, m0\n\ts_mov_b32 m0, %2\n\ts_nop 0\n\tglobal_load_lds_dwordx4 %1, off\n\ts_mov_b32 m0, %0" : "=&s"(keep) : "v"(gsrc), "s"(lds_dst) : "memory"); }
typedef float f32x2_t __attribute__((ext_vector_type(2))); typedef __bf16 bf16x2_t __attribute__((ext_vector_type(2)));
__device__ __forceinline__ unsigned cvtpk(float lo, float hi) { const f32x2_t v = {lo, hi}; return __builtin_bit_cast(unsigned, __builtin_convertvector(v, bf16x2_t)); }
__device__ __forceinline__ s16x4 vtr(lds_cptr p) { return __builtin_bit_cast(s16x4, __builtin_amdgcn_ds_read_tr16_b64_v4i16((__attribute__((address_space(3))) v4i16_t*)p)); }
__device__ __forceinline__ float swapmax(float m) { auto rr = __builtin_amdgcn_permlane32_swap(__float_as_uint(m), __float_as_uint(m), false, false); return fmaxf(__uint_as_float(rr[0]), __uint_as_float(rr[1])); }
__device__ __forceinline__ float swapsum(float m) { auto rr = __builtin_amdgcn_permlane32_swap(__float_as_uint(m), __float_as_uint(m), false, false); return __uint_as_float(rr[0]) + __uint_as_float(rr[1]); }

template <int NBR, int DV> struct Cfg {
    static constexpr int NVB = DV / 32, VBYTES = 64 * DV * 2, STG = NBR * 8192 + VBYTES, PPW = STG / 8192, ROWS = 256 / NBR;
    static constexpr int NSLOT = 4;
    static constexpr int EXCH_OFF = 65536;
};
struct Unit { const bf16_t* q0; const bf16_t* q1; const bf16_t* k0; const bf16_t* k1; const bf16_t* v; int qrow0; int nt; int same_tile; };

__device__ __forceinline__ void load_k(bf16x8 (&kf)[8], lds_cptr stage, int br, int r32, int hi) {
    const lds_cptr kp = stage + br * 8192 + hi * 1024 + r32 * 16;
#pragma unroll
    for (int d0 = 0; d0 < 4; ++d0) { kf[2 * d0] = *(const __attribute__((address_space(3))) bf16x8*)(kp + d0 * 2048); kf[2 * d0 + 1] = *(const __attribute__((address_space(3))) bf16x8*)(kp + d0 * 2048 + 512); }
}
template <int NVB> __device__ __forceinline__ void load_v(bf16x8 (&vf)[NVB], lds_cptr vp, int ks) {
#pragma unroll
    for (int db = 0; db < NVB; ++db) { const s16x4 lo = vtr(vp + db * 4096 + ks * 1024), hh = vtr(vp + db * 4096 + ks * 1024 + 512);
        vf[db] = (bf16x8){lo[0], lo[1], lo[2], lo[3], hh[0], hh[1], hh[2], hh[3]}; }
}
constexpr float THR = 8.0f;
template <int NBR, int DV> __device__ __forceinline__ void tile_x(lds_cptr stage, const bf16x8 (&kf)[8], const bf16x8 (&qr)[4], f32x16 (&o)[DV / 32], u32x4 (&pw)[4], f32x16& p0, f32x16& p1, bf16x8 (&vf0)[DV / 32], float& m, float& l, bool first, int hi, int lane) {
    typedef Cfg<NBR, DV> C;
    p0 = (f32x16){}; p1 = (f32x16){};
#pragma unroll
    for (int d0 = 0; d0 < 4; ++d0) {
        p0 = __builtin_amdgcn_mfma_f32_32x32x16_bf16(kf[2 * d0], qr[d0], p0, 0, 0, 0);
        p1 = __builtin_amdgcn_mfma_f32_32x32x16_bf16(kf[2 * d0 + 1], qr[d0], p1, 0, 0, 0);
    }
    const lds_cptr vp = stage + NBR * 8192 + ((lane >> 4) & 1) * 32 + (lane & 3) * 8 + (4 * hi + ((lane & 15) >> 2)) * 64;
    load_v<C::NVB>(vf0, vp, 0);
    __builtin_amdgcn_sched_barrier(0);
#pragma unroll
    for (int r = 0; r < 16; ++r) { p0[r] -= m; p1[r] -= m; }
    float mx = fmaxf(p0[0], p1[0]);
#pragma unroll
    for (int r = 1; r < 16; ++r) mx = fmaxf(mx, fmaxf(p0[r], p1[r]));
    mx = swapmax(mx);
    if (first || __any(mx > THR)) {
        const float dl = first ? mx : fmaxf(mx, 0.f), alpha = __builtin_amdgcn_exp2f(-dl);
        m += dl; l *= alpha;
#pragma unroll
        for (int r = 0; r < 16; ++r) { p0[r] -= dl; p1[r] -= dl; }
#pragma unroll
        for (int db = 0; db < C::NVB; ++db)
#pragma unroll
            for (int r = 0; r < 16; ++r) o[db][r] *= alpha;
    }
    float ls = 0.f;
#pragma unroll
    for (int r = 0; r < 8; ++r) { p0[r] = __builtin_amdgcn_exp2f(p0[r]); ls += p0[r]; }
    l += ls;
#pragma unroll
    for (int i = 0; i < 4; ++i) pw[0][i] = cvtpk(p0[2 * i], p0[2 * i + 1]);
    __builtin_amdgcn_sched_barrier(0);
}
#define FA_PIN4(a) asm volatile("" : "+v"(a[0]), "+v"(a[1]), "+v"(a[2]), "+v"(a[3]))
template <int NBR, int DV> __device__ __forceinline__ void tile_y(lds_cptr stage, lds_cptr stage_next, bool load_next, int br, f32x16 (&o)[DV / 32], u32x4 (&pw)[4], f32x16& p0, f32x16& p1, float& l, bf16x8 (&vf0)[DV / 32], bf16x8 (&kf)[8], int r32, int hi, int lane) {
    typedef Cfg<NBR, DV> C;
    const lds_cptr vp = stage + NBR * 8192 + ((lane >> 4) & 1) * 32 + (lane & 3) * 8 + (4 * hi + ((lane & 15) >> 2)) * 64;
    if (load_next) load_k(kf, stage_next, br, r32, hi);
    bf16x8 vf1[C::NVB];
    load_v<C::NVB>(vf1, vp, 1);
    __builtin_amdgcn_sched_barrier(0);
    float ls = 0.f;
    constexpr int E = 8 / C::NVB;
#pragma unroll
    for (int db = 0; db < C::NVB; ++db) { o[db] = __builtin_amdgcn_mfma_f32_32x32x16_bf16(vf0[db], __builtin_bit_cast(bf16x8, pw[0]), o[db], 0, 0, 0);
#pragma unroll
        for (int e = 0; e < E; ++e) p0[8 + E * db + e] = __builtin_amdgcn_exp2f(p0[8 + E * db + e]);
#pragma unroll
        for (int e = 0; e < E / 2; ++e) { const int i = (E / 2) * db + e; pw[1][i] = cvtpk(p0[8 + 2 * i], p0[9 + 2 * i]); ls += p0[8 + 2 * i] + p0[9 + 2 * i]; }
        asm volatile("" : "+v"(p0), "+v"(pw[1]), "+v"(ls));
        __builtin_amdgcn_sched_barrier(0); }
    load_v<C::NVB>(vf0, vp, 2);
    __builtin_amdgcn_sched_barrier(0);
#pragma unroll
    for (int db = 0; db < C::NVB; ++db) { o[db] = __builtin_amdgcn_mfma_f32_32x32x16_bf16(vf1[db], __builtin_bit_cast(bf16x8, pw[1]), o[db], 0, 0, 0);
#pragma unroll
        for (int e = 0; e < E; ++e) p1[E * db + e] = __builtin_amdgcn_exp2f(p1[E * db + e]);
#pragma unroll
        for (int e = 0; e < E / 2; ++e) { const int i = (E / 2) * db + e; pw[2][i] = cvtpk(p1[2 * i], p1[2 * i + 1]); ls += p1[2 * i] + p1[2 * i + 1]; }
        asm volatile("" : "+v"(p1), "+v"(pw[2]), "+v"(ls));
        __builtin_amdgcn_sched_barrier(0); }
    load_v<C::NVB>(vf1, vp, 3);
    __builtin_amdgcn_sched_barrier(0);
#pragma unroll
    for (int db = 0; db < C::NVB; ++db) { o[db] = __builtin_amdgcn_mfma_f32_32x32x16_bf16(vf0[db], __builtin_bit_cast(bf16x8, pw[2]), o[db], 0, 0, 0);
#pragma unroll
        for (int e = 0; e < E; ++e) p1[8 + E * db + e] = __builtin_amdgcn_exp2f(p1[8 + E * db + e]);
#pragma unroll
        for (int e = 0; e < E / 2; ++e) { const int i = (E / 2) * db + e; pw[3][i] = cvtpk(p1[8 + 2 * i], p1[9 + 2 * i]); ls += p1[8 + 2 * i] + p1[9 + 2 * i]; }
        asm volatile("" : "+v"(p1), "+v"(pw[3]), "+v"(ls));
        __builtin_amdgcn_sched_barrier(0); }
#pragma unroll
    for (int db = 0; db < C::NVB; ++db) o[db] = __builtin_amdgcn_mfma_f32_32x32x16_bf16(vf1[db], __builtin_bit_cast(bf16x8, pw[3]), o[db], 0, 0, 0);
    l += ls;
    __builtin_amdgcn_sched_barrier(0);
}

template <int NBR, int DV> __device__ __forceinline__ void attn_unit(const Unit& U, bool causal, bf16_t* out, int out_row0, int ocol, float lam, const float* gsub, float oscale, LAS unsigned char* lds_) {
    typedef Cfg<NBR, DV> C;
    const int tid = fresh_tid(), lane = tid & 63, r32 = lane & 31, hi = lane >> 5; const int wid = __builtin_amdgcn_readfirstlane(tid >> 6);
    const int br = (NBR == 2) ? (wid >> 2) : 0, rw = (NBR == 2) ? (wid & 3) : wid;
    const lds_cptr lds = (lds_cptr)lds_;
    const unsigned lds0 = (unsigned)(uintptr_t)lds_;
    const int myrow0 = U.qrow0 + 32 * rw;
    const int NT = U.nt, my_nt = causal ? ((myrow0 >> 6) + 1) : NT;
    const int pc0 = wid * C::PPW;
    const char* src; int srcstep;
    if (pc0 < 8 * NBR) { src = (const char*)((pc0 >> 3) ? U.k1 : U.k0) + (pc0 & 7) * 1024; srcstep = 8192; }
    else { src = (const char*)U.v + (pc0 - 8 * NBR) * 1024; srcstep = C::VBYTES; }
    src += lane * 16;
    if (U.same_tile) srcstep = 0;
    const unsigned dst0 = lds0 + pc0 * 1024;
#if FA_DEBUG_SYNC == 2
#define FA_DMA(t, slot) do { _Pragma("unroll") for (int i_ = 0; i_ < C::PPW; ++i_) { const u32x4 v_ = *(const u32x4*)(src + (size_t)(t) * srcstep + i_ * 1024); \
        *(LAS u32x4*)(lds_ + pc0 * 1024 + (slot) * C::STG + i_ * 1024 + lane * 16) = v_; } } while (0)
#else
#define FA_DMA(t, slot) do { _Pragma("unroll") for (int i_ = 0; i_ < C::PPW; ++i_) glds16(src + (size_t)(t) * srcstep + i_ * 1024, (unsigned)__builtin_amdgcn_readfirstlane(dst0 + (slot) * C::STG + i_ * 1024)); } while (0)
#endif
    bf16x8 qr[4];
    FA_DMA(0, 0);
    if (NT > 1) FA_DMA(1, 1);
    if (NT > 2) FA_DMA(2, 2);
    { const bf16_t* qp = (br ? U.q1 : U.q0) + (size_t)(myrow0 + r32) * 64 + hi * 8;
#pragma unroll
      for (int d0 = 0; d0 < 4; ++d0) qr[d0] = *(const bf16x8*)(qp + d0 * 16);
      asm volatile("" : "+v"(qr[0]), "+v"(qr[1]), "+v"(qr[2]), "+v"(qr[3])); }
    f32x16 o[C::NVB];
#pragma unroll
    for (int db = 0; db < C::NVB; ++db) o[db] = (f32x16){};
    float m = 0.f, l = 0.f;
    const bool late = wid >= 4;
#if FA_SETPRIO
    if (late) __builtin_amdgcn_s_setprio(1);
#endif
    u32x4 pw[4]; f32x16 p0c, p1c; bf16x8 kf[8], vf0[C::NVB];
    asm volatile("s_waitcnt vmcnt(0) lgkmcnt(0)" ::: "memory");
    if (late) asm volatile("s_barrier" ::: "memory");
    asm volatile("s_barrier" ::: "memory");
    load_k(kf, lds, br, r32, hi);
#pragma unroll 1
    for (int t = 0; t < NT; ++t) {
        const lds_cptr st = lds + (t & 3) * C::STG;
        if (t < my_nt) tile_x<NBR, DV>(st, kf, qr, o, pw, p0c, p1c, vf0, m, l, t == 0, hi, lane);
        if (t + 2 < NT) { if (C::PPW == 4) asm volatile("s_waitcnt vmcnt(4) lgkmcnt(0)\n\ts_barrier" ::: "memory"); else asm volatile("s_waitcnt vmcnt(2) lgkmcnt(0)\n\ts_barrier" ::: "memory"); }
        else asm volatile("s_waitcnt vmcnt(0) lgkmcnt(0)\n\ts_barrier" ::: "memory");
        if (t + 3 < NT && (U.same_tile < 2 || t == 0)) FA_DMA(t + 3, (t + 3) & 3);
        if (t < my_nt) tile_y<NBR, DV>(st, lds + ((t + 1) & 3) * C::STG, t + 1 < my_nt, br, o, pw, p0c, p1c, l, vf0, kf, r32, hi, lane);
        asm volatile("s_waitcnt lgkmcnt(0)\n\ts_barrier" ::: "memory");
    }
    if (!late) asm volatile("s_barrier" ::: "memory");
#if FA_SETPRIO
    if (late) __builtin_amdgcn_s_setprio(0);
#endif
#undef FA_DMA
    asm volatile("s_waitcnt vmcnt(0) lgkmcnt(0)\n\ts_barrier" ::: "memory");
    l = swapsum(l);
    if (NBR == 2) {
        LAS float* ex = (LAS float*)(lds_ + C::EXCH_OFF) + rw * 4096 + lane;
        if (br == 1) {
            const float f = lam / l;
#pragma unroll
            for (int db = 0; db < C::NVB; ++db)
#pragma unroll
                for (int r = 0; r < 16; ++r) ex[(db * 16 + r) * 64] = o[db][r] * f;
        }
        asm volatile("s_waitcnt lgkmcnt(0)\n\ts_barrier" ::: "memory");
        if (br == 0) {
            const float il = 1.f / l; float ss = 0.f;
#pragma unroll
            for (int db = 0; db < C::NVB; ++db)
#pragma unroll
                for (int r = 0; r < 16; ++r) { const float v = o[db][r] * il - ex[(db * 16 + r) * 64]; o[db][r] = v; ss += v * v; }
            ss = swapsum(ss);
            const float rstd = oscale / sqrtf(ss * (1.f / (float)DV) + EPS);
            bf16_t* orow = out + (size_t)(out_row0 + myrow0 + r32) * D + ocol + 4 * hi;
#pragma unroll
            for (int db = 0; db < C::NVB; ++db)
#pragma unroll
                for (int g = 0; g < 4; ++g) { const f32x4 gg = *(const f32x4*)(gsub + db * 32 + 8 * g + 4 * hi);
                    uint2 w; w.x = cvtpk(o[db][4 * g] * rstd * gg.x, o[db][4 * g + 1] * rstd * gg.y); w.y = cvtpk(o[db][4 * g + 2] * rstd * gg.z, o[db][4 * g + 3] * rstd * gg.w);
                    *(uint2*)(orow + db * 32 + 8 * g) = w; }
        }
    } else {
        const float il = 1.f / l;
        bf16_t* orow = out + (size_t)(out_row0 + myrow0 + r32) * D + ocol + 4 * hi;
#pragma unroll
        for (int db = 0; db < C::NVB; ++db)
#pragma unroll
            for (int g = 0; g < 4; ++g) { uint2 w; w.x = cvtpk(o[db][4 * g] * il, o[db][4 * g + 1] * il); w.y = cvtpk(o[db][4 * g + 2] * il, o[db][4 * g + 3] * il);
                *(uint2*)(orow + db * 32 + 8 * g) = w; }
    }
    asm volatile("s_waitcnt lgkmcnt(0)\n\ts_barrier" ::: "memory");
}
}

namespace sa {
typedef short bf16x8 __attribute__((ext_vector_type(8)));
typedef short s16x4 __attribute__((ext_vector_type(4)));
typedef short v4i16_t __attribute__((ext_vector_type(4)));
typedef unsigned u32x2 __attribute__((ext_vector_type(2)));
typedef __attribute__((address_space(3))) const char* lds_cptr;
constexpr int VROW = 144, WLDS = 512 + 64 * VROW;
static_assert(8 * WLDS <= 131072, "sparse attention LDS");
__device__ __forceinline__ s16x4 vtr(lds_cptr p) { return __builtin_bit_cast(s16x4, __builtin_amdgcn_ds_read_tr16_b64_v4i16((__attribute__((address_space(3))) v4i16_t*)p)); }
__device__ __forceinline__ unsigned pk(float lo, float hi) { typedef float f2 __attribute__((ext_vector_type(2))); typedef __bf16 b2 __attribute__((ext_vector_type(2))); const f2 v = {lo, hi}; return __builtin_bit_cast(unsigned, __builtin_convertvector(v, b2)); }
__device__ __forceinline__ float xmax(float v) { v = fmaxf(v, __shfl_xor(v, 16)); return fmaxf(v, __shfl_xor(v, 32)); }
__device__ __forceinline__ float xsum(float v) { v += __shfl_xor(v, 16); return v + __shfl_xor(v, 32); }

__device__ __forceinline__ void query(int m, int b, int nvalid, const bf16_t* __restrict__ P, const LAS unsigned short* idxs, LAS unsigned char* vst, bf16_t* __restrict__ O, int lane) {
    const int ks = lane & 15, kq = lane >> 4;
    const bf16_t* qp = P + P1_Q + (size_t)m * 768 + (ks < 12 ? ks : 11) * 64 + 8 * kq;
    const bf16x8 q0 = *(const bf16x8*)qp, q1 = *(const bf16x8*)(qp + 32);
    const u32x4 ia = *(const LAS u32x4*)(idxs + 16 * ks), ib = *(const LAS u32x4*)(idxs + 16 * ks + 8);
    const unsigned iw[8] = {ia.x, ia.y, ia.z, ia.w, ib.x, ib.y, ib.z, ib.w};
    const bf16_t* Kb = P + P1_K + (size_t)b * S * 64 + 8 * kq;
    const bf16_t* Vb = P + P1_V + (size_t)b * S * 64 + 8 * (lane & 7);
    f32x4 Sx[16];
    {
        bf16x8 ka[16], kb[16];
#pragma unroll
        for (int g = 0; g < 16; ++g) { const unsigned id = (g & 1) ? (iw[g >> 1] >> 16) : (iw[g >> 1] & 0xFFFFu);
            const bf16_t* kp = Kb + (size_t)id * 64; ka[g] = *(const bf16x8*)kp; kb[g] = *(const bf16x8*)(kp + 32); }
#pragma unroll
        for (int g = 0; g < 16; ++g) {
            Sx[g] = __builtin_amdgcn_mfma_f32_16x16x32_bf16(ka[g], q0, (f32x4){0.f, 0.f, 0.f, 0.f}, 0, 0, 0);
            Sx[g] = __builtin_amdgcn_mfma_f32_16x16x32_bf16(kb[g], q1, Sx[g], 0, 0, 0); }
    }
    __builtin_amdgcn_sched_barrier(0);
    u32x4 vv[32];
#pragma unroll
    for (int i = 0; i < 24; ++i) { const int g = i >> 1; const unsigned id = idxs[16 * (8 * (i & 1) + (lane >> 3)) + g]; vv[i] = *(const u32x4*)(Vb + (size_t)id * 64); }
    __builtin_amdgcn_sched_barrier(0);
    float mx = -INFINITY;
#pragma unroll
    for (int g = 0; g < 16; ++g)
#pragma unroll
        for (int r = 0; r < 4; ++r) { if (64 * kq + 16 * r + g >= nvalid) Sx[g][r] = -INFINITY; mx = fmaxf(mx, Sx[g][r]); }
    mx = xmax(mx);
    float sum = 0.f;
#pragma unroll
    for (int g = 0; g < 16; ++g)
#pragma unroll
        for (int r = 0; r < 4; ++r) { Sx[g][r] = __builtin_amdgcn_exp2f(Sx[g][r] - mx); sum += Sx[g][r]; }
    sum = xsum(sum);
    f32x4 o[4];
#pragma unroll
    for (int n = 0; n < 4; ++n) o[n] = (f32x4){0.f, 0.f, 0.f, 0.f};
    const lds_cptr vrd = (lds_cptr)vst + (4 * kq + ((lane & 15) >> 2)) * VROW + (lane & 3) * 8;
#pragma unroll
    for (int vb = 0; vb < 4; ++vb) {
        __builtin_amdgcn_sched_barrier(0);
#pragma unroll
        for (int i = 0; i < 8; ++i) *(LAS u32x4*)(vst + (8 * i + (lane >> 3)) * VROW + (lane & 7) * 16) = vv[8 * vb + i];
        if (vb == 0) {
#pragma unroll
            for (int i = 24; i < 32; ++i) { const int g = i >> 1; const unsigned id = idxs[16 * (8 * (i & 1) + (lane >> 3)) + g]; vv[i] = *(const u32x4*)(Vb + (size_t)id * 64); }
        }
#pragma unroll
        for (int Gl = 0; Gl < 2; ++Gl) {
            const int G2 = 2 * vb + Gl;
            u32x4 pw; pw.x = pk(Sx[2 * G2][0], Sx[2 * G2][1]); pw.y = pk(Sx[2 * G2][2], Sx[2 * G2][3]); pw.z = pk(Sx[2 * G2 + 1][0], Sx[2 * G2 + 1][1]); pw.w = pk(Sx[2 * G2 + 1][2], Sx[2 * G2 + 1][3]);
#pragma unroll
            for (int n = 0; n < 4; ++n) {
                const s16x4 lo = vtr(vrd + (32 * Gl) * VROW + n * 32), hh = vtr(vrd + (32 * Gl + 16) * VROW + n * 32);
                const bf16x8 vf = (bf16x8){lo[0], lo[1], lo[2], lo[3], hh[0], hh[1], hh[2], hh[3]};
                o[n] = __builtin_amdgcn_mfma_f32_16x16x32_bf16(vf, __builtin_bit_cast(bf16x8, pw), o[n], 0, 0, 0);
            }
        }
    }
    __builtin_amdgcn_sched_barrier(0);
    if (ks < 12) {
        const float il = 1.f / sum;
        bf16_t* op = O + (size_t)m * D + ks * 64 + 4 * kq;
#pragma unroll
        for (int n = 0; n < 4; ++n) { u32x2 w; w.x = pk(o[n][0] * il, o[n][1] * il); w.y = pk(o[n][2] * il, o[n][3] * il); *(u32x2*)(op + 16 * n) = w; }
    }
}

__device__ __forceinline__ void ph_dsa_attn(const bf16_t* P, const unsigned short* topk, bf16_t* O, LAS unsigned char* lds) {
    const int tid = fresh_tid(), lane = tid & 63; const int wid = __builtin_amdgcn_readfirstlane(tid >> 6);
    LAS unsigned char* wl = lds + wid * WLDS;
    const int G = (int)gridDim.x, bid = (int)blockIdx.x;
    const int b0 = bid & 7, w0 = (bid >> 3) * 8 + wid;
#pragma unroll 1
    for (int i = 0; i < M / (G * NWAVES); ++i) {
        int m, b, t;
        if (G == 256) { b = b0; t = w0 + 256 * i; m = b * S + t; } else { m = (i * G + bid) * NWAVES + wid; b = m / S; t = m % S; }
        const int nv = 64 * (t / 64 + 1);
        { u32x2 iv = *(const u32x2*)(topk + (size_t)m * 256 + 4 * lane);
          if ((iv.x & 0xFFFFu) == 0xFFFFu) iv.x &= 0xFFFF0000u; if ((iv.x >> 16) == 0xFFFFu) iv.x &= 0x0000FFFFu;
          if ((iv.y & 0xFFFFu) == 0xFFFFu) iv.y &= 0xFFFF0000u; if ((iv.y >> 16) == 0xFFFFu) iv.y &= 0x0000FFFFu;
          *(LAS u32x2*)((LAS unsigned short*)wl + 4 * lane) = iv; }
        query(m, b, nv < 256 ? nv : 256, P, (const LAS unsigned short*)wl, wl + 512, O, lane);
    }
}
}

#ifndef IX_FUSE_SA
#define IX_FUSE_SA 0
#endif
namespace ix {
typedef _Float16 f16x8 __attribute__((ext_vector_type(8)));
typedef float f32x16 __attribute__((ext_vector_type(16)));
constexpr int HROW = 513 * 4;
constexpr int L_HIST = 0, L_BMAP = 0, BROW = 1024;
constexpr int L_ROW = 32 * HROW;
constexpr int POOL = 3072;
constexpr int L_CK = L_ROW + 32 * 32;
constexpr int L_CI = L_CK + POOL * 8;
constexpr int L_IDX = 94208;
constexpr int L_END = L_IDX + 32 * 512;
static_assert(L_CI <= L_IDX, "indexer LDS map");
static_assert(L_END <= 131072, "indexer LDS map");
constexpr float BIN_K = 2.0f, BIN_OFF = 256.0f;

__device__ __forceinline__ unsigned bin_of(float s, float scale) { const float t = __builtin_fmaf(s, scale, BIN_OFF); return (unsigned)(int)__builtin_amdgcn_fmed3f(t, 0.0f, 511.0f); }
__device__ __forceinline__ unsigned wave_incl_scan(unsigned x) {
    x += (unsigned)__builtin_amdgcn_update_dpp(0, (int)x, 0x111, 0xF, 0xF, false);
    x += (unsigned)__builtin_amdgcn_update_dpp(0, (int)x, 0x112, 0xF, 0xF, false);
    x += (unsigned)__builtin_amdgcn_update_dpp(0, (int)x, 0x114, 0xF, 0xF, false);
    x += (unsigned)__builtin_amdgcn_update_dpp(0, (int)x, 0x118, 0xF, 0xF, false);
    x += (unsigned)__builtin_amdgcn_update_dpp(0, (int)x, 0x142, 0xA, 0xF, false);
    x += (unsigned)__builtin_amdgcn_update_dpp(0, (int)x, 0x143, 0xC, 0xF, false);
    return x;
}
__device__ __forceinline__ unsigned skey(unsigned bits) { return (bits & 0x80000000u) ? ~bits : (bits | 0x80000000u); }

__device__ __forceinline__ void topk_row_exact(int m, const bf16_t* __restrict__ proj, unsigned short* __restrict__ topk, LAS unsigned char* lds) {
    LAS unsigned* keys = (LAS unsigned*)lds;
    LAS float* iqs = (LAS float*)(lds + 32768);
    LAS float* ws = (LAS float*)(lds + 32768 + 2048);
    LAS unsigned* cnt_s = (LAS unsigned*)(lds + 32768 + 2048 + 64);
    LAS unsigned* scan_g = (LAS unsigned*)(lds + 36864);
    LAS unsigned* scan_e = (LAS unsigned*)(lds + 36864 + 2048);
    const int tid = fresh_tid();
    const int b = m / S, t = m % S; const int n = 64 * (t / 64 + 1);
    unsigned short* out = topk + (size_t)m * 256;
    __syncthreads();
    iqs[tid] = (float)((const _Float16*)(proj + P1_IQ))[(size_t)m * 512 + tid];
    if (tid < 8) ws[tid] = ((const float*)(proj + P1_IW))[(size_t)m * 8 + tid];
    __syncthreads();
    for (int j = tid; j < n; j += NTHR) {
        const _Float16* kp = (const _Float16*)(proj + P1_IK) + (((size_t)b * 128 + (j >> 6)) * 8) * 512 + (j & 63) * 8;
        float kf[64];
#pragma unroll
        for (int d = 0; d < 64; ++d) kf[d] = (float)kp[(d >> 3) * 512 + (d & 7)];
        float sc = 0.f;
#pragma unroll 1
        for (int hh = 0; hh < 8; ++hh) { float lg = 0.f;
#pragma unroll
            for (int d = 0; d < 64; ++d) lg += iqs[hh * 64 + d] * kf[d];
            sc += fmaxf(lg, 0.f) * ws[hh]; }
        sc += 0.0f;
        keys[j] = skey(__float_as_uint(sc));
    }
    __syncthreads();
    unsigned T = 0u;
    for (int bit = 31; bit >= 0; --bit) {
        const unsigned cand = T | (1u << bit);
        if (tid == 0) cnt_s[0] = 0u;
        __syncthreads();
        unsigned c0 = 0u;
        for (int j = tid; j < n; j += NTHR) c0 += (keys[j] >= cand) ? 1u : 0u;
        c0 = (unsigned)wave_sum((float)c0);
        if ((tid & 63) == 0) atomicAdd((unsigned*)cnt_s, c0);
        __syncthreads();
        if (cnt_s[0] >= 256u) T = cand;
        __syncthreads();
    }
    const int per = (n + NTHR - 1) / NTHR; const int j0 = tid * per, j1 = (j0 + per < n) ? j0 + per : n;
    unsigned g = 0u, e = 0u;
    for (int j = j0; j < j1; ++j) { const unsigned k = keys[j]; g += (k > T) ? 1u : 0u; e += (k == T) ? 1u : 0u; }
    scan_g[tid] = g; scan_e[tid] = e;
    __syncthreads();
    unsigned pg = 0u, pe = 0u, tg = 0u, te = 0u;
    for (int i = 0; i < NTHR; ++i) { const unsigned gi = scan_g[i], ei = scan_e[i]; if (i < tid) { pg += gi; pe += ei; } tg += gi; te += ei; }
    const unsigned R = 256u - tg;
    unsigned pos = pg + (pe < R ? pe : R), oe = pe;
    for (int j = j0; j < j1; ++j) { const unsigned k = keys[j];
        if (k > T) { out[pos] = (unsigned short)j; ++pos; }
        else if (k == T) { if (oe < R) { out[pos] = (unsigned short)j; ++pos; } ++oe; } }
    __syncthreads();
}

__device__ __forceinline__ void score_tile(f32x4 (&sc)[4], const f16x8 (&kf)[4][2], const f16x8 (&iqf)[8][2], const f16x8 (&cf)[2], const float (&w)[8]) {
#pragma unroll
    for (int blk = 0; blk < 4; ++blk) sc[blk] = __builtin_amdgcn_mfma_f32_16x16x32_f16(kf[blk][0], cf[0], (f32x4){0.f, 0.f, 0.f, 0.f}, 0, 0, 0);
#pragma unroll
    for (int blk = 0; blk < 4; ++blk) sc[blk] = __builtin_amdgcn_mfma_f32_16x16x32_f16(kf[blk][1], cf[1], sc[blk], 0, 0, 0);
#pragma unroll
    for (int h = 0; h < 8; ++h) {
        f32x4 L[4];
#pragma unroll
        for (int blk = 0; blk < 4; ++blk) L[blk] = __builtin_amdgcn_mfma_f32_16x16x32_f16(kf[blk][0], iqf[h][0], (f32x4){0.f, 0.f, 0.f, 0.f}, 0, 0, 0);
#pragma unroll
        for (int blk = 0; blk < 4; ++blk) L[blk] = __builtin_amdgcn_mfma_f32_16x16x32_f16(kf[blk][1], iqf[h][1], L[blk], 0, 0, 0);
#pragma unroll
        for (int blk = 0; blk < 4; ++blk)
#pragma unroll
            for (int r = 0; r < 4; ++r) sc[blk][r] = __builtin_fmaf(__builtin_fabsf(L[blk][r]), w[h], sc[blk][r]);
        asm volatile("" : "+v"(sc[0]), "+v"(sc[1]), "+v"(sc[2]), "+v"(sc[3]));
        __builtin_amdgcn_sched_barrier(0);
    }
}
#define IX_LOADK(dst, t_) do { _Pragma("unroll") for (int blk_ = 0; blk_ < 4; ++blk_) _Pragma("unroll") for (int s_ = 0; s_ < 2; ++s_) dst[blk_][s_] = *(const f16x8*)(ikb + (size_t)(t_) * 8192 + s_ * 4096 + blk_ * 256); } while (0)

template <class SAQ> __device__ __forceinline__ void topk_unit(int b, int j, const bf16_t* __restrict__ proj, unsigned short* __restrict__ topk, unsigned long long* scr, LAS unsigned char* lds, bool force_exact, const SAQ& attend) {
    const int tid = fresh_tid(), lane = tid & 63, q16 = lane & 15, kq = lane >> 4; const int wid = __builtin_amdgcn_readfirstlane(tid >> 6);
    const int qh = wid >> 2, kw = wid & 3, qr = 16 * qh + q16;
    const int row0 = 32 * j, c = row0 >> 6, n = 64 * (c + 1), NT = c + 1;
    const size_t m0 = (size_t)b * S + row0;
    LAS unsigned short* idxl = (LAS unsigned short*)(lds + L_IDX);
    if (n <= 256 || force_exact) {
        if (n <= 256) { for (int i = tid; i < 32 * 256; i += NTHR) { const int k = i & 255; idxl[i] = (k < n) ? (unsigned short)k : (unsigned short)0; } }
        else { for (int r = 0; r < 32; ++r) topk_row_exact((int)m0 + r, proj, topk, lds);
               for (int i = tid; i < 32 * 256; i += NTHR) idxl[i] = topk[m0 * 256 + i]; }
        asm volatile("s_waitcnt vmcnt(0) lgkmcnt(0)\n\ts_barrier" ::: "memory");
        if (IX_FUSE_SA) {
#pragma unroll 1
            for (int rr = 0; rr < 4; ++rr) attend(m0 + 4 * wid + rr, b, n < 256 ? n : 256, idxl + (4 * wid + rr) * 256, lds + wid * 9216, lane);
        } else { for (int i = tid; i < 32 * 128; i += NTHR) ((unsigned*)(topk + m0 * 256))[i] = ((const LAS unsigned*)idxl)[i]; }
        asm volatile("s_waitcnt lgkmcnt(0)\n\ts_barrier" ::: "memory");
        return;
    }
    for (int i = tid; i < (32 * HROW) / 4; i += NTHR) ((LAS unsigned*)(lds + L_HIST))[i] = 0u;
    f16x8 iqf[8][2], cf[2]; float w[8]; float bscale;
    {
        const _Float16* iqp = (const _Float16*)(proj + P1_IQ) + (m0 + qr) * 512 + 8 * kq;
#pragma unroll
        for (int h = 0; h < 8; ++h)
#pragma unroll
            for (int s2 = 0; s2 < 2; ++s2) iqf[h][s2] = *(const f16x8*)(iqp + h * 64 + s2 * 32);
        const float* wp = (const float*)(proj + P1_IW) + (m0 + qr) * 8;
        const f32x4 w0 = *(const f32x4*)wp, w1 = *(const f32x4*)(wp + 4);
        w[0] = 0.5f * w0.x; w[1] = 0.5f * w0.y; w[2] = 0.5f * w0.z; w[3] = 0.5f * w0.w; w[4] = 0.5f * w1.x; w[5] = 0.5f * w1.y; w[6] = 0.5f * w1.z; w[7] = 0.5f * w1.w;
        { float ss = 0.f;
#pragma unroll
          for (int h = 0; h < 8; ++h) ss = __builtin_fmaf(w[h], w[h], ss);
          bscale = __builtin_amdgcn_fmed3f(BIN_K * __builtin_amdgcn_rsqf(ss), 0.125f, 65536.0f); }
#pragma unroll
        for (int s2 = 0; s2 < 2; ++s2)
#pragma unroll
            for (int e = 0; e < 8; ++e) { float a = 0.f;
#pragma unroll
                for (int h = 0; h < 8; ++h) a = __builtin_fmaf(w[h], (float)iqf[h][s2][e], a);
                cf[s2][e] = (_Float16)a; }
    }
    const char* ikb = (const char*)((const _Float16*)(proj + P1_IK) + (size_t)b * S * 64) + kq * 1024 + q16 * 16;
    asm volatile("s_waitcnt lgkmcnt(0)\n\ts_barrier" ::: "memory");
#ifndef IX_PROBE
#define IX_PROBE 0
#endif
#pragma unroll 1
    for (int rep = 0; rep < ((IX_PROBE == 1 || IX_PROBE == 2) ? 2 : 1); ++rep) {
        const unsigned addv = rep ? 0u : 1u; unsigned dummy = 0u;
        LAS unsigned char* hrow = lds + L_HIST + qr * HROW;
        unsigned long long* swr = scr + (size_t)qh * 32768 + q16 * 4 + kq;
        f16x8 kf[4][2], kn[4][2];
        if (kw < NT) IX_LOADK(kn, kw);
#pragma unroll 1
        for (int t = kw; t < NT; t += 4) {
#pragma unroll
            for (int blk = 0; blk < 4; ++blk) { kf[blk][0] = kn[blk][0]; kf[blk][1] = kn[blk][1]; }
            if (t + 4 < NT) IX_LOADK(kn, t + 4);
            __builtin_amdgcn_sched_barrier(0);
            f32x4 sc[4]; score_tile(sc, kf, iqf, cf, w);
            __builtin_amdgcn_sched_barrier(0);
#pragma unroll
            for (int blk = 0; blk < 4; ++blk) {
                typedef _Float16 h4 __attribute__((ext_vector_type(4)));
                const h4 hs = __builtin_convertvector(sc[blk], h4);
                swr[(size_t)t * 256 + blk * 64] = __builtin_bit_cast(unsigned long long, hs);
#pragma unroll
                for (int r = 0; r < 4; ++r) { const unsigned bn = bin_of((float)hs[r], bscale);
                    if (IX_PROBE == 2 && rep) dummy ^= bn; else __hip_atomic_fetch_add((LAS unsigned*)(hrow + bn * 4), addv, __ATOMIC_RELAXED, __HIP_MEMORY_SCOPE_WORKGROUP); }
            }
        }
        if (IX_PROBE == 2 && dummy == 0xFFFFFFFFu) ((LAS unsigned*)(lds + L_ROW))[7] = 0u;
    }
    asm volatile("s_waitcnt lgkmcnt(0)\n\ts_barrier" ::: "memory");
#pragma unroll 1
    for (int rr_ = 0; rr_ < (IX_PROBE == 3 ? 8 : 4); ++rr_) { const int rr = rr_ & 3;
        const int q = 4 * wid + rr;
        const LAS unsigned* hr = (const LAS unsigned*)(lds + L_HIST + q * HROW);
        unsigned cb[8]; unsigned tot = 0u;
#pragma unroll
        for (int i = 0; i < 8; ++i) { cb[i] = hr[511 - 8 * lane - i]; tot += cb[i]; }
        unsigned incl = tot;
#pragma unroll
        for (int o = 1; o < 64; o <<= 1) { const unsigned v = __shfl_up(incl, o); if (lane >= o) incl += v; }
        const unsigned excl = incl - tot;
        const unsigned long long bal = __ballot(incl >= 256u);
        const int L = __builtin_ctzll(bal);
        unsigned run = excl; int tbi = 0; unsigned above = 0u, mcnt = 0u; bool found = false;
#pragma unroll
        for (int i = 0; i < 8; ++i) { if (!found) { if (run + cb[i] >= 256u) { found = true; tbi = 511 - 8 * lane - i; above = run; mcnt = cb[i]; } else run += cb[i]; } }
        const unsigned tb = (unsigned)__shfl(tbi, L), ab = __shfl(above, L), mc = __shfl(mcnt, L);
        if (lane < 8) ((LAS unsigned*)(lds + L_ROW))[8 * q + lane] = (lane == 0) ? tb : (lane == 1) ? ab : (lane == 2) ? mc : 0u;
    }
    asm volatile("s_waitcnt lgkmcnt(0)\n\ts_barrier" ::: "memory");
    for (int i = tid; i < (32 * BROW) / 4; i += NTHR) ((LAS unsigned*)(lds + L_BMAP))[i] = 0u;
    asm volatile("s_waitcnt lgkmcnt(0)\n\ts_barrier" ::: "memory");
    unsigned my_off, my_lim;
    {
        const unsigned Ml = (lane < 32) ? ((const LAS unsigned*)(lds + L_ROW))[8 * (lane & 31) + 2] : 0u;
        unsigned incl = Ml;
#pragma unroll
        for (int o = 1; o < 32; o <<= 1) { const unsigned v = __shfl_up(incl, o); if (lane >= o) incl += v; }
        const bool fits = (incl <= (unsigned)POOL) && (Ml <= 512u);
        const unsigned offl = incl - Ml, liml = fits ? incl : offl;
        if (wid == 0 && lane < 32 && !fits) ((LAS unsigned*)(lds + L_ROW))[8 * lane + 5] = 1u;
        my_off = __shfl(offl, qr); my_lim = __shfl(liml, qr);
        if (wid == 0 && lane < 32) ((LAS unsigned*)(lds + L_ROW))[8 * lane + 3] = offl;
    }
    {
        const unsigned tb = ((const LAS unsigned*)(lds + L_ROW))[8 * qr];
        LAS unsigned char* brow = lds + L_BMAP + qr * BROW;
        LAS unsigned* rcnt = (LAS unsigned*)(lds + L_ROW) + 8 * qr + 4;
        LAS unsigned long long* ck = (LAS unsigned long long*)(lds + L_CK);
        const unsigned long long* srd = scr + (size_t)qh * 32768 + q16 * 4 + kq;
#pragma unroll 1
        for (int t = kw; t < NT; t += 4) {
            typedef _Float16 h4 __attribute__((ext_vector_type(4)));
            unsigned long long raw[4];
#pragma unroll
            for (int blk = 0; blk < 4; ++blk) raw[blk] = __hip_atomic_load(srd + (size_t)t * 256 + blk * 64, __ATOMIC_RELAXED, __HIP_MEMORY_SCOPE_AGENT);
            float scf[4][4];
            unsigned gm[4], em = 0u;
#pragma unroll
            for (int blk = 0; blk < 4; ++blk) { gm[blk] = 0u; const h4 hs = __builtin_bit_cast(h4, raw[blk]);
#pragma unroll
                for (int r = 0; r < 4; ++r) { scf[blk][r] = (float)hs[r]; const unsigned bn = bin_of(scf[blk][r], bscale); gm[blk] |= (bn > tb) ? (1u << r) : 0u; em |= (bn == tb) ? (1u << (4 * blk + r)) : 0u; } }
            const unsigned w0 = (gm[0] | (gm[1] << 16)) << (4 * kq), w1 = (gm[2] | (gm[3] << 16)) << (4 * kq);
            if (w0) __hip_atomic_fetch_or((LAS unsigned*)(brow + (2 * t) * 4), w0, __ATOMIC_RELAXED, __HIP_MEMORY_SCOPE_WORKGROUP);
            if (w1) __hip_atomic_fetch_or((LAS unsigned*)(brow + (2 * t + 1) * 4), w1, __ATOMIC_RELAXED, __HIP_MEMORY_SCOPE_WORKGROUP);
            if (__any(em != 0u)) {
                unsigned k = my_off;
                if (em) k += __hip_atomic_fetch_add(rcnt, (unsigned)__builtin_popcount(em), __ATOMIC_RELAXED, __HIP_MEMORY_SCOPE_WORKGROUP);
                const int kbase = 64 * t + 4 * kq;
#pragma unroll
                for (int blk = 0; blk < 4; ++blk)
#pragma unroll
                    for (int r = 0; r < 4; ++r) { if (em & (1u << (4 * blk + r))) { if (k < my_lim) ck[k] = ((unsigned long long)skey(__float_as_uint(scf[blk][r])) << 16) | (unsigned long long)(0xFFFFu - (unsigned)(kbase + 16 * blk + r)); ++k; } }
            }
        }
    }
    asm volatile("s_waitcnt lgkmcnt(0)\n\ts_barrier" ::: "memory");
#pragma unroll 1
    for (int rr_ = 0; rr_ < (IX_PROBE == 4 ? 8 : 4); ++rr_) { const int rr = rr_ & 3;
        const int q = 4 * wid + rr;
        const LAS unsigned* rw = (const LAS unsigned*)(lds + L_ROW) + 8 * q;
        const unsigned above = (unsigned)__builtin_amdgcn_readfirstlane((int)rw[1]), Mq = (unsigned)__builtin_amdgcn_readfirstlane((int)rw[2]), offq = (unsigned)__builtin_amdgcn_readfirstlane((int)rw[3]);
        const bool over = __builtin_amdgcn_readfirstlane((int)rw[5]) != 0;
        const unsigned R = 256u - above;
        LAS unsigned* bm = (LAS unsigned*)(lds + L_BMAP + q * BROW);
        if (!over) {
            const LAS unsigned long long* sk = (const LAS unsigned long long*)(lds + L_CK) + offq;
            if (Mq <= 64u) {
                const bool vd = (unsigned)lane < Mq;
                const unsigned long long mine = sk[vd ? lane : 0];
                const unsigned mlo = (unsigned)mine, mhi = (unsigned)(mine >> 32);
                unsigned rk = 0u;
#pragma unroll 1
                for (unsigned e = 0; e < Mq; ++e) {
                    const unsigned long long ce = ((unsigned long long)(unsigned)__builtin_amdgcn_readlane((int)mhi, (int)e) << 32) | (unsigned)__builtin_amdgcn_readlane((int)mlo, (int)e);
                    rk += (ce > mine) ? 1u : 0u; }
                if (vd && rk < R) { const unsigned ix0 = 0xFFFFu - (mlo & 0xFFFFu); __hip_atomic_fetch_or(bm + (ix0 >> 5), 1u << (ix0 & 31), __ATOMIC_RELAXED, __HIP_MEMORY_SCOPE_WORKGROUP); }
            } else {
                unsigned long long mine[8]; unsigned rk[8]; bool vd[8];
#pragma unroll
                for (int k = 0; k < 8; ++k) { const unsigned e = lane + 64 * k; vd[k] = e < Mq; mine[k] = sk[vd[k] ? e : 0u]; rk[k] = 0u; }
#pragma unroll 2
                for (unsigned e = 0; e < Mq; ++e) { const unsigned long long ce = sk[e];
#pragma unroll
                    for (int k = 0; k < 8; ++k) rk[k] += (ce > mine[k]) ? 1u : 0u; }
#pragma unroll
                for (int k = 0; k < 8; ++k) if (vd[k] && rk[k] < R) { const unsigned ix0 = 0xFFFFu - ((unsigned)mine[k] & 0xFFFFu); __hip_atomic_fetch_or(bm + (ix0 >> 5), 1u << (ix0 & 31), __ATOMIC_RELAXED, __HIP_MEMORY_SCOPE_WORKGROUP); }
            }
        }
        asm volatile("s_waitcnt lgkmcnt(0)" ::: "memory");
        const u32x4 wv = *(const LAS u32x4*)(bm + 4 * lane);
        unsigned wd[4] = {wv.x, wv.y, wv.z, wv.w};
        const unsigned pc = __builtin_popcount(wd[0]) + __builtin_popcount(wd[1]) + __builtin_popcount(wd[2]) + __builtin_popcount(wd[3]);
        unsigned pos = wave_incl_scan(pc) - pc;
        LAS unsigned short* out = idxl + q * 256;
        if (!over) {
            unsigned long long x0 = ((unsigned long long)wd[1] << 32) | wd[0], x1 = ((unsigned long long)wd[3] << 32) | wd[2];
            const unsigned kb = 128u * (unsigned)lane;
            while (x0 | x1) {
                unsigned key;
                if (x0) { key = kb + (unsigned)__builtin_ctzll(x0); x0 &= x0 - 1ull; } else { key = kb + 64u + (unsigned)__builtin_ctzll(x1); x1 &= x1 - 1ull; }
                if (pos < 256u) out[pos] = (unsigned short)key;
                ++pos;
            }
        }
    }
    asm volatile("s_waitcnt vmcnt(0) lgkmcnt(0)\n\ts_barrier" ::: "memory");
    {
        const bool anyf = __any(((const LAS unsigned*)(lds + L_ROW))[8 * (lane & 31) + 5] != 0u);
        if (anyf) {
            __syncthreads();
#pragma unroll 1
            for (int r = 0; r < 32; ++r) { const unsigned f = ((const LAS unsigned*)(lds + L_ROW))[8 * r + 5];
                if (f) { topk_row_exact((int)m0 + r, proj, topk, lds); if (tid < 256) idxl[r * 256 + tid] = topk[(m0 + r) * 256 + tid]; } }
        }
        __syncthreads();
    }
    if (IX_FUSE_SA) {
#pragma unroll 1
        for (int rr_ = 0; rr_ < (IX_PROBE == 7 ? 8 : 4); ++rr_) { const int rr = rr_ & 3; attend(m0 + 4 * wid + rr, b, 256, idxl + (4 * wid + rr) * 256, lds + wid * 9216, lane); }
    } else { for (int i = tid; i < 32 * 128; i += NTHR) ((unsigned*)(topk + m0 * 256))[i] = ((const LAS unsigned*)idxl)[i]; }
    asm volatile("s_waitcnt lgkmcnt(0)\n\ts_barrier" ::: "memory");
}

template <class SAQ> __device__ __forceinline__ void ph_topk(const bf16_t* proj, unsigned short* topk, unsigned char* scr_base, LAS unsigned char* lds, bool force_exact, const SAQ& attend) {
    unsigned long long* scr = (unsigned long long*)(scr_base + (size_t)blockIdx.x * 524288);
    const int G = (int)gridDim.x, bid = (int)blockIdx.x;
    if (G == 256) {
        const int b = bid & 7, idx = bid >> 3;
#pragma unroll 1
        for (int i = 0; i < 8; ++i) { const int j = (i & 1) ? 64 * (i >> 1) + 63 - idx : 64 * (i >> 1) + idx; topk_unit(b, j, proj, topk, scr, lds, force_exact, attend); }
    } else {
        for (int u = bid; u < NB * 256; u += G) topk_unit(u >> 8, u & 255, proj, topk, scr, lds, force_exact, attend);
    }
}
}

constexpr int RING_BYTES = 131072, LDSCTL_OFF = RING_BYTES, LDS_BYTES = 147456;
constexpr size_t CTL_ZERO_BYTES = 1 * MiB;
constexpr int CW_TMO = 0, CW_BAR = 4096;

struct Args { const void* in[19]; float* out; unsigned char* ws; };

#define FRESH_IDS const int tid = fresh_tid(), lane = tid & 63, wave = __builtin_amdgcn_readfirstlane(tid >> 6); (void)lane; (void)wave
#define GSTRIDE_WAVES(gw, NGW) const int gw = (int)blockIdx.x * NWAVES + wave, NGW = (int)gridDim.x * NWAVES

__device__ __forceinline__ int src_col(int p, int N, int mode) {
    if (mode == 0) return (p < N) ? p : -1;
    const int tile = p >> 8, wc = (p >> 5) & 3, d = 32 * ((p >> 7) & 1) + (p & 31);
    if (mode == 1) return tile * 256 + 64 * wc + d;
    if (tile < 3) return DQ + 64 * (4 * tile + wc) + d;
    if (tile == 3) return wc == 0 ? DK + d : wc == 1 ? DV + d : wc == 2 ? DIK + d : (d < 8 ? DIW + d : -1);
    if (tile < 6) return DIQ + 64 * (4 * (tile - 4) + wc) + d;
    return DQM + 64 * wc + d;
}
__device__ __forceinline__ void prep_item(const float* __restrict__ W, int K, int N, bf16_t* __restrict__ Wt, int Nout, int mode, LAS float* scr, int item, int lane) {
    const int nblk = Nout / 32, kb = item / nblk, nb = item % nblk, k0 = 64 * kb, p0 = 32 * nb;
    const int p = src_col(p0 + (lane & 31), N, mode);
#pragma unroll
    for (int i = 0; i < 32; ++i) { const int kk = 2 * i + (lane >> 5); scr[kk * 33 + (lane & 31)] = (p >= 0) ? W[(size_t)(k0 + kk) * N + p] : 0.f; }
    LDS_WAIT(); asm volatile("" ::: "memory");
    const int c = lane & 7;
#pragma unroll
    for (int j = 0; j < 4; ++j) { const int n = (lane >> 3) + 8 * j; const LAS float* s = scr + (8 * c) * 33 + n;
        u32x4 o; o.x = pk2(s[0 * 33], s[1 * 33]); o.y = pk2(s[2 * 33], s[3 * 33]); o.z = pk2(s[4 * 33], s[5 * 33]); o.w = pk2(s[6 * 33], s[7 * 33]);
        *(u32x4*)(Wt + (size_t)(p0 + n) * K + k0 + 8 * c) = o; }
    LDS_WAIT(); asm volatile("" ::: "memory");
}
__device__ __forceinline__ void prep_matrix(const float* W, int K, int N, bf16_t* Wt, int Nout, int mode, LAS float* scr, int gw, int NGW, int lane) {
    const int nitems = (K / 64) * (Nout / 32);
    for (int it = gw; it < nitems; it += NGW) prep_item(W, K, N, Wt, Nout, mode, scr, it, lane);
}
__device__ __forceinline__ void rms_row_bf16(const float* xrow, const float* g, bf16_t* orow, int lane) {
    const f32x4* xr = (const f32x4*)xrow + lane; const f32x4* gr = (const f32x4*)g + lane;
    f32x4 v[4]; float s = 0.f;
#pragma unroll
    for (int j = 0; j < 4; ++j) { v[j] = xr[64 * j]; s += (v[j].x * v[j].x + v[j].y * v[j].y) + (v[j].z * v[j].z + v[j].w * v[j].w); }
    const float rstd = 1.f / sqrtf(wave_sum(s) * (1.f / D) + EPS);
    unsigned long long* o8 = (unsigned long long*)orow + lane;
#pragma unroll
    for (int j = 0; j < 4; ++j) { const f32x4 gg = gr[64 * j];
        o8[64 * j] = (unsigned long long)pk2(v[j].x * rstd * gg.x, v[j].y * rstd * gg.y) | ((unsigned long long)pk2(v[j].z * rstd * gg.z, v[j].w * rstd * gg.w) << 32); }
}
__device__ __forceinline__ f32x4 ld4(const float* p) { return *(const f32x4*)p; }
__device__ __forceinline__ f32x4 ld4(const bf16_t* p) { const unsigned long long u = *(const unsigned long long*)p; return (f32x4){__uint_as_float((unsigned)u << 16), __uint_as_float((unsigned)u & 0xFFFF0000u), __uint_as_float((unsigned)(u >> 32) << 16), __uint_as_float((unsigned)(u >> 32) & 0xFFFF0000u)}; }
__device__ __forceinline__ void st4(float* p, f32x4 v) { *(f32x4*)p = v; }
__device__ __forceinline__ void st4(bf16_t* p, f32x4 v) { *(unsigned long long*)p = (unsigned long long)pk2(v.x, v.y) | ((unsigned long long)pk2(v.z, v.w) << 32); }
template <class TI, class TO> __device__ __forceinline__ void norm_res_row(const bf16_t* yrow, const TI* xin, const float* g1, TO* xout, const float* g2, bf16_t* hrow, int lane) {
    f32x4 v[4], xv[4]; float s = 0.f;
#pragma unroll
    for (int j = 0; j < 4; ++j) { v[j] = ld4(yrow + 4 * lane + 256 * j); xv[j] = ld4(xin + 4 * lane + 256 * j); s += (v[j].x * v[j].x + v[j].y * v[j].y) + (v[j].z * v[j].z + v[j].w * v[j].w); }
    const float rstd = 1.f / sqrtf(wave_sum(s) * (1.f / D) + EPS);
    float s2 = 0.f;
#pragma unroll
    for (int j = 0; j < 4; ++j) { const f32x4 gg = ((const f32x4*)g1 + lane)[64 * j]; xv[j] = xv[j] + v[j] * rstd * gg;
        s2 += (xv[j].x * xv[j].x + xv[j].y * xv[j].y) + (xv[j].z * xv[j].z + xv[j].w * xv[j].w);
        st4(xout + 4 * lane + 256 * j, xv[j]); }
    if (g2) {
        const float r2 = 1.f / sqrtf(wave_sum(s2) * (1.f / D) + EPS);
#pragma unroll
        for (int j = 0; j < 4; ++j) { const f32x4 gg = ((const f32x4*)g2 + lane)[64 * j]; st4(hrow + 4 * lane + 256 * j, (f32x4){xv[j].x * r2 * gg.x, xv[j].y * r2 * gg.y, xv[j].z * r2 * gg.z, xv[j].w * r2 * gg.w}); }
    }
}
template <class TI, class TO> __device__ __forceinline__ void ph_norm_res(const bf16_t* Y, const TI* xin, const float* g1, TO* xout, const float* g2, bf16_t* H, int wave, int lane) {
    GSTRIDE_WAVES(gw, NGW);
    for (int m = gw * 2; m < M; m += NGW * 2) {
        f32x4 v[2][4], xv[2][4]; float rs[2];
#pragma unroll
        for (int r = 0; r < 2; ++r)
#pragma unroll
            for (int j = 0; j < 4; ++j) { v[r][j] = ld4(Y + (size_t)(m + r) * D + 4 * lane + 256 * j); xv[r][j] = ld4(xin + (size_t)(m + r) * D + 4 * lane + 256 * j); }
#pragma unroll
        for (int r = 0; r < 2; ++r) { float s = 0.f;
#pragma unroll
            for (int j = 0; j < 4; ++j) s += (v[r][j].x * v[r][j].x + v[r][j].y * v[r][j].y) + (v[r][j].z * v[r][j].z + v[r][j].w * v[r][j].w);
            rs[r] = 1.f / sqrtf(wave_sum(s) * (1.f / D) + EPS); }
        float s2[2] = {0.f, 0.f};
#pragma unroll
        for (int j = 0; j < 4; ++j) { const f32x4 gg = ((const f32x4*)g1 + lane)[64 * j];
#pragma unroll
            for (int r = 0; r < 2; ++r) { xv[r][j] = xv[r][j] + v[r][j] * rs[r] * gg;
                s2[r] += (xv[r][j].x * xv[r][j].x + xv[r][j].y * xv[r][j].y) + (xv[r][j].z * xv[r][j].z + xv[r][j].w * xv[r][j].w);
                st4(xout + (size_t)(m + r) * D + 4 * lane + 256 * j, xv[r][j]); } }
        if (g2) {
#pragma unroll
            for (int r = 0; r < 2; ++r) s2[r] = 1.f / sqrtf(wave_sum(s2[r]) * (1.f / D) + EPS);
#pragma unroll
            for (int j = 0; j < 4; ++j) { const f32x4 gg = ((const f32x4*)g2 + lane)[64 * j];
#pragma unroll
                for (int r = 0; r < 2; ++r) st4(H + (size_t)(m + r) * D + 4 * lane + 256 * j, (f32x4){xv[r][j].x * s2[r] * gg.x, xv[r][j].y * s2[r] * gg.y, xv[r][j].z * s2[r] * gg.z, xv[r][j].w * s2[r] * gg.w}); }
        }
    }
}
__device__ __forceinline__ void ph_attn_diff(const bf16_t* P, bf16_t* O, const float* lq1, const float* lk1, const float* lq2, const float* lk2, const float* gsub, LAS unsigned char* lds, int same_tile = 0) {
    float a1 = 0.f, a2 = 0.f;
    for (int i = 0; i < 64; ++i) { a1 += lq1[i] * lk1[i]; a2 += lq2[i] * lk2[i]; }
    const float lam = expf(a1) - expf(a2) + 0.2f;
    const int G = (int)gridDim.x, bid = (int)blockIdx.x; const int vcu = (G % 8 == 0) ? (bid % 8) * (G / 8) + bid / 8 : bid;
    for (int i = 0; ; ++i) {
        const int pu = vcu + (i >> 1) * G; if (pu >= NB * 6 * 32) break;
        const int bh = pu >> 5, pair = pu & 31, b = bh / 6, h = bh % 6; const int qblk = (i & 1) ? pair : 63 - pair;
        fa::Unit U;
        U.q0 = P + P0_Q + (size_t)(b * 12 + 2 * h) * S * 64; U.q1 = U.q0 + (size_t)S * 64;
        U.k0 = P + P0_K + (size_t)(b * 12 + 2 * h) * S * 64; U.k1 = U.k0 + (size_t)S * 64;
        U.v = P + P0_V + (size_t)(b * 6 + h) * S * 128; U.qrow0 = qblk * 128; U.nt = 2 * qblk + 2; U.same_tile = same_tile;
        fa::attn_unit<2, 128>(U, true, O, b * S, h * 128, lam, gsub, 0.8f, lds);
    }
}
__device__ __forceinline__ void ph_attn_mem(const bf16_t* QM, const bf16_t* kv, bf16_t* O, LAS unsigned char* lds) {
    for (int u = (int)blockIdx.x; u < NB * 4 * (S / 256); u += (int)gridDim.x) {
        const int b = u >> 7, mh = (u >> 5) & 3, qb = u & 31;
        fa::Unit U;
        U.q0 = QM + (size_t)(b * 4 + mh) * S * 64; U.q1 = U.q0;
        U.k0 = kv + MKV_K + (size_t)(b * 4 + mh) * NMEMT * 64; U.k1 = U.k0;
        U.v = kv + MKV_V + (size_t)(b * 4 + mh) * NMEMT * 64; U.qrow0 = qb * 256; U.nt = 4; U.same_tile = 0;
        fa::attn_unit<1, 64>(U, false, O, b * S, 768 + mh * 64, 0.f, nullptr, 1.f, lds);
    }
}

#ifndef DUP_MASK
#define DUP_MASK 0
#endif
#define REP(k, ...) do { __VA_ARGS__; if ((DUP_MASK >> (k)) & 1) { __VA_ARGS__; } } while (0)
#ifndef IX_FORCE_EXACT
#define IX_FORCE_EXACT 0
#endif
#define GEMM_PHASE(EPI, Aptr, Bptr, Mr, Nn, Kk, ...) do { pg8::Gemm g_{(Aptr), (Bptr), (Mr), (Nn), (Kk)}; pg8::StaticOrder S_; S_.init((Mr), (Nn), (int)gridDim.x, (int)blockIdx.x); \
    EPI E_{__VA_ARGS__}; pg8::gemm_phase<EPI, pg8::StaticOrder, true, true>(lds, g_, S_, E_); } while (0)

__global__ void __launch_bounds__(NTHR, 2) mk_fwd(Args args) {
    extern __shared__ __attribute__((aligned(16))) unsigned char lds_raw[];
    LAS unsigned char* lds = (LAS unsigned char*)lds_raw;
    unsigned char* ws = args.ws; float* out = args.out;
    const float* x = (const float*)args.in[0]; const float* mem = (const float*)args.in[1]; const int* pos = (const int*)args.in[2];
    const float* g_pre_mix = (const float*)args.in[3]; const float* g_post_mix = (const float*)args.in[4]; const float* g_mem = (const float*)args.in[5];
    const float* w_mem_kv = (const float*)args.in[6]; const float* w_out = (const float*)args.in[7]; const float* g_pre_mlp = (const float*)args.in[8];
    const float* g_post_mlp = (const float*)args.in[9]; const float* w_up = (const float*)args.in[10]; const float* w_dn = (const float*)args.in[11];
    const float* w_in_diff = (const float*)args.in[12]; const float* lq1 = (const float*)args.in[13]; const float* lk1 = (const float*)args.in[14];
    const float* lq2 = (const float*)args.in[15]; const float* lk2 = (const float*)args.in[16]; const float* gsub = (const float*)args.in[17]; const float* w_in_dsa = (const float*)args.in[18];
    bf16_t* Win0 = (bf16_t*)(ws + WS_WIN0); bf16_t* Win1 = (bf16_t*)(ws + WS_WIN1); bf16_t* Wout = (bf16_t*)(ws + WS_WOUT);
    bf16_t* Wup = (bf16_t*)(ws + WS_WUP); bf16_t* Wdn = (bf16_t*)(ws + WS_WDN); bf16_t* Wkv = (bf16_t*)(ws + WS_WKV);
    bf16_t* memn = (bf16_t*)(ws + WS_MEMN); bf16_t* memkv = (bf16_t*)(ws + WS_MEMKV); float2* rope = (float2*)(ws + WS_ROPE);
    unsigned short* topk = (unsigned short*)(ws + WS_TOPK); bf16_t* H = (bf16_t*)(ws + WS_H); bf16_t* proj = (bf16_t*)(ws + WS_PROJ);
    bf16_t* O = (bf16_t*)(ws + WS_O); bf16_t* hid = (bf16_t*)(ws + WS_HID); bf16_t* Y = (bf16_t*)(ws + WS_Y); bf16_t* X16 = (bf16_t*)(ws + WS_Y + 128 * MiB);
    gu32* ctl = (gu32*)(ws + WS_CTL);

    for (int u = threadIdx.x; u < (LDS_BYTES - LDSCTL_OFF) / 4; u += NTHR) ((LAS unsigned*)(lds + LDSCTL_OFF))[u] = 0u;
    __syncthreads();
    XcdBarrier bar = xcd_barrier_post((unsigned*)(ctl + CW_BAR), (volatile LAS unsigned*)(lds + LDSCTL_OFF + 64));
#define GRID_BAR() xcd_barrier(bar)

    for (int rep0 = 0; rep0 < 1 + ((DUP_MASK >> 0) & 1); ++rep0) {
        FRESH_IDS;
        LAS float* scr = (LAS float*)(lds + wave * 16384);
        GSTRIDE_WAVES(gw, NGW);
        prep_matrix(w_in_diff, D, NDIFF, Win0, NDIFF, 1, scr, gw, NGW, lane);
        prep_matrix(w_in_dsa, D, NDSA_L, Win1, NDSA, 2, scr, gw, NGW, lane);
#pragma unroll 1
        for (int l = 0; l < 2; ++l) {
            prep_matrix(w_out + (size_t)l * D * D, D, D, Wout + (size_t)l * D * D, D, 0, scr, gw, NGW, lane);
            prep_matrix(w_up + (size_t)l * D * FF, D, FF, Wup + (size_t)l * D * FF, FF, 0, scr, gw, NGW, lane);
            prep_matrix(w_dn + (size_t)l * D * FF, FF, D, Wdn + (size_t)l * D * FF, D, 0, scr, gw, NGW, lane);
            prep_matrix(w_mem_kv + (size_t)l * D * 512, D, 512, Wkv + (size_t)l * D * 512, 512, 1, scr, gw, NGW, lane);
            for (int m = gw; m < NB * NMEMT; m += NGW) rms_row_bf16(mem + (size_t)m * D, g_mem + l * D, memn + ((size_t)l * NB * NMEMT + m) * D, lane);
        }
        {
            const double inv_rev = pow(10000.0, -(double)(tid & 31) / 32.0) * 0.15915494309189535;
            for (int idx = (int)blockIdx.x * NTHR + tid; idx < M * 32; idx += (int)gridDim.x * NTHR) {
                const double rev = (double)pos[idx >> 5] * inv_rev; const float fr = (float)(rev - rint(rev));
                rope[idx] = make_float2(__builtin_amdgcn_cosf(fr), __builtin_amdgcn_sinf(fr));
            }
        }
        for (int m = gw * 4; m < M; m += NGW * 4) {
            f32x4 v[4][4]; float ss[4];
#pragma unroll
            for (int r = 0; r < 4; ++r) { const f32x4* xr = (const f32x4*)(x + (size_t)(m + r) * D) + lane;
#pragma unroll
                for (int j = 0; j < 4; ++j) v[r][j] = xr[64 * j]; }
#pragma unroll
            for (int r = 0; r < 4; ++r) { float s = 0.f;
#pragma unroll
                for (int j = 0; j < 4; ++j) s += (v[r][j].x * v[r][j].x + v[r][j].y * v[r][j].y) + (v[r][j].z * v[r][j].z + v[r][j].w * v[r][j].w);
                ss[r] = 1.f / sqrtf(wave_sum(s) * (1.f / D) + EPS); }
#pragma unroll
            for (int j = 0; j < 4; ++j) { const f32x4 gg = ((const f32x4*)g_pre_mix + lane)[64 * j];
#pragma unroll
                for (int r = 0; r < 4; ++r) st4(H + (size_t)(m + r) * D + 4 * lane + 256 * j, (f32x4){v[r][j].x * ss[r] * gg.x, v[r][j].y * ss[r] * gg.y, v[r][j].z * ss[r] * gg.z, v[r][j].w * ss[r] * gg.w}); }
        }
    }
    GRID_BAR();
    REP(1, GEMM_PHASE(EpiMemKV, memn, Wkv, NB * NMEMT, 512, D, memkv);
           GEMM_PHASE(EpiMemKV, memn + (size_t)NB * NMEMT * D, Wkv + (size_t)D * 512, NB * NMEMT, 512, D, memkv + MKV_LAYER);
           GEMM_PHASE(EpiProj0, H, Win0, M, NDIFF, D, proj, rope));
    GRID_BAR();
    REP(2, ph_attn_diff(proj, O, lq1, lk1, lq2, lk2, gsub, lds));
    if ((DUP_MASK >> 14) & 1) ph_attn_diff(proj, Y, lq1, lk1, lq2, lk2, gsub, lds, 1);
    if ((DUP_MASK >> 13) & 1) ph_attn_diff(proj, Y, lq1, lk1, lq2, lk2, gsub, lds, 2);
    REP(3, ph_attn_mem(proj + P0_QM, memkv, O, lds));
    GRID_BAR();
    REP(4, GEMM_PHASE(EpiB<0>, O, Wout, M, D, D, Y, D));
    GRID_BAR();
    { FRESH_IDS; ph_norm_res(Y, x, g_post_mix, X16, g_pre_mlp, H, wave, lane); }
    if ((DUP_MASK >> 15) & 1) { FRESH_IDS; ph_norm_res(Y, x, g_post_mix, hid, g_pre_mlp, hid + (size_t)M * D, wave, lane); }
    GRID_BAR();
    REP(5, GEMM_PHASE(EpiB<2>, H, Wup, M, FF, D, hid, FF));
    GRID_BAR();
    REP(6, GEMM_PHASE(EpiB<0>, hid, Wdn, M, D, FF, Y, D));
    GRID_BAR();
    { FRESH_IDS; ph_norm_res(Y, X16, g_post_mlp, X16, g_pre_mix + D, H, wave, lane); }
    GRID_BAR();
    REP(7, GEMM_PHASE(EpiProj1, H, Win1, M, NDSA, D, proj, rope));
    GRID_BAR();
    {
        auto attend = [=](size_t m, int b, int nvalid, const LAS unsigned short* idx, LAS unsigned char* vst, int lane) { sa::query((int)m, b, nvalid, proj, idx, vst, O, lane); };
        REP(8, ix::ph_topk(proj, topk, (unsigned char*)Y, lds, IX_FORCE_EXACT != 0, attend));
    }
#if !IX_FUSE_SA
    GRID_BAR();
    REP(9, sa::ph_dsa_attn(proj, topk, O, lds); __syncthreads());
#endif
    REP(3, ph_attn_mem(proj + P1_QM, memkv + MKV_LAYER, O, lds));
    GRID_BAR();
    GEMM_PHASE(EpiB<0>, O, Wout + (size_t)D * D, M, D, D, Y, D);
    GRID_BAR();
    { FRESH_IDS; ph_norm_res(Y, X16, g_post_mix + D, X16, g_pre_mlp + D, H, wave, lane); }
    GRID_BAR();
    GEMM_PHASE(EpiB<2>, H, Wup + (size_t)D * FF, M, FF, D, hid, FF);
    GRID_BAR();
    GEMM_PHASE(EpiB<0>, hid, Wdn + (size_t)D * FF, M, D, FF, Y, D);
    GRID_BAR();
    { FRESH_IDS; ph_norm_res(Y, X16, g_post_mlp + D, out, (const float*)nullptr, H, wave, lane); }
}

extern "C" void kernel_launch(void* const* d_in, const int* in_sizes, int n_in, void* d_out, int out_size, void* d_ws, size_t ws_size, hipStream_t stream) {
    static int grid = 0;
    if (grid == 0) {
        if (n_in != 19 || out_size != M * D || ws_size < WS_END) { fprintf(stderr, "kernel_launch: unexpected shapes n_in %d out %d ws %zu\n", n_in, out_size, ws_size); grid = -1; return; }
        int dev = 0, cus = 0, per_cu = 0;
        if (hipGetDevice(&dev) != hipSuccess || hipDeviceGetAttribute(&cus, hipDeviceAttributeMultiprocessorCount, dev) != hipSuccess) { grid = -1; return; }
        if (hipFuncSetAttribute((const void*)mk_fwd, hipFuncAttributeMaxDynamicSharedMemorySize, LDS_BYTES) != hipSuccess) { fprintf(stderr, "kernel_launch: hipFuncSetAttribute failed\n"); grid = -1; return; }
        if (hipOccupancyMaxActiveBlocksPerMultiprocessor(&per_cu, (const void*)mk_fwd, NTHR, LDS_BYTES) != hipSuccess || per_cu < 1) { fprintf(stderr, "kernel_launch: occupancy query says %d blocks per CU\n", per_cu); grid = -1; (void)hipGetLastError(); return; }
        grid = cus;
    }
    if (grid < 0) return;
    (void)hipMemsetAsync((char*)d_ws + WS_CTL, 0, CTL_ZERO_BYTES, stream);
    Args a; memset(&a, 0, sizeof(a));
    for (int i = 0; i < 19; ++i) a.in[i] = d_in[i];
    a.out = (float*)d_out; a.ws = (unsigned char*)d_ws;
    hipLaunchKernelGGL(mk_fwd, dim3(grid), dim3(NTHR), LDS_BYTES, stream, a);
}
```
